# Optimizing an MI355X kernel written in HIP

```python
import math
import jax, jax.numpy as jnp
from jax import lax
import numpy as np

D_MODEL = 2048
BATCH = 4
SEQ = 2048
DEPTH = 2

D_FF = 256 * ((8 * D_MODEL // 3 + 255) // 256)
HEAD_DIM = 128
A_HEADS = D_MODEL // (2 * HEAD_DIM)
A_WIDTH = A_HEADS * HEAD_DIM
MOBA_BLOCK = 256
MOBA_TOPK = 3
MOBA_QUERY_BLOCK = 64
ROPE_THETA = 10000.0
G_GROUPS = A_HEADS
G_DIM = HEAD_DIM
G_WIDTH = G_GROUPS * G_DIM
GMLP_CHUNK = 128
AB_IN = 3 * A_WIDTH + 2 * G_WIDTH
AB_MIX = A_WIDTH + G_WIDTH
DN_QK_HEADS = D_MODEL // 128
DN_V_HEADS = 2 * DN_QK_HEADS
DN_HEAD_DIM = 128
DN_QK_WIDTH = DN_QK_HEADS * DN_HEAD_DIM
DN_V_WIDTH = DN_V_HEADS * DN_HEAD_DIM
DN_CONV_DIM = 2 * DN_QK_WIDTH + DN_V_WIDTH
DN_IN = DN_CONV_DIM + DN_V_WIDTH + 2 * DN_V_HEADS
DN_CONV = 4
DN_CHUNK = 64
DEEPNORM_ALPHA = (2 * DEPTH) ** 0.25
DEEPNORM_BETA = (8 * DEPTH) ** -0.25
LN_EPS = 1e-5
RMS_EPS = 1e-6
NEG_INF = -1e30

kernel_name = 'hybrid_moba_gmlp_gdn_macaron_deepnorm'


def layer_norm(x, g, b):
    xf = x.astype(jnp.float32)
    mu = jnp.mean(xf, axis=-1, keepdims=True)
    xc = xf - mu
    var = jnp.mean(xc * xc, axis=-1, keepdims=True)
    y = xc * lax.rsqrt(var + LN_EPS) * g.astype(jnp.float32) + b.astype(jnp.float32)
    return y.astype(x.dtype)


def swiglu(x, w_gate, w_up, w_down):
    return (jax.nn.silu(x @ w_gate) * (x @ w_up)) @ w_down


def rope(x):
    s, d = x.shape[2], x.shape[3]
    half = d // 2
    inv = jnp.exp(-math.log(ROPE_THETA) * jnp.arange(half, dtype=jnp.float32) * (2.0 / d))
    ang = jnp.arange(s, dtype=jnp.float32)[:, None] * inv[None, :]
    cos, sin = jnp.cos(ang), jnp.sin(ang)
    xf = x.astype(jnp.float32)
    x1, x2 = xf[..., :half], xf[..., half:]
    return jnp.concatenate([x1 * cos - x2 * sin, x2 * cos + x1 * sin], axis=-1).astype(x.dtype)


def moba_attention(q, k, v):
    b, h, s, d = q.shape
    nb = -(-s // MOBA_BLOCK)
    pad = nb * MOBA_BLOCK - s
    kp = jnp.pad(k, ((0, 0), (0, 0), (0, pad), (0, 0)))
    vp = jnp.pad(v, ((0, 0), (0, 0), (0, pad), (0, 0)))
    k_blocks = kp.reshape(b, h, nb, MOBA_BLOCK, d)
    v_blocks = vp.reshape(b, h, nb, MOBA_BLOCK, d)
    k_mean = jnp.mean(k_blocks.astype(jnp.float32), axis=3)
    gate = jnp.einsum('bhsd,bhnd->bhsn', q.astype(jnp.float32), k_mean)
    q_blk = jnp.arange(s) // MOBA_BLOCK
    past = jnp.arange(nb)[None, :] < q_blk[:, None]
    gate = jnp.where(past[None, None], gate, NEG_INF)
    n_sel = min(MOBA_TOPK, nb)
    _, sel = lax.top_k(gate, n_sel)
    sel_valid = jnp.arange(n_sel)[None, :] < q_blk[:, None]
    scale = d ** -0.5
    b_idx = jnp.arange(b)[:, None, None, None]
    h_idx = jnp.arange(h)[None, :, None, None]
    qb = MOBA_QUERY_BLOCK

    def attend_block(i):
        start = i * qb
        qi = lax.dynamic_slice_in_dim(q, start, qb, axis=2)
        si = lax.dynamic_slice_in_dim(sel, start, qb, axis=2)
        vi = lax.dynamic_slice_in_dim(sel_valid, start, qb, axis=0)
        qpos = start + jnp.arange(qb)
        kg = k_blocks[b_idx, h_idx, si]
        vg = v_blocks[b_idx, h_idx, si]
        s_sel = jnp.einsum('bhqd,bhqnkd->bhqnk', qi, kg, preferred_element_type=jnp.float32) * scale
        s_sel = jnp.where(vi[None, None, :, :, None], s_sel, NEG_INF).reshape(b, h, qb, n_sel * MOBA_BLOCK)
        own = start // MOBA_BLOCK
        k_own = lax.dynamic_index_in_dim(k_blocks, own, axis=2, keepdims=False)
        v_own = lax.dynamic_index_in_dim(v_blocks, own, axis=2, keepdims=False)
        kpos = own * MOBA_BLOCK + jnp.arange(MOBA_BLOCK)
        s_own = jnp.einsum('bhqd,bhkd->bhqk', qi, k_own, preferred_element_type=jnp.float32) * scale
        s_own = jnp.where((kpos[None, :] <= qpos[:, None])[None, None], s_own, NEG_INF)
        p = jax.nn.softmax(jnp.concatenate([s_sel, s_own], axis=-1), axis=-1).astype(v.dtype)
        p_sel = p[..., :n_sel * MOBA_BLOCK].reshape(b, h, qb, n_sel, MOBA_BLOCK)
        p_own = p[..., n_sel * MOBA_BLOCK:]
        return (jnp.einsum('bhqnk,bhqnkd->bhqd', p_sel, vg)
                + jnp.einsum('bhqk,bhkd->bhqd', p_own, v_own))

    out = lax.map(attend_block, jnp.arange(s // qb))
    return out.transpose(1, 2, 0, 3, 4).reshape(b, h, s, d)


def chunked_spatial_gating(u, v, ln_g, ln_b, w_s, b_s):
    b, s, _ = u.shape
    u = jax.nn.gelu(u).reshape(b, s, G_GROUPS, G_DIM)
    vf = jax.nn.gelu(v).astype(jnp.float32).reshape(b, s, G_GROUPS, G_DIM)
    mu = jnp.mean(vf, axis=-1, keepdims=True)
    vc = vf - mu
    var = jnp.mean(vc * vc, axis=-1, keepdims=True)
    vn = (vc * lax.rsqrt(var + LN_EPS) * ln_g.reshape(G_GROUPS, G_DIM).astype(jnp.float32)
          + ln_b.reshape(G_GROUPS, G_DIM).astype(jnp.float32)).astype(u.dtype)
    vn = vn.reshape(b, s // GMLP_CHUNK, GMLP_CHUNK, G_GROUPS, G_DIM)
    causal = jnp.tril(jnp.ones((GMLP_CHUNK, GMLP_CHUNK), dtype=bool))
    w = jnp.where(causal[None], w_s, jnp.zeros_like(w_s))
    mixed = jnp.einsum('gts,bnsgd->bntgd', w, vn) + b_s.T[None, None, :, :, None]
    return (u * mixed.reshape(b, s, G_GROUPS, G_DIM)).reshape(b, s, G_WIDTH)


def mixer_ab(x, w_in, ln_g, ln_b, w_s, b_s, w_out):
    b, s, _ = x.shape
    hcat = x @ w_in
    q = hcat[..., :A_WIDTH]
    k = hcat[..., A_WIDTH:2 * A_WIDTH]
    v = hcat[..., 2 * A_WIDTH:3 * A_WIDTH]
    gu = hcat[..., 3 * A_WIDTH:3 * A_WIDTH + G_WIDTH]
    gv = hcat[..., 3 * A_WIDTH + G_WIDTH:]
    heads = lambda t: t.reshape(b, s, A_HEADS, HEAD_DIM).transpose(0, 2, 1, 3)
    a_out = moba_attention(rope(heads(q)), rope(heads(k)), heads(v))
    a_out = a_out.transpose(0, 2, 1, 3).reshape(b, s, A_WIDTH)
    g_out = chunked_spatial_gating(gu, gv, ln_g, ln_b, w_s, b_s)
    return jnp.concatenate([a_out, g_out], axis=-1) @ w_out


def causal_conv_silu(x, w):
    kw = w.shape[0]
    s = x.shape[1]
    xp = jnp.pad(x, ((0, 0), (kw - 1, 0), (0, 0)))
    y = xp[:, 0:s] * w[0]
    for j in range(1, kw):
        y = y + xp[:, j:j + s] * w[j]
    return jax.nn.silu(y)


def gated_delta_rule(q, k, v, g, beta):
    b, s, h, dk = q.shape
    dv = v.shape[-1]
    c = DN_CHUNK
    n = s // c

    def to_chunks(t):
        t = t.reshape(b, n, c, h, *t.shape[3:])
        return jnp.swapaxes(jnp.moveaxis(t, 1, 0), 2, 3)

    q, k, v, g, beta = map(to_chunks, (q, k, v, g, beta))
    gc = jnp.cumsum(g, axis=-1)
    incl = jnp.tril(jnp.ones((c, c), dtype=bool))
    strict = jnp.tril(jnp.ones((c, c), dtype=bool), -1)
    decay = jnp.exp(jnp.where(incl, gc[..., :, None] - gc[..., None, :], -jnp.inf))
    kb = k * beta[..., None]
    vb = v * beta[..., None]
    a_low = jnp.where(strict, jnp.einsum('nbhck,nbhek->nbhce', kb, k) * decay, 0.0)
    t_sys = a_low + jnp.eye(c, dtype=a_low.dtype)
    u = lax.linalg.triangular_solve(t_sys, vb, left_side=True, lower=True, unit_diagonal=True)
    w = lax.linalg.triangular_solve(t_sys, kb * jnp.exp(gc)[..., None], left_side=True, lower=True,
                                    unit_diagonal=True)
    attn = jnp.einsum('nbhck,nbhek->nbhce', q, k) * decay
    q_dec = q * jnp.exp(gc)[..., None]
    k_dec = k * jnp.exp(gc[..., -1:] - gc)[..., None]
    g_last = jnp.exp(gc[..., -1])

    def step(state, xs):
        u_c, w_c, qd_c, a_c, kd_c, gl_c = xs
        v_new = u_c - jnp.einsum('bhck,bhkv->bhcv', w_c, state)
        o_c = jnp.einsum('bhck,bhkv->bhcv', qd_c, state) + jnp.einsum('bhce,bhev->bhcv', a_c, v_new)
        state = state * gl_c[..., None, None] + jnp.einsum('bhck,bhcv->bhkv', kd_c, v_new)
        return state, o_c

    state0 = jnp.zeros((b, h, dk, dv), jnp.float32)
    _, o = lax.scan(step, state0, (u, w, q_dec, attn, k_dec, g_last))
    o = jnp.moveaxis(jnp.swapaxes(o, 2, 3), 0, 1)
    return o.reshape(b, s, h, dv)


def mixer_dn(x, w_in, conv_w, a_log, dt_bias, norm_g, w_out):
    b, s, _ = x.shape
    hcat = x @ w_in
    off = DN_CONV_DIM + DN_V_WIDTH
    qkv = causal_conv_silu(hcat[..., :DN_CONV_DIM], conv_w)
    z = hcat[..., DN_CONV_DIM:off]
    bb = hcat[..., off:off + DN_V_HEADS]
    aa = hcat[..., off + DN_V_HEADS:]
    q = qkv[..., :DN_QK_WIDTH].reshape(b, s, DN_QK_HEADS, DN_HEAD_DIM).astype(jnp.float32)
    k = qkv[..., DN_QK_WIDTH:2 * DN_QK_WIDTH].reshape(b, s, DN_QK_HEADS, DN_HEAD_DIM).astype(jnp.float32)
    v = qkv[..., 2 * DN_QK_WIDTH:].reshape(b, s, DN_V_HEADS, DN_HEAD_DIM).astype(jnp.float32)
    q = q * lax.rsqrt(jnp.sum(q * q, axis=-1, keepdims=True) + RMS_EPS) * (DN_HEAD_DIM ** -0.5)
    k = k * lax.rsqrt(jnp.sum(k * k, axis=-1, keepdims=True) + RMS_EPS)
    rep = DN_V_HEADS // DN_QK_HEADS
    q = jnp.repeat(q, rep, axis=2)
    k = jnp.repeat(k, rep, axis=2)
    beta = jax.nn.sigmoid(bb.astype(jnp.float32))
    g = -jnp.exp(a_log.astype(jnp.float32)) * jax.nn.softplus(aa.astype(jnp.float32) + dt_bias.astype(jnp.float32))
    o = gated_delta_rule(q, k, v, g, beta)
    zf = z.reshape(b, s, DN_V_HEADS, DN_HEAD_DIM).astype(jnp.float32)
    o = (o * lax.rsqrt(jnp.mean(o * o, axis=-1, keepdims=True) + RMS_EPS)
         * norm_g.astype(jnp.float32) * jax.nn.silu(zf))
    return o.reshape(b, s, DN_V_WIDTH).astype(x.dtype) @ w_out


def setup_inputs(seed: int = 0) -> dict:
    key = jax.random.key(seed)
    ks = jax.random.split(key, 24)
    f32 = jnp.float32
    ne = (DEPTH + 1) // 2
    no = DEPTH // 2

    def nrm(k, shape, scale):
        return jax.random.normal(k, shape, f32) * scale

    dt = jnp.exp(jax.random.uniform(ks[20], (no, DN_V_HEADS), f32)
                 * (math.log(0.1) - math.log(0.001)) + math.log(0.001))
    dt = jnp.maximum(dt, 1e-4)
    return {
        'x': nrm(ks[0], (BATCH, SEQ, D_MODEL), 1.0),
        'ffn1_w_gate': nrm(ks[1], (DEPTH, D_MODEL, D_FF), D_MODEL ** -0.5),
        'ffn1_w_up': nrm(ks[2], (DEPTH, D_MODEL, D_FF), D_MODEL ** -0.5),
        'ffn1_w_down': nrm(ks[3], (DEPTH, D_FF, D_MODEL), DEEPNORM_BETA * D_FF ** -0.5),
        'ffn2_w_gate': nrm(ks[4], (DEPTH, D_MODEL, D_FF), D_MODEL ** -0.5),
        'ffn2_w_up': nrm(ks[5], (DEPTH, D_MODEL, D_FF), D_MODEL ** -0.5),
        'ffn2_w_down': nrm(ks[6], (DEPTH, D_FF, D_MODEL), DEEPNORM_BETA * D_FF ** -0.5),
        'ln_g': 1.0 + nrm(ks[7], (DEPTH, 3, D_MODEL), 0.02),
        'ln_b': nrm(ks[8], (DEPTH, 3, D_MODEL), 0.02),
        'ab_w_in': nrm(ks[9], (ne, D_MODEL, AB_IN), D_MODEL ** -0.5),
        'ab_gmlp_ln_g': 1.0 + nrm(ks[10], (ne, G_WIDTH), 0.02),
        'ab_gmlp_ln_b': nrm(ks[11], (ne, G_WIDTH), 0.02),
        'ab_gmlp_w_s': nrm(ks[12], (ne, G_GROUPS, GMLP_CHUNK, GMLP_CHUNK), 0.5 * GMLP_CHUNK ** -0.5),
        'ab_gmlp_b_s': 1.0 + nrm(ks[13], (ne, G_GROUPS, GMLP_CHUNK), 0.02),
        'ab_w_out': nrm(ks[14], (ne, AB_MIX, D_MODEL), DEEPNORM_BETA * AB_MIX ** -0.5),
        'dn_w_in': nrm(ks[15], (no, D_MODEL, DN_IN), D_MODEL ** -0.5),
        'dn_conv_w': nrm(ks[16], (no, DN_CONV, DN_CONV_DIM), DN_CONV ** -0.5),
        'dn_a_log': jnp.log(jax.random.uniform(ks[17], (no, DN_V_HEADS), f32, 1.0, 16.0)),
        'dn_dt_bias': dt + jnp.log(-jnp.expm1(-dt)),
        'dn_norm_g': 1.0 + nrm(ks[18], (no, DN_HEAD_DIM), 0.02),
        'dn_w_out': nrm(ks[19], (no, DN_V_WIDTH, D_MODEL), DEEPNORM_BETA * DN_V_WIDTH ** -0.5),
    }


def reference(x, ffn1_w_gate, ffn1_w_up, ffn1_w_down, ffn2_w_gate, ffn2_w_up, ffn2_w_down,
              ln_g, ln_b, ab_w_in, ab_gmlp_ln_g, ab_gmlp_ln_b, ab_gmlp_w_s, ab_gmlp_b_s, ab_w_out,
              dn_w_in, dn_conv_w, dn_a_log, dn_dt_bias, dn_norm_g, dn_w_out):
    for i in range(DEPTH):
        f1 = swiglu(x, ffn1_w_gate[i], ffn1_w_up[i], ffn1_w_down[i])
        x = layer_norm(DEEPNORM_ALPHA * x + 0.5 * f1, ln_g[i, 0], ln_b[i, 0])
        j = i // 2
        if i % 2 == 0:
            m = mixer_ab(x, ab_w_in[j], ab_gmlp_ln_g[j], ab_gmlp_ln_b[j], ab_gmlp_w_s[j],
                         ab_gmlp_b_s[j], ab_w_out[j])
        else:
            m = mixer_dn(x, dn_w_in[j], dn_conv_w[j], dn_a_log[j], dn_dt_bias[j], dn_norm_g[j],
                         dn_w_out[j])
        x = layer_norm(DEEPNORM_ALPHA * x + m, ln_g[i, 1], ln_b[i, 1])
        f2 = swiglu(x, ffn2_w_gate[i], ffn2_w_up[i], ffn2_w_down[i])
        x = layer_norm(DEEPNORM_ALPHA * x + 0.5 * f2, ln_g[i, 2], ln_b[i, 2])
    return x
```

```cpp
#include <hip/hip_runtime.h>
#include <hip/hip_cooperative_groups.h>
#include <cstdio>
#include <cstdint>
namespace cg = cooperative_groups;
namespace pg8 {
#define PG8_LAS __attribute__((address_space(3)))
typedef unsigned short bf16_t;
typedef short bf16x8 __attribute__((ext_vector_type(8)));
typedef float f32x4 __attribute__((ext_vector_type(4)));
typedef unsigned u32x4 __attribute__((ext_vector_type(4)));
constexpr int BM = 256, BK = 64, HALF = 128, HTB = HALF * BK * 2  , STAGE_BYTES = 8 * HTB, NXCD = 8, WGM = 8;

__host__ __device__ __forceinline__ int lds_byte(int r, int c) { const int st = (r >> 4) * 2 + (c >> 5), rr = r & 15, cc = c & 31, ob = rr * 64 + cc * 2; return st * 1024 + (ob ^ (((ob >> 9) & 1) << 5)); }
__host__ __device__ __forceinline__ void stage_rc(int b, int& R, int& C) { const int st = b / 1024, sb = b % 1024, swz = sb ^ (((sb >> 9) & 1) << 5); R = (st >> 1) * 16 + swz / 64; C = (st & 1) * 32 + (swz % 64) / 2; }
__host__ __device__ __forceinline__ int perm32(int rho) { const int n = rho >> 4, i = rho & 15; return 8 * (i >> 2) + 4 * n + (i & 3); }

struct Unit { int pm, pn; };
struct Gemm { const bf16_t* A; const bf16_t* Bt; int M, N, K; };

struct StaticOrder {
    int nM, nN, nwg, G, c;
    __host__ __device__ void init(int M, int N, int G_, int c_) { nM = M / BM; nN = N / BM; nwg = nM * nN; G = G_; c = c_; }
    __host__ __device__ bool next(int i, Unit& u) const {
        const long L = (long)i * G + c; if (L >= nwg) return false;
        int wgid = (int)L; { const int q = nwg / NXCD, r = nwg % NXCD, xcd = wgid % NXCD, off = wgid / NXCD; wgid = (xcd < r ? xcd * (q + 1) : r * (q + 1) + (xcd - r) * q) + off; }
        const int nig = WGM * nN, gid = wgid / nig, fm = gid * WGM, gsz = (nM - fm) < WGM ? (nM - fm) : WGM;
        u.pm = fm + ((wgid % nig) % gsz); u.pn = (wgid % nig) / gsz; return true;
    }
    __device__ __forceinline__ void a_ready(const Unit&) const {}
    __device__ __forceinline__ void done(const Unit&) const {}
};

__device__ __forceinline__ unsigned cvt_pk_bf16(float lo, float hi) { unsigned r; asm volatile("v_cvt_pk_bf16_f32 %0, %1, %2" : "=v"(r) : "v"(lo), "v"(hi)); return r; }
typedef float f32x2 __attribute__((ext_vector_type(2)));
typedef __bf16 bf16x2_t __attribute__((ext_vector_type(2)));
__device__ __forceinline__ unsigned pk2(float lo, float hi) { f32x2 v = {lo, hi}; bf16x2_t b = __builtin_convertvector(v, bf16x2_t); return __builtin_bit_cast(unsigned, b); }
__device__ __forceinline__ float silu_f(float g) { return g * __builtin_amdgcn_rcpf(1.0f + __expf(-g)); }

struct EpiPlain {
    static constexpr bool PERM = true, AFTER_DRAIN = false;
    bf16_t* O; int ldc;
    __device__ __forceinline__ void operator()(const f32x4 (&acc)[2][2][4][2], const Unit& u, int wr, int wc, int fr, int fq) const {
        const int row0 = u.pm * BM + wr * 64 + fr, col0 = u.pn * BM + wc * 32 + 8 * fq;
#pragma unroll
        for (int ai = 0; ai < 2; ++ai)
#pragma unroll
            for (int m = 0; m < 4; ++m) { bf16_t* rowp = O + (size_t)(row0 + ai * HALF + m * 16) * ldc + col0;
#pragma unroll
                for (int bj = 0; bj < 2; ++bj) { const f32x4 v0 = acc[ai][bj][m][0], v1 = acc[ai][bj][m][1];
                    u32x4 w; w.x = pk2(v0[0], v0[1]); w.y = pk2(v0[2], v0[3]); w.z = pk2(v1[0], v1[1]); w.w = pk2(v1[2], v1[3]);
                    *(u32x4*)(rowp + bj * HALF) = w; } }
    }
};
struct EpiDnIn {
    static constexpr bool PERM = true, AFTER_DRAIN = false;
    bf16_t* O; float* BA;
    __device__ __forceinline__ void operator()(const f32x4 (&acc)[2][2][4][2], const Unit& u, int wr, int wc, int fr, int fq) const {
        const int row0 = u.pm * BM + wr * 64 + fr;
        if (u.pn < 48) {
            bf16_t* base = O + (size_t)(u.pn >> 4) * ((size_t)8192 * 4096);
            const int col0 = (u.pn & 15) * BM + wc * 32 + 8 * fq;
#pragma unroll
            for (int ai = 0; ai < 2; ++ai)
#pragma unroll
                for (int m = 0; m < 4; ++m) { bf16_t* rowp = base + (size_t)(row0 + ai * HALF + m * 16) * 4096 + col0;
#pragma unroll
                    for (int bj = 0; bj < 2; ++bj) { const f32x4 v0 = acc[ai][bj][m][0], v1 = acc[ai][bj][m][1];
                        u32x4 w; w.x = pk2(v0[0], v0[1]); w.y = pk2(v0[2], v0[3]); w.z = pk2(v1[0], v1[1]); w.w = pk2(v1[2], v1[3]);
                        *(u32x4*)(rowp + bj * HALF) = w; } }
        } else if (wc < 2) {
            const int col0 = wc * 32 + 8 * fq;
#pragma unroll
            for (int ai = 0; ai < 2; ++ai)
#pragma unroll
                for (int m = 0; m < 4; ++m) { float* rowp = BA + (size_t)(row0 + ai * HALF + m * 16) * 64 + col0;
                    *(f32x4*)(rowp) = acc[ai][0][m][0]; *(f32x4*)(rowp + 4) = acc[ai][0][m][1]; }
        }
    }
};
struct EpiSwiGLU {
    static constexpr bool PERM = true, AFTER_DRAIN = false;
    bf16_t* O; int ldc;
    __device__ __forceinline__ void operator()(const f32x4 (&acc)[2][2][4][2], const Unit& u, int wr, int wc, int fr, int fq) const {
        const int row0 = u.pm * BM + wr * 64 + fr, col0 = u.pn * HALF + wc * 32 + 8 * fq;
#pragma unroll
        for (int ai = 0; ai < 2; ++ai)
#pragma unroll
            for (int m = 0; m < 4; ++m) { bf16_t* rowp = O + (size_t)(row0 + ai * HALF + m * 16) * ldc + col0;
                const f32x4 g0 = acc[ai][0][m][0], g1 = acc[ai][0][m][1], u0 = acc[ai][1][m][0], u1 = acc[ai][1][m][1];
                u32x4 w;
                w.x = pk2(silu_f(g0[0]) * u0[0], silu_f(g0[1]) * u0[1]); w.y = pk2(silu_f(g0[2]) * u0[2], silu_f(g0[3]) * u0[3]);
                w.z = pk2(silu_f(g1[0]) * u1[0], silu_f(g1[1]) * u1[1]); w.w = pk2(silu_f(g1[2]) * u1[2], silu_f(g1[3]) * u1[3]);
                *(u32x4*)(rowp) = w; }
    }
};
struct EpiResid {
    static constexpr bool PERM = false, AFTER_DRAIN = false;
    const float* resid; float* out; int ldc; float alpha, scale;
    __device__ __forceinline__ void operator()(const f32x4 (&acc)[2][2][4][2], const Unit& u, int wr, int wc, int fr, int fq) const {
        const int col0 = u.pn * BM + wc * 32 + 4 * fq;
#pragma unroll
        for (int ai = 0; ai < 2; ++ai)
#pragma unroll
            for (int m = 0; m < 4; ++m) { const size_t off = (size_t)(u.pm * BM + ai * HALF + wr * 64 + m * 16 + fr) * ldc + col0;
                f32x4 rv[2][2];
#pragma unroll
                for (int bj = 0; bj < 2; ++bj)
#pragma unroll
                    for (int n = 0; n < 2; ++n) rv[bj][n] = *(const f32x4*)(resid + off + bj * HALF + n * 16);
#pragma unroll
                for (int bj = 0; bj < 2; ++bj)
#pragma unroll
                    for (int n = 0; n < 2; ++n) *(f32x4*)(out + off + bj * HALF + n * 16) = rv[bj][n] * alpha + acc[ai][bj][m][n] * scale;
                asm volatile("" ::: "memory"); }
    }
};
template <class Epi, class Sched, bool ALIGN_EPI = false, bool SP2 = false>
__device__ __forceinline__ void gemm_phase(PG8_LAS unsigned char* lds, const Gemm g, const Sched& S, const Epi& E) {
    const int tid = threadIdx.x, wid = __builtin_amdgcn_readfirstlane(tid >> 6), lane = tid & 63, wr = wid >> 2, wc = wid & 3, fr = lane & 15, fq = lane >> 4;
    const int K = g.K, nt = K / BK;
    unsigned voffA[2], voffB[2];
#pragma unroll
    for (int i = 0; i < 2; ++i) { int R, C; stage_rc(tid * 16 + i * 8192, R, C); const int Rb = Epi::PERM ? ((R & ~31) + perm32(R & 31)) : R;
        voffA[i] = (unsigned)(R * K + C) * 2u; voffB[i] = (unsigned)(Rb * K + C) * 2u; }
    const size_t kstep = (size_t)(BK * 2);
    const size_t hstep = (size_t)HALF * K * 2;
    const size_t tstep = 2 * hstep;
    const unsigned ldsw = (unsigned)wid * 1024u;
    const int aoff = lds_byte(wr * 64 + fr, fq * 8), boff = lds_byte(wc * 32 + fr, fq * 8);
#define PG8_SA(b, h) (((b) * 2 + (h)) * HTB)
#define PG8_SB(b, h) ((4 + (b) * 2 + (h)) * HTB)
#define PG8_STAGE(bufoff, gbase, voff) do { _Pragma("unroll") for (int _i = 0; _i < 2; ++_i) \
        __builtin_amdgcn_global_load_lds((const unsigned*)((const char*)(gbase) + (voff)[_i]), (PG8_LAS unsigned*)(lds + (bufoff) + ldsw + _i * 8192), 16, 0, 0); } while (0)
#define PG8_LDA(dst, b, h) do { _Pragma("unroll") for (int m = 0; m < 4; ++m) _Pragma("unroll") for (int k = 0; k < 2; ++k) dst[m][k] = *(const PG8_LAS bf16x8*)(lds + PG8_SA(b, h) + aoff + m * 2048 + k * 1024); } while (0)
#define PG8_LDB(dst, b, h) do { _Pragma("unroll") for (int n = 0; n < 2; ++n) _Pragma("unroll") for (int k = 0; k < 2; ++k) dst[n][k] = *(const PG8_LAS bf16x8*)(lds + PG8_SB(b, h) + boff + n * 2048 + k * 1024); } while (0)
#define PG8_MMA(ai, bj, At, Bt) do { __builtin_amdgcn_s_setprio(1); _Pragma("unroll") for (int m = 0; m < 4; ++m) _Pragma("unroll") for (int n = 0; n < 2; ++n) _Pragma("unroll") for (int k = 0; k < 2; ++k) \
        acc[ai][bj][m][n] = __builtin_amdgcn_mfma_f32_16x16x32_bf16(Bt[n][k], At[m][k], acc[ai][bj][m][n], 0, 0, 0); __builtin_amdgcn_s_setprio(0); } while (0)
#define PG8_WAIT_V(n) asm volatile("s_waitcnt vmcnt(" #n ")" ::: "memory")
#define PG8_WAIT_L(n) asm volatile("s_waitcnt lgkmcnt(" #n ")" ::: "memory")
#define PG8_BAR __builtin_amdgcn_s_barrier()
#define PG8_SCHED __builtin_amdgcn_sched_barrier(0)
    Unit cur, nxt; int ui = 0;
    if (!S.next(0, cur)) return;
    f32x4 acc[2][2][4][2];
#pragma unroll
    for (int a = 0; a < 2; ++a)
#pragma unroll
        for (int b = 0; b < 2; ++b)
#pragma unroll
            for (int m = 0; m < 4; ++m)
#pragma unroll
                for (int n = 0; n < 2; ++n) acc[a][b][m][n] = (f32x4){0.f, 0.f, 0.f, 0.f};
    bf16x8 At[4][2], B0[2][2], B1[2][2];
    const char* cA = (const char*)g.A + (size_t)cur.pm * tstep; const char* cB = (const char*)g.Bt + (size_t)cur.pn * tstep;
    S.a_ready(cur);
    if constexpr (SP2) {
        PG8_STAGE(PG8_SB(0, 0), cB, voffB); PG8_STAGE(PG8_SB(0, 1), cB + hstep, voffB); PG8_STAGE(PG8_SA(0, 0), cA, voffA); PG8_STAGE(PG8_SA(0, 1), cA + hstep, voffA);
        if (wr == 1) PG8_BAR;
        PG8_WAIT_V(2); PG8_BAR;
        PG8_STAGE(PG8_SB(1, 0), cB + kstep, voffB); PG8_STAGE(PG8_SA(1, 0), cA + kstep, voffA); PG8_STAGE(PG8_SB(1, 1), cB + hstep + kstep, voffB);
        PG8_WAIT_V(6); PG8_BAR;
    } else {
        PG8_STAGE(PG8_SB(0, 0), cB, voffB); PG8_STAGE(PG8_SA(0, 0), cA, voffA); PG8_STAGE(PG8_SB(0, 1), cB + hstep, voffB); PG8_STAGE(PG8_SA(0, 1), cA + hstep, voffA);
        if (wr == 1) PG8_BAR;
        PG8_WAIT_V(4); PG8_BAR;
        PG8_STAGE(PG8_SB(1, 0), cB + kstep, voffB); PG8_STAGE(PG8_SA(1, 0), cA + kstep, voffA); PG8_STAGE(PG8_SB(1, 1), cB + hstep + kstep, voffB);
        PG8_WAIT_V(6); PG8_BAR;
    }
    for (;;) {
        const bool has_next = S.next(ui + 1, nxt);
        const char* nA = has_next ? (const char*)g.A + (size_t)nxt.pm * tstep : cA; const char* nB = has_next ? (const char*)g.Bt + (size_t)nxt.pn * tstep : cB;
        for (int t = 0; t < nt; t += 2) {
            const bool last = (t == nt - 2);
            const char* a1 = cA + (size_t)(t + 1) * kstep;
            const char* a2 = last ? nA : cA + (size_t)(t + 2) * kstep; const char* b2 = last ? nB : cB + (size_t)(t + 2) * kstep;
            const char* a3 = a2 + kstep; const char* b3 = b2 + kstep;
            if (last && has_next) S.a_ready(nxt);
            if constexpr (SP2) {
            PG8_LDB(B0, 0, 0); PG8_LDB(B1, 0, 1); PG8_SCHED; PG8_LDA(At, 0, 0); PG8_STAGE(PG8_SA(1, 1), a1 + hstep, voffA);
            PG8_WAIT_V(8); PG8_WAIT_L(0); PG8_BAR; PG8_MMA(0, 0, At, B0); PG8_MMA(0, 1, At, B1); PG8_BAR; PG8_SCHED;
            PG8_LDA(At, 0, 1); PG8_STAGE(PG8_SB(0, 0), b2, voffB); PG8_STAGE(PG8_SB(0, 1), b2 + hstep, voffB); PG8_STAGE(PG8_SA(0, 0), a2, voffA);
            PG8_WAIT_V(8); PG8_WAIT_L(0); PG8_BAR; PG8_MMA(1, 0, At, B0); PG8_MMA(1, 1, At, B1); PG8_BAR; PG8_SCHED;
            PG8_LDB(B0, 1, 0); PG8_LDB(B1, 1, 1); PG8_SCHED; PG8_LDA(At, 1, 0); PG8_STAGE(PG8_SA(0, 1), a2 + hstep, voffA);
            PG8_WAIT_V(8); PG8_WAIT_L(0); PG8_BAR; PG8_MMA(0, 0, At, B0); PG8_MMA(0, 1, At, B1); PG8_BAR; PG8_SCHED;
            PG8_LDA(At, 1, 1); PG8_STAGE(PG8_SB(1, 0), b3, voffB); PG8_STAGE(PG8_SB(1, 1), b3 + hstep, voffB); PG8_STAGE(PG8_SA(1, 0), a3, voffA);
            PG8_WAIT_V(8); PG8_WAIT_L(0); PG8_BAR; PG8_MMA(1, 0, At, B0); PG8_MMA(1, 1, At, B1); PG8_BAR; PG8_SCHED;
            } else {
            PG8_LDB(B0, 0, 0); PG8_SCHED; PG8_LDA(At, 0, 0); PG8_STAGE(PG8_SA(1, 1), a1 + hstep, voffA);
            PG8_WAIT_L(8); PG8_BAR; PG8_WAIT_L(0); PG8_MMA(0, 0, At, B0); PG8_BAR; PG8_SCHED;
            PG8_LDB(B1, 0, 1); PG8_STAGE(PG8_SB(0, 0), b2, voffB);
            PG8_BAR; PG8_WAIT_L(0); PG8_MMA(0, 1, At, B1); PG8_BAR;
            PG8_LDA(At, 0, 1); PG8_STAGE(PG8_SA(0, 0), a2, voffA);
            PG8_BAR; PG8_WAIT_L(0); PG8_MMA(1, 0, At, B0); PG8_BAR; PG8_SCHED;
            PG8_STAGE(PG8_SB(0, 1), b2 + hstep, voffB);
            PG8_WAIT_V(6); PG8_BAR; PG8_MMA(1, 1, At, B1); PG8_BAR;
            PG8_LDB(B0, 1, 0); PG8_SCHED; PG8_LDA(At, 1, 0); PG8_STAGE(PG8_SA(0, 1), a2 + hstep, voffA);
            PG8_WAIT_L(8); PG8_BAR; PG8_WAIT_L(0); PG8_MMA(0, 0, At, B0); PG8_BAR; PG8_SCHED;
            PG8_LDB(B1, 1, 1); PG8_STAGE(PG8_SB(1, 0), b3, voffB);
            PG8_BAR; PG8_WAIT_L(0); PG8_MMA(0, 1, At, B1); PG8_BAR;
            PG8_LDA(At, 1, 1); PG8_STAGE(PG8_SA(1, 0), a3, voffA);
            PG8_BAR; PG8_WAIT_L(0); PG8_MMA(1, 0, At, B0); PG8_BAR; PG8_SCHED;
            PG8_STAGE(PG8_SB(1, 1), b3 + hstep, voffB);
            PG8_WAIT_V(6); PG8_BAR; PG8_MMA(1, 1, At, B1); PG8_BAR;
            }
        }
        if constexpr (ALIGN_EPI) { if (wr == 0) PG8_BAR; }
        if constexpr (!Epi::AFTER_DRAIN) { E(acc, cur, wr, wc, fr, fq); S.done(cur); }
        if (!has_next) break;
#pragma unroll
        for (int a = 0; a < 2; ++a)
#pragma unroll
            for (int b = 0; b < 2; ++b)
#pragma unroll
                for (int m = 0; m < 4; ++m)
#pragma unroll
                    for (int n = 0; n < 2; ++n) acc[a][b][m][n] = (f32x4){0.f, 0.f, 0.f, 0.f};
        cur = nxt; cA = nA; cB = nB; ++ui;
        if constexpr (ALIGN_EPI) { if (wr == 1) PG8_BAR; }
    }
    PG8_WAIT_V(0);
    if constexpr (!ALIGN_EPI) { if (wr == 0) PG8_BAR; }
    PG8_BAR;
    if constexpr (Epi::AFTER_DRAIN) { E.fused(acc, cur, wr, wc, fr, fq, lds, wid, lane); S.done(cur); }
#undef PG8_SA
#undef PG8_SB
#undef PG8_STAGE
#undef PG8_LDA
#undef PG8_LDB
#undef PG8_MMA
#undef PG8_WAIT_V
#undef PG8_WAIT_L
#undef PG8_BAR
#undef PG8_SCHED
}
}
#define LAS __attribute__((address_space(3)))
#define DI __device__ __forceinline__
typedef unsigned short bf16_t;
typedef short bf16x8 __attribute__((ext_vector_type(8)));
typedef float f32x4 __attribute__((ext_vector_type(4)));
typedef float f32x16 __attribute__((ext_vector_type(16)));
typedef unsigned u32x4 __attribute__((ext_vector_type(4)));
typedef unsigned u32x2 __attribute__((ext_vector_type(2)));
using pg8::pk2;

constexpr int NWAVES = 8, NTHREADS = 512;
constexpr int D = 2048, BATCH = 4, SEQ = 2048, M = BATCH * SEQ, DFF = 5632;
constexpr int AB_IN = 5120, DN_IN = 12352, DN_IN_PAD = 12544;
constexpr float ALPHA = 1.41421356237f;
constexpr float LN_EPS = 1e-5f, RMS_EPS = 1e-6f;
constexpr size_t MiB = (size_t)1 << 20;
constexpr size_t WS_L0 = 0;
constexpr size_t WS_WGU1_0 = 0, WS_WD1_0 = 44 * MiB, WS_WGU2_0 = 66 * MiB, WS_WD2_0 = 110 * MiB, WS_WABIN = 132 * MiB, WS_WABOUT = 152 * MiB;
constexpr size_t WS_WGU1_1 = 160 * MiB, WS_WD1_1 = 204 * MiB, WS_WGU2_1 = 226 * MiB, WS_WD2_1 = 270 * MiB, WS_WDNIN = 292 * MiB, WS_WDNOUT = 341 * MiB;
constexpr size_t WS_XB = 357 * MiB;
constexpr size_t WS_BIG = 389 * MiB;
constexpr size_t WS_BA = WS_BIG + 192 * MiB;
constexpr size_t WS_DNX = 585 * MiB;
constexpr size_t WS_QR = WS_DNX, WS_KR = WS_DNX + 16 * MiB, WS_VT = WS_DNX + 32 * MiB, WS_CAT = WS_DNX + 48 * MiB, WS_KMEAN = WS_DNX + 80 * MiB;
constexpr size_t WS_QN = WS_DNX, WS_KN = WS_DNX + 32 * MiB, WS_V = WS_DNX + 64 * MiB, WS_G = WS_DNX + 128 * MiB, WS_BETA = WS_DNX + 129 * MiB;
constexpr size_t WS_OG = WS_L0;
constexpr size_t WS_END = 715 * MiB;
constexpr int LDS_BYTES = 147456;

DI float bflo(unsigned u) { return __uint_as_float(u << 16); }
DI float bfhi(unsigned u) { return __uint_as_float(u & 0xffff0000u); }
DI float bf2f(bf16_t h) { return __uint_as_float((unsigned)h << 16); }
DI bf16_t f2bf(float f) { return (bf16_t)(pk2(f, 0.f) & 0xffffu); }
DI float wave_sum(float v) {
#pragma unroll
    for (int o = 1; o < 64; o <<= 1) v += __shfl_xor(v, o);
    return v;
}
DI float gelu_tanh(float x) { const float t = 1.5957691216f * (x + 0.044715f * x * x * x); return x * __builtin_amdgcn_rcpf(1.0f + __expf(-t)); }
DI int crow(int r, int h) { return (r & 3) + 8 * (r >> 2) + 4 * h; }
#define MFMA32(a, b, c) __builtin_amdgcn_mfma_f32_32x32x16_bf16((a), (b), (c), 0, 0, 0)
DI bf16x8 pack8(float a0, float a1, float a2, float a3, float a4, float a5, float a6, float a7) {
    u32x4 p; p.x = pk2(a0, a1); p.y = pk2(a2, a3); p.z = pk2(a4, a5); p.w = pk2(a6, a7); return __builtin_bit_cast(bf16x8, p);
}

DI void tr_tile(const float* __restrict__ W, int K, int N, bf16_t* __restrict__ WT, int k0, int n0, int drow0, LAS float* scr, int lane) {
#pragma unroll 4
    for (int i = 0; i < 16; ++i) { const int kk = 4 * i + (lane >> 4), c4 = (lane & 15) * 4;
        const f32x4 v = *(const f32x4*)(W + (size_t)(k0 + kk) * N + n0 + c4);
        LAS float* s = scr + kk * 65 + c4; s[0] = v.x; s[1] = v.y; s[2] = v.z; s[3] = v.w; }
    asm volatile("s_waitcnt lgkmcnt(0)" ::: "memory");
    const int c = lane & 7;
#pragma unroll
    for (int j = 0; j < 8; ++j) { const int n = (lane >> 3) + 8 * j; const LAS float* s = scr + (8 * c) * 65 + n;
        u32x4 o; o.x = pk2(s[0], s[65]); o.y = pk2(s[2 * 65], s[3 * 65]); o.z = pk2(s[4 * 65], s[5 * 65]); o.w = pk2(s[6 * 65], s[7 * 65]);
        *(u32x4*)(WT + (size_t)(drow0 + n) * K + k0 + 8 * c) = o; }
    asm volatile("s_waitcnt lgkmcnt(0)" ::: "memory");
}
DI void tr_matrix(const float* W, int K, int N, bf16_t* WT, int mode, LAS float* scr, int gw, int ngw, int lane) {
    const int nb = N / 64, items = (K / 64) * nb;
    for (int it = gw; it < items; it += ngw) {
        const int kb = it / nb, n0 = (it % nb) * 64;
        const int drow0 = mode == 0 ? n0 : ((n0 >> 7) * 256 + (n0 & 127) + (mode == 2 ? 128 : 0));
        tr_tile(W, K, N, WT, kb * 64, n0, drow0, scr, lane);
    }
}

struct Args { const float* in[21]; float* out; unsigned char* ws; int ph_lo, ph_hi; };

DI void p0_prologue(const Args& a, LAS unsigned char* lds, int wave, int lane) {
    LAS float* scr = (LAS float*)(lds + wave * 17408);
    const int gw = blockIdx.x * NWAVES + wave, ngw = gridDim.x * NWAVES;
    unsigned char* ws = a.ws;
    const size_t WGU = (size_t)D * DFF;
    for (int l = 0; l < 2; ++l) {
        bf16_t* gu1 = (bf16_t*)(ws + (l ? WS_WGU1_1 : WS_WGU1_0)); bf16_t* d1 = (bf16_t*)(ws + (l ? WS_WD1_1 : WS_WD1_0));
        bf16_t* gu2 = (bf16_t*)(ws + (l ? WS_WGU2_1 : WS_WGU2_0)); bf16_t* d2 = (bf16_t*)(ws + (l ? WS_WD2_1 : WS_WD2_0));
        tr_matrix(a.in[1] + l * WGU, D, DFF, gu1, 1, scr, gw, ngw, lane);
        tr_matrix(a.in[2] + l * WGU, D, DFF, gu1, 2, scr, gw, ngw, lane);
        tr_matrix(a.in[3] + l * WGU, DFF, D, d1, 0, scr, gw, ngw, lane);
        tr_matrix(a.in[4] + l * WGU, D, DFF, gu2, 1, scr, gw, ngw, lane);
        tr_matrix(a.in[5] + l * WGU, D, DFF, gu2, 2, scr, gw, ngw, lane);
        tr_matrix(a.in[6] + l * WGU, DFF, D, d2, 0, scr, gw, ngw, lane);
    }
    tr_matrix(a.in[9], D, AB_IN, (bf16_t*)(ws + WS_WABIN), 0, scr, gw, ngw, lane);
    tr_matrix(a.in[14], D, D, (bf16_t*)(ws + WS_WABOUT), 0, scr, gw, ngw, lane);
    tr_matrix(a.in[15], D, DN_IN, (bf16_t*)(ws + WS_WDNIN), 0, scr, gw, ngw, lane);
    tr_matrix(a.in[20], 4096, D, (bf16_t*)(ws + WS_WDNOUT), 0, scr, gw, ngw, lane);
    { u32x4* p = (u32x4*)((bf16_t*)(ws + WS_WDNIN) + (size_t)DN_IN * D); const int n16 = (DN_IN_PAD - DN_IN) * D / 8;
      for (int i = blockIdx.x * NTHREADS + threadIdx.x; i < n16; i += gridDim.x * NTHREADS) p[i] = (u32x4){0u, 0u, 0u, 0u}; }
    { const f32x4* x4 = (const f32x4*)a.in[0]; u32x2* xb = (u32x2*)(ws + WS_XB); const int n4 = M * D / 4;
      for (int i = blockIdx.x * NTHREADS + threadIdx.x; i < n4; i += gridDim.x * NTHREADS) { const f32x4 v = x4[i]; xb[i] = (u32x2){pk2(v.x, v.y), pk2(v.z, v.w)}; } }
}

DI void ln_phase(float* Y, bf16_t* XB, const float* g, const float* b, int wave, int lane) {
    const int gw = blockIdx.x * NWAVES + wave, ngw = gridDim.x * NWAVES;
    for (int m = gw; m < M; m += ngw) {
        f32x4* yr = (f32x4*)(Y + (size_t)m * D) + lane;
        f32x4 v[8]; float s = 0.f;
#pragma unroll
        for (int j = 0; j < 8; ++j) { v[j] = yr[64 * j]; s += (v[j].x + v[j].y) + (v[j].z + v[j].w); }
        const float mean = wave_sum(s) * (1.f / D); float s2 = 0.f;
#pragma unroll
        for (int j = 0; j < 8; ++j) { v[j] = v[j] - mean; s2 += (v[j].x * v[j].x + v[j].y * v[j].y) + (v[j].z * v[j].z + v[j].w * v[j].w); }
        const float rstd = rsqrtf(wave_sum(s2) * (1.f / D) + LN_EPS);
        u32x2* o8 = (u32x2*)(XB + (size_t)m * D) + lane;
#pragma unroll
        for (int j = 0; j < 8; ++j) { const f32x4 gg = ((const f32x4*)g)[lane + 64 * j], bb = ((const f32x4*)b)[lane + 64 * j];
            const f32x4 o = v[j] * rstd * gg + bb; yr[64 * j] = o; o8[64 * j] = (u32x2){pk2(o.x, o.y), pk2(o.z, o.w)}; }
    }
}

DI void rope_item(const bf16_t* HC, bf16_t* Qr, bf16_t* Kr, bf16_t* Vt, float* kmean, int item, LAS float* red, int tid) {
    const int h = item & 7, blk = (item >> 3) & 7, b = item >> 6, bh = b * 8 + h;
    const int i = tid & 63, rg = tid >> 6;
    const float inv = expf((-9.210340371976184f * (float)i) * 0.015625f);
    float ks0 = 0.f, ks1 = 0.f;
    for (int rr = 0; rr < 32; ++rr) {
        const int pos = blk * 256 + rr * 8 + rg; const size_t row = (size_t)b * SEQ + pos;
        float sn, cs; sincosf((float)pos * inv, &sn, &cs);
        const bf16_t* hp = HC + row * AB_IN + h * 128 + i;
        const float q1 = bf2f(hp[0]), q2 = bf2f(hp[64]), k1 = bf2f(hp[1024]), k2 = bf2f(hp[1024 + 64]);
        const bf16_t v1 = hp[2048], v2 = hp[2048 + 64];
        const float qa = (q1 * cs - q2 * sn) * 0.08838834764831845f, qb = (q2 * cs + q1 * sn) * 0.08838834764831845f;
        const float ka = k1 * cs - k2 * sn, kb = k2 * cs + k1 * sn;
        const size_t o = ((size_t)bh * SEQ + pos) * 128 + i;
        Qr[o] = f2bf(qa); Qr[o + 64] = f2bf(qb); Kr[o] = f2bf(ka); Kr[o + 64] = f2bf(kb);
        ks0 += ka; ks1 += kb;
        Vt[((size_t)bh * 128 + i) * SEQ + pos] = v1; Vt[((size_t)bh * 128 + i + 64) * SEQ + pos] = v2;
    }
    red[rg * 128 + i] = ks0; red[rg * 128 + 64 + i] = ks1;
    __syncthreads();
    if (tid < 128) { float s = 0.f;
#pragma unroll
        for (int g = 0; g < 8; ++g) s += red[g * 128 + tid];
        kmean[((size_t)bh * 8 + blk) * 128 + tid] = s * (1.f / 256.f); }
    __syncthreads();
}

DI void gmlp_item(const bf16_t* HC, const float* lng, const float* lnb, const float* w_s, const float* b_s, bf16_t* CAT, int item, LAS unsigned char* lds, int wave, int lane) {
    const int g = item & 7, c = (item >> 3) & 15, b = item >> 7;
    const size_t row0 = (size_t)b * SEQ + c * 128;
    LAS bf16_t* vnT = (LAS bf16_t*)lds;
    { const float g0 = lng[g * 128 + 2 * lane], g1 = lng[g * 128 + 2 * lane + 1], b0 = lnb[g * 128 + 2 * lane], b1 = lnb[g * 128 + 2 * lane + 1];
      for (int ss = 0; ss < 16; ++ss) { const int s = wave * 16 + ss;
        const unsigned raw = *(const unsigned*)(HC + (row0 + s) * AB_IN + 4096 + g * 128 + 2 * lane);
        const float v0 = gelu_tanh(bflo(raw)), v1 = gelu_tanh(bfhi(raw));
        const float mu = wave_sum(v0 + v1) * (1.f / 128.f); const float d0 = v0 - mu, d1 = v1 - mu;
        const float rstd = rsqrtf(wave_sum(d0 * d0 + d1 * d1) * (1.f / 128.f) + LN_EPS);
        vnT[(2 * lane) * 136 + s] = f2bf(d0 * rstd * g0 + b0); vnT[(2 * lane + 1) * 136 + s] = f2bf(d1 * rstd * g1 + b1); } }
    __syncthreads();
    const int tt = wave >> 1, dh = wave & 1, r32 = lane & 31, hi = lane >> 5;
    f32x16 acc[2];
#pragma unroll
    for (int j = 0; j < 2; ++j)
#pragma unroll
        for (int r = 0; r < 16; ++r) acc[j][r] = 0.f;
    const int t = 32 * tt + r32; const float* wrow = w_s + ((size_t)g * 128 + t) * 128;
    for (int st = 0; st < 2 * (tt + 1); ++st) { const int s0 = 16 * st + 8 * hi;
        const f32x4 w0 = *(const f32x4*)(wrow + s0), w1 = *(const f32x4*)(wrow + s0 + 4);
        const bf16x8 a = pack8(s0 + 0 <= t ? w0.x : 0.f, s0 + 1 <= t ? w0.y : 0.f, s0 + 2 <= t ? w0.z : 0.f, s0 + 3 <= t ? w0.w : 0.f,
                               s0 + 4 <= t ? w1.x : 0.f, s0 + 5 <= t ? w1.y : 0.f, s0 + 6 <= t ? w1.z : 0.f, s0 + 7 <= t ? w1.w : 0.f);
#pragma unroll
        for (int j = 0; j < 2; ++j) { const bf16x8 bv = *(const LAS bf16x8*)(vnT + (32 * (2 * dh + j) + r32) * 136 + s0); acc[j] = MFMA32(a, bv, acc[j]); } }
#pragma unroll
    for (int j = 0; j < 2; ++j) { const int d = 32 * (2 * dh + j) + r32;
#pragma unroll
        for (int r = 0; r < 16; ++r) { const int tq = 32 * tt + crow(r, hi); const size_t row = row0 + tq;
            const float uval = gelu_tanh(bf2f(HC[row * AB_IN + 3072 + g * 128 + d]));
            CAT[row * D + 1024 + g * 128 + d] = f2bf(uval * (acc[j][r] + b_s[g * 128 + tq])); } }
    __syncthreads();
}

DI void moba_wave(const bf16_t* Qr, const bf16_t* Kr, const bf16_t* Vt, const float* kmean, bf16_t* CAT, int bh, int qt, int lane) {
    const int qi = lane & 31, hi = lane >> 5, q0 = qt * 32, own = q0 >> 8, pos = q0 + qi, b = bh >> 3, h = bh & 7;
    bf16x8 qf[8];
    { const bf16_t* qp = Qr + ((size_t)bh * SEQ + pos) * 128 + 8 * hi;
#pragma unroll
      for (int st = 0; st < 8; ++st) qf[st] = *(const bf16x8*)(qp + 16 * st); }
    unsigned selmask = 0u;
    if (own > 0) {
        f32x16 ga;
#pragma unroll
        for (int r = 0; r < 16; ++r) ga[r] = 0.f;
#pragma unroll
        for (int st = 0; st < 8; ++st) { bf16x8 a = (bf16x8){0, 0, 0, 0, 0, 0, 0, 0};
            if (qi < 8) { const float* kp = kmean + ((size_t)bh * 8 + qi) * 128 + 16 * st + 8 * hi; const f32x4 k0 = *(const f32x4*)kp, k1 = *(const f32x4*)(kp + 4);
                a = pack8(k0.x, k0.y, k0.z, k0.w, k1.x, k1.y, k1.z, k1.w); }
            ga = MFMA32(a, qf[st], ga); }
        float g[8];
#pragma unroll
        for (int r = 0; r < 4; ++r) { const float mine = ga[r], other = __shfl_xor(mine, 32); g[r] = hi ? other : mine; g[4 + r] = hi ? mine : other; }
        const int nsel = own < 3 ? own : 3;
#pragma unroll
        for (int j = 0; j < 8; ++j) { int rank = 0;
#pragma unroll
            for (int i2 = 0; i2 < 8; ++i2) if (i2 != j) rank += (i2 < own && (g[i2] > g[j] || (g[i2] == g[j] && i2 < j))) ? 1 : 0;
            if (j < own && rank < nsel) selmask |= 1u << j; }
    }
    f32x16 o[4];
#pragma unroll
    for (int dt = 0; dt < 4; ++dt)
#pragma unroll
        for (int r = 0; r < 16; ++r) o[dt][r] = 0.f;
    float mrun = -INFINITY, lrun = 0.f;
    for (int j = 0; j <= own; ++j) {
        const bool act = (j == own) || ((selmask >> j) & 1u);
        if (__ballot(act) == 0ull) continue;
        const int nkt = (j == own) ? ((q0 & 255) >> 5) + 1 : 8;
        for (int kt = 0; kt < nkt; ++kt) {
            const int key0 = j * 256 + kt * 32;
            f32x16 s;
#pragma unroll
            for (int r = 0; r < 16; ++r) s[r] = 0.f;
            const bf16_t* kp = Kr + ((size_t)bh * SEQ + key0 + qi) * 128 + 8 * hi;
#pragma unroll
            for (int st = 0; st < 8; ++st) s = MFMA32(*(const bf16x8*)(kp + 16 * st), qf[st], s);
            float mt = -INFINITY;
#pragma unroll
            for (int r = 0; r < 16; ++r) { const int key = key0 + crow(r, hi); const bool ok = act && (j < own || key <= pos); s[r] = ok ? s[r] : -INFINITY; mt = fmaxf(mt, s[r]); }
            mt = fmaxf(mt, __shfl_xor(mt, 32));
            const float mnew = fmaxf(mrun, mt), muse = (mnew == -INFINITY) ? 0.f : mnew;
            const float alpha = __expf(mrun - muse);
            float ls = 0.f;
#pragma unroll
            for (int r = 0; r < 16; ++r) { s[r] = __expf(s[r] - muse); ls += s[r]; }
            lrun = lrun * alpha + ls; mrun = mnew;
#pragma unroll
            for (int dt = 0; dt < 4; ++dt)
#pragma unroll
                for (int r = 0; r < 16; ++r) o[dt][r] *= alpha;
#pragma unroll
            for (int sp = 0; sp < 2; ++sp) {
                const bf16x8 pb = pack8(s[8 * sp], s[8 * sp + 1], s[8 * sp + 2], s[8 * sp + 3], s[8 * sp + 4], s[8 * sp + 5], s[8 * sp + 6], s[8 * sp + 7]);
#pragma unroll
                for (int dt = 0; dt < 4; ++dt) { const bf16_t* vp = Vt + ((size_t)bh * 128 + 32 * dt + qi) * SEQ + key0 + 16 * sp + 4 * hi;
                    const u32x2 lo = *(const u32x2*)vp, hh = *(const u32x2*)(vp + 8);
                    const bf16x8 a = __builtin_bit_cast(bf16x8, (u32x4){lo.x, lo.y, hh.x, hh.y});
                    o[dt] = MFMA32(a, pb, o[dt]); }
            }
        }
    }
    const float ltot = lrun + __shfl_xor(lrun, 32), inv = 1.0f / ltot;
    bf16_t* op = CAT + ((size_t)b * SEQ + pos) * D + h * 128;
#pragma unroll
    for (int dt = 0; dt < 4; ++dt)
#pragma unroll
        for (int g4 = 0; g4 < 4; ++g4) { const int d = 32 * dt + 8 * g4 + 4 * hi;
            *(u32x2*)(op + d) = (u32x2){pk2(o[dt][4 * g4] * inv, o[dt][4 * g4 + 1] * inv), pk2(o[dt][4 * g4 + 2] * inv, o[dt][4 * g4 + 3] * inv)}; }
}

DI void dnp_phase(const bf16_t* QKraw, const bf16_t* Vraw, const float* BA, const float* conv_w, const float* a_log, const float* dt_bias,
                  bf16_t* QN, bf16_t* KN, bf16_t* V, float* G, float* BETA, int wave, int lane) {
    const int gw = blockIdx.x * NWAVES + wave, ngw = gridDim.x * NWAVES;
    for (int it = gw; it < BATCH * 64 * 32; it += ngw) {
        const int rc = it & 31, hs = (it >> 5) & 63, b = it >> 11;
        const int ch = hs * 128 + 2 * lane;
        float w0[4], w1[4];
#pragma unroll
        for (int j = 0; j < 4; ++j) { w0[j] = conv_w[j * 8192 + ch]; w1[j] = conv_w[j * 8192 + ch + 1]; }
        const bf16_t* src = hs < 32 ? QKraw + ch : Vraw + (ch - 4096);
        const int t0 = rc * 64;
        float x0[3], x1[3];
#pragma unroll
        for (int j = 0; j < 3; ++j) { const int t = t0 - 3 + j; unsigned raw = 0u; if (t >= 0) raw = *(const unsigned*)(src + ((size_t)b * SEQ + t) * 4096); x0[j] = bflo(raw); x1[j] = bfhi(raw); }
        for (int tt = 0; tt < 64; ++tt) { const size_t row = (size_t)b * SEQ + t0 + tt;
            const unsigned raw = *(const unsigned*)(src + row * 4096); const float c0 = bflo(raw), c1 = bfhi(raw);
            float y0 = x0[0] * w0[0] + x0[1] * w0[1] + x0[2] * w0[2] + c0 * w0[3];
            float y1 = x1[0] * w1[0] + x1[1] * w1[1] + x1[2] * w1[2] + c1 * w1[3];
            x0[0] = x0[1]; x0[1] = x0[2]; x0[2] = c0; x1[0] = x1[1]; x1[1] = x1[2]; x1[2] = c1;
            y0 = pg8::silu_f(y0); y1 = pg8::silu_f(y1);
            if (hs < 32) { const float ss = wave_sum(y0 * y0 + y1 * y1); const float sc = rsqrtf(ss + RMS_EPS) * (hs < 16 ? 0.08838834764831845f : 1.0f);
                bf16_t* dst = (hs < 16 ? QN + row * 2048 + ch : KN + row * 2048 + (ch - 2048)); *(unsigned*)dst = pk2(y0 * sc, y1 * sc); }
            else *(unsigned*)(V + row * 4096 + (ch - 4096)) = pk2(y0, y1);
        }
    }
    for (int i = blockIdx.x * NTHREADS + threadIdx.x; i < M * 32; i += gridDim.x * NTHREADS) { const int row = i >> 5, h = i & 31;
        const float bb = BA[(size_t)row * 64 + h], aa = BA[(size_t)row * 64 + 32 + h];
        BETA[i] = 1.0f / (1.0f + expf(-bb));
        const float x = aa + dt_bias[h]; const float sp = x > 20.f ? x : log1pf(expf(x));
        G[i] = -expf(a_log[h]) * sp; }
}

DI void dn_scan_item(const bf16_t* QN, const bf16_t* KN, const bf16_t* V, const float* G, const float* BETA, bf16_t* OG, int item, LAS float* lds, int tid) {
    const int b = item >> 5, hv = item & 31, hk = hv >> 1;
    const int v = tid & 127, kg = tid >> 7;
    LAS float* kq = lds;
    LAS float* red = lds + 512;
    LAS float* red2 = lds + 1024;
    float S[32];
#pragma unroll
    for (int i = 0; i < 32; ++i) S[i] = 0.f;
    const size_t rowb = (size_t)b * SEQ;
    float nkq = (tid < 256) ? bf2f((tid < 128 ? KN : QN)[rowb * 2048 + hk * 128 + (tid & 127)]) : 0.f;
    float nvv = bf2f(V[rowb * 4096 + hv * 128 + v]); float ng = G[rowb * 32 + hv], nbeta = BETA[rowb * 32 + hv];
    for (int t = 0; t < SEQ; ++t) {
        const size_t row = rowb + t;
        LAS float* kqb = kq + (t & 1) * 256;
        if (tid < 256) kqb[tid] = nkq;
        const float vv = nvv, a = __expf(ng), beta = nbeta;
        if (t + 1 < SEQ) { const size_t r1 = row + 1;
            if (tid < 256) nkq = bf2f((tid < 128 ? KN : QN)[r1 * 2048 + hk * 128 + (tid & 127)]);
            nvv = bf2f(V[r1 * 4096 + hv * 128 + v]); ng = G[r1 * 32 + hv]; nbeta = BETA[r1 * 32 + hv]; }
        __syncthreads();
        float kk[32]; float part = 0.f;
#pragma unroll
        for (int i = 0; i < 8; ++i) { const f32x4 k4 = *(const LAS f32x4*)(kqb + kg * 32 + 4 * i); kk[4 * i] = k4.x; kk[4 * i + 1] = k4.y; kk[4 * i + 2] = k4.z; kk[4 * i + 3] = k4.w; }
#pragma unroll
        for (int i = 0; i < 32; ++i) part += kk[i] * S[i];
        red[kg * 128 + v] = part;
        __syncthreads();
        const float kS = (red[v] + red[128 + v]) + (red[256 + v] + red[384 + v]);
        const float vnew = beta * (vv - a * kS);
        float op = 0.f;
#pragma unroll
        for (int i = 0; i < 8; ++i) { const f32x4 q4 = *(const LAS f32x4*)(kqb + 128 + kg * 32 + 4 * i);
            S[4 * i] = a * S[4 * i] + kk[4 * i] * vnew; S[4 * i + 1] = a * S[4 * i + 1] + kk[4 * i + 1] * vnew;
            S[4 * i + 2] = a * S[4 * i + 2] + kk[4 * i + 2] * vnew; S[4 * i + 3] = a * S[4 * i + 3] + kk[4 * i + 3] * vnew;
            op += (S[4 * i] * q4.x + S[4 * i + 1] * q4.y) + (S[4 * i + 2] * q4.z + S[4 * i + 3] * q4.w); }
        red2[kg * 128 + v] = op;
        __syncthreads();
        if (kg == 0) { const float oo = (red2[v] + red2[128 + v]) + (red2[256 + v] + red2[384 + v]); OG[row * 4096 + hv * 128 + v] = f2bf(oo); }
    }
    __syncthreads();
}

DI void dnc_phase(bf16_t* OG, const bf16_t* Z, const float* norm_g, int wave, int lane) {
    const int gw = blockIdx.x * NWAVES + wave, ngw = gridDim.x * NWAVES;
    const float g0 = norm_g[2 * lane], g1 = norm_g[2 * lane + 1];
    for (int it = gw; it < M * 32; it += ngw) { const size_t off = (size_t)it * 128 + 2 * lane;
        const unsigned raw = *(const unsigned*)(OG + off), zr = *(const unsigned*)(Z + off);
        const float o0 = bflo(raw), o1 = bfhi(raw), z0 = bflo(zr), z1 = bfhi(zr);
        const float sc = rsqrtf(wave_sum(o0 * o0 + o1 * o1) * (1.f / 128.f) + RMS_EPS);
        *(unsigned*)(OG + off) = pk2(o0 * sc * g0 * pg8::silu_f(z0), o1 * sc * g1 * pg8::silu_f(z1)); }
}

constexpr int N_PHASES = 24;
DI void gemm_swiglu(LAS unsigned char* lds, const bf16_t* A, const bf16_t* Wt, bf16_t* H) {
    pg8::Gemm g{A, Wt, M, 2 * DFF, D}; pg8::StaticOrder S; S.init(M, 2 * DFF, (int)gridDim.x, (int)blockIdx.x);
    pg8::EpiSwiGLU E{H, DFF};
    pg8::gemm_phase<pg8::EpiSwiGLU, pg8::StaticOrder, true, true>(lds, g, S, E);
}
DI void gemm_resid(LAS unsigned char* lds, const bf16_t* A, const bf16_t* Wt, int K, const float* resid, float* out, float scale) {
    pg8::Gemm g{A, Wt, M, D, K}; pg8::StaticOrder S; S.init(M, D, (int)gridDim.x, (int)blockIdx.x);
    pg8::EpiResid E{resid, out, D, ALPHA, scale};
    pg8::gemm_phase<pg8::EpiResid, pg8::StaticOrder, true, true>(lds, g, S, E);
}
__global__ void __launch_bounds__(NTHREADS, 2) fwd_kernel(Args args) {
    extern __shared__ __attribute__((aligned(16))) unsigned char lds_raw[];
    LAS unsigned char* lds = (LAS unsigned char*)lds_raw;
    cg::grid_group grid = cg::this_grid();
    const int tid = threadIdx.x, lane = tid & 63, wave = __builtin_amdgcn_readfirstlane(tid >> 6);
    unsigned char* const ws = args.ws;
    const int lo = args.ph_lo, hi = args.ph_hi;
#define PHASE(k) if (lo <= (k) && (k) < hi && ((k) == lo || (grid.sync(), true)))
#define WSP(T, off) ((T*)(ws + (off)))
    const size_t WGU = (size_t)D * DFF;
    PHASE(0) { p0_prologue(args, lds, wave, lane); }
    PHASE(1) { gemm_swiglu(lds, WSP(bf16_t, WS_XB), WSP(bf16_t, WS_WGU1_0), WSP(bf16_t, WS_BIG)); }
    PHASE(2) { gemm_resid(lds, WSP(bf16_t, WS_BIG), WSP(bf16_t, WS_WD1_0), DFF, args.in[0], args.out, 0.5f); }
    PHASE(3) { ln_phase(args.out, WSP(bf16_t, WS_XB), args.in[7] + 0 * D, args.in[8] + 0 * D, wave, lane); }
    PHASE(4) { pg8::Gemm g{WSP(bf16_t, WS_XB), WSP(bf16_t, WS_WABIN), M, AB_IN, D}; pg8::StaticOrder S; S.init(M, AB_IN, (int)gridDim.x, (int)blockIdx.x);
        pg8::EpiPlain E{WSP(bf16_t, WS_BIG), AB_IN};
        pg8::gemm_phase<pg8::EpiPlain, pg8::StaticOrder, true, true>(lds, g, S, E); }
    PHASE(5) {
        for (int it = blockIdx.x; it < 256; it += gridDim.x)
            rope_item(WSP(bf16_t, WS_BIG), WSP(bf16_t, WS_QR), WSP(bf16_t, WS_KR), WSP(bf16_t, WS_VT), WSP(float, WS_KMEAN), it, (LAS float*)lds, tid);
        for (int it = blockIdx.x; it < 512; it += gridDim.x)
            gmlp_item(WSP(bf16_t, WS_BIG), args.in[10], args.in[11], args.in[12], args.in[13], WSP(bf16_t, WS_CAT), it, lds, wave, lane);
    }
    PHASE(6) {
        for (int wg = blockIdx.x; wg < 256; wg += gridDim.x) { const int bh = wg >> 3, sub = wg & 7;
            moba_wave(WSP(bf16_t, WS_QR), WSP(bf16_t, WS_KR), WSP(bf16_t, WS_VT), WSP(float, WS_KMEAN), WSP(bf16_t, WS_CAT), bh, wave * 8 + sub, lane); }
    }
    PHASE(7) { gemm_resid(lds, WSP(bf16_t, WS_CAT), WSP(bf16_t, WS_WABOUT), D, args.out, args.out, 1.0f); }
    PHASE(8) { ln_phase(args.out, WSP(bf16_t, WS_XB), args.in[7] + 1 * D, args.in[8] + 1 * D, wave, lane); }
    PHASE(9) { gemm_swiglu(lds, WSP(bf16_t, WS_XB), WSP(bf16_t, WS_WGU2_0), WSP(bf16_t, WS_BIG)); }
    PHASE(10) { gemm_resid(lds, WSP(bf16_t, WS_BIG), WSP(bf16_t, WS_WD2_0), DFF, args.out, args.out, 0.5f); }
    PHASE(11) { ln_phase(args.out, WSP(bf16_t, WS_XB), args.in[7] + 2 * D, args.in[8] + 2 * D, wave, lane); }
    PHASE(12) { gemm_swiglu(lds, WSP(bf16_t, WS_XB), WSP(bf16_t, WS_WGU1_1), WSP(bf16_t, WS_BIG)); }
    PHASE(13) { gemm_resid(lds, WSP(bf16_t, WS_BIG), WSP(bf16_t, WS_WD1_1), DFF, args.out, args.out, 0.5f); }
    PHASE(14) { ln_phase(args.out, WSP(bf16_t, WS_XB), args.in[7] + 3 * D, args.in[8] + 3 * D, wave, lane); }
    PHASE(15) { pg8::Gemm g{WSP(bf16_t, WS_XB), WSP(bf16_t, WS_WDNIN), M, DN_IN_PAD, D}; pg8::StaticOrder S; S.init(M, DN_IN_PAD, (int)gridDim.x, (int)blockIdx.x);
        pg8::EpiDnIn E{WSP(bf16_t, WS_BIG), WSP(float, WS_BA)};
        pg8::gemm_phase<pg8::EpiDnIn, pg8::StaticOrder, true, true>(lds, g, S, E); }
    PHASE(16) { dnp_phase(WSP(bf16_t, WS_BIG), WSP(bf16_t, WS_BIG) + (size_t)M * 4096, WSP(float, WS_BA), args.in[16], args.in[17], args.in[18],
                          WSP(bf16_t, WS_QN), WSP(bf16_t, WS_KN), WSP(bf16_t, WS_V), WSP(float, WS_G), WSP(float, WS_BETA), wave, lane); }
    PHASE(17) {
        for (int it = blockIdx.x; it < 128; it += gridDim.x)
            dn_scan_item(WSP(bf16_t, WS_QN), WSP(bf16_t, WS_KN), WSP(bf16_t, WS_V), WSP(float, WS_G), WSP(float, WS_BETA), WSP(bf16_t, WS_OG), it, (LAS float*)lds, tid);
    }
    PHASE(18) { dnc_phase(WSP(bf16_t, WS_OG), WSP(bf16_t, WS_BIG) + (size_t)2 * M * 4096, args.in[19], wave, lane); }
    PHASE(19) { gemm_resid(lds, WSP(bf16_t, WS_OG), WSP(bf16_t, WS_WDNOUT), 4096, args.out, args.out, 1.0f); }
    PHASE(20) { ln_phase(args.out, WSP(bf16_t, WS_XB), args.in[7] + 4 * D, args.in[8] + 4 * D, wave, lane); }
    PHASE(21) { gemm_swiglu(lds, WSP(bf16_t, WS_XB), WSP(bf16_t, WS_WGU2_1), WSP(bf16_t, WS_BIG)); }
    PHASE(22) { gemm_resid(lds, WSP(bf16_t, WS_BIG), WSP(bf16_t, WS_WD2_1), DFF, args.out, args.out, 0.5f); }
    PHASE(23) { ln_phase(args.out, WSP(bf16_t, WS_XB), args.in[7] + 5 * D, args.in[8] + 5 * D, wave, lane); }
}

extern "C" void kernel_launch(void* const* d_in, const int* in_sizes, int n_in, void* d_out, int out_size, void* d_ws, size_t ws_size, hipStream_t stream) {
    static int grid = 0;
    if (grid == 0) {
        if (n_in != 21 || out_size != M * D || ws_size < WS_END) { fprintf(stderr, "kernel_launch: unexpected shapes (n_in %d out %d ws %zu)\n", n_in, out_size, ws_size); grid = -1; return; }
        int dev = 0, cus = 0, per_cu = 0;
        (void)hipGetDevice(&dev); (void)hipDeviceGetAttribute(&cus, hipDeviceAttributeMultiprocessorCount, dev);
        (void)hipFuncSetAttribute((const void*)fwd_kernel, hipFuncAttributeMaxDynamicSharedMemorySize, LDS_BYTES);
        (void)hipOccupancyMaxActiveBlocksPerMultiprocessor(&per_cu, (const void*)fwd_kernel, NTHREADS, LDS_BYTES);
        if (per_cu < 1) { fprintf(stderr, "kernel_launch: occupancy query says %d blocks/CU\n", per_cu); per_cu = 1; }
        (void)hipGetLastError();
        grid = cus;
    }
    if (grid < 0) return;
    Args a{};
    for (int i = 0; i < 21; ++i) a.in[i] = (const float*)d_in[i];
    a.out = (float*)d_out; a.ws = (unsigned char*)d_ws; a.ph_lo = 0; a.ph_hi = N_PHASES;
    void* kargs[] = {&a};
    hipError_t e = hipLaunchCooperativeKernel((const void*)fwd_kernel, dim3(grid), dim3(NTHREADS), kargs, LDS_BYTES, stream);
    if (e != hipSuccess) fprintf(stderr, "kernel_launch: cooperative launch failed: %s (grid %d)\n", hipGetErrorString(e), grid);
}
```

```cpp
#include <hip/hip_runtime.h>
#include <hip/hip_cooperative_groups.h>
#include <cstdio>
#include <cstdint>
namespace cg = cooperative_groups;
namespace pg8 {
#define PG8_LAS __attribute__((address_space(3)))
typedef unsigned short bf16_t;
typedef short bf16x8 __attribute__((ext_vector_type(8)));
typedef float f32x4 __attribute__((ext_vector_type(4)));
typedef unsigned u32x4 __attribute__((ext_vector_type(4)));
constexpr int BM = 256, BK = 64, HALF = 128, HTB = HALF * BK * 2  , STAGE_BYTES = 8 * HTB, NXCD = 8, WGM = 8;

__host__ __device__ __forceinline__ int lds_byte(int r, int c) { const int st = (r >> 4) * 2 + (c >> 5), rr = r & 15, cc = c & 31, ob = rr * 64 + cc * 2; return st * 1024 + (ob ^ (((ob >> 9) & 1) << 5)); }
__host__ __device__ __forceinline__ void stage_rc(int b, int& R, int& C) { const int st = b / 1024, sb = b % 1024, swz = sb ^ (((sb >> 9) & 1) << 5); R = (st >> 1) * 16 + swz / 64; C = (st & 1) * 32 + (swz % 64) / 2; }
__host__ __device__ __forceinline__ int perm32(int rho) { const int n = rho >> 4, i = rho & 15; return 8 * (i >> 2) + 4 * n + (i & 3); }

struct Unit { int pm, pn; };
struct Gemm { const bf16_t* A; const bf16_t* Bt; int M, N, K; };

struct StaticOrder {
    int nM, nN, nwg, G, c;
    __host__ __device__ void init(int M, int N, int G_, int c_) { nM = M / BM; nN = N / BM; nwg = nM * nN; G = G_; c = c_; }
    __host__ __device__ bool next(int i, Unit& u) const {
        const long L = (long)i * G + c; if (L >= nwg) return false;
        int wgid = (int)L; { const int q = nwg / NXCD, r = nwg % NXCD, xcd = wgid % NXCD, off = wgid / NXCD; wgid = (xcd < r ? xcd * (q + 1) : r * (q + 1) + (xcd - r) * q) + off; }
        const int nig = WGM * nN, gid = wgid / nig, fm = gid * WGM, gsz = (nM - fm) < WGM ? (nM - fm) : WGM;
        u.pm = fm + ((wgid % nig) % gsz); u.pn = (wgid % nig) / gsz; return true;
    }
    __device__ __forceinline__ void a_ready(const Unit&) const {}
    __device__ __forceinline__ void done(const Unit&) const {}
};

__device__ __forceinline__ unsigned cvt_pk_bf16(float lo, float hi) { unsigned r; asm volatile("v_cvt_pk_bf16_f32 %0, %1, %2" : "=v"(r) : "v"(lo), "v"(hi)); return r; }
typedef float f32x2 __attribute__((ext_vector_type(2)));
typedef __bf16 bf16x2_t __attribute__((ext_vector_type(2)));
__device__ __forceinline__ unsigned pk2(float lo, float hi) { f32x2 v = {lo, hi}; bf16x2_t b = __builtin_convertvector(v, bf16x2_t); return __builtin_bit_cast(unsigned, b); }
__device__ __forceinline__ float silu_f(float g) { return g * __builtin_amdgcn_rcpf(1.0f + __expf(-g)); }

struct EpiPlain {
    static constexpr bool PERM = true, AFTER_DRAIN = false;
    bf16_t* O; int ldc;
    __device__ __forceinline__ void operator()(const f32x4 (&acc)[2][2][4][2], const Unit& u, int wr, int wc, int fr, int fq) const {
        const int row0 = u.pm * BM + wr * 64 + fr, col0 = u.pn * BM + wc * 32 + 8 * fq;
#pragma unroll
        for (int ai = 0; ai < 2; ++ai)
#pragma unroll
            for (int m = 0; m < 4; ++m) { bf16_t* rowp = O + (size_t)(row0 + ai * HALF + m * 16) * ldc + col0;
#pragma unroll
                for (int bj = 0; bj < 2; ++bj) { const f32x4 v0 = acc[ai][bj][m][0], v1 = acc[ai][bj][m][1];
                    u32x4 w; w.x = pk2(v0[0], v0[1]); w.y = pk2(v0[2], v0[3]); w.z = pk2(v1[0], v1[1]); w.w = pk2(v1[2], v1[3]);
                    *(u32x4*)(rowp + bj * HALF) = w; } }
    }
};
struct EpiDnIn {
    static constexpr bool PERM = true, AFTER_DRAIN = false;
    bf16_t* O; float* BA;
    __device__ __forceinline__ void operator()(const f32x4 (&acc)[2][2][4][2], const Unit& u, int wr, int wc, int fr, int fq) const {
        const int row0 = u.pm * BM + wr * 64 + fr;
        if (u.pn < 48) {
            bf16_t* base = O + (size_t)(u.pn >> 4) * ((size_t)8192 * 4096);
            const int col0 = (u.pn & 15) * BM + wc * 32 + 8 * fq;
#pragma unroll
            for (int ai = 0; ai < 2; ++ai)
#pragma unroll
                for (int m = 0; m < 4; ++m) { bf16_t* rowp = base + (size_t)(row0 + ai * HALF + m * 16) * 4096 + col0;
#pragma unroll
                    for (int bj = 0; bj < 2; ++bj) { const f32x4 v0 = acc[ai][bj][m][0], v1 = acc[ai][bj][m][1];
                        u32x4 w; w.x = pk2(v0[0], v0[1]); w.y = pk2(v0[2], v0[3]); w.z = pk2(v1[0], v1[1]); w.w = pk2(v1[2], v1[3]);
                        *(u32x4*)(rowp + bj * HALF) = w; } }
        } else if (wc < 2) {
            const int col0 = wc * 32 + 8 * fq;
#pragma unroll
            for (int ai = 0; ai < 2; ++ai)
#pragma unroll
                for (int m = 0; m < 4; ++m) { float* rowp = BA + (size_t)(row0 + ai * HALF + m * 16) * 64 + col0;
                    *(f32x4*)(rowp) = acc[ai][0][m][0]; *(f32x4*)(rowp + 4) = acc[ai][0][m][1]; }
        }
    }
};
struct EpiSwiGLU {
    static constexpr bool PERM = true, AFTER_DRAIN = false;
    bf16_t* O; int ldc;
    __device__ __forceinline__ void operator()(const f32x4 (&acc)[2][2][4][2], const Unit& u, int wr, int wc, int fr, int fq) const {
        const int row0 = u.pm * BM + wr * 64 + fr, col0 = u.pn * HALF + wc * 32 + 8 * fq;
#pragma unroll
        for (int ai = 0; ai < 2; ++ai)
#pragma unroll
            for (int m = 0; m < 4; ++m) { bf16_t* rowp = O + (size_t)(row0 + ai * HALF + m * 16) * ldc + col0;
                const f32x4 g0 = acc[ai][0][m][0], g1 = acc[ai][0][m][1], u0 = acc[ai][1][m][0], u1 = acc[ai][1][m][1];
                u32x4 w;
                w.x = pk2(silu_f(g0[0]) * u0[0], silu_f(g0[1]) * u0[1]); w.y = pk2(silu_f(g0[2]) * u0[2], silu_f(g0[3]) * u0[3]);
                w.z = pk2(silu_f(g1[0]) * u1[0], silu_f(g1[1]) * u1[1]); w.w = pk2(silu_f(g1[2]) * u1[2], silu_f(g1[3]) * u1[3]);
                *(u32x4*)(rowp) = w; }
    }
};
struct EpiResid {
    static constexpr bool PERM = false, AFTER_DRAIN = false;
    const float* resid; float* out; int ldc; float alpha, scale;
    __device__ __forceinline__ void operator()(const f32x4 (&acc)[2][2][4][2], const Unit& u, int wr, int wc, int fr, int fq) const {
        const int col0 = u.pn * BM + wc * 32 + 4 * fq;
#pragma unroll
        for (int ai = 0; ai < 2; ++ai)
#pragma unroll
            for (int m = 0; m < 4; ++m) { const size_t off = (size_t)(u.pm * BM + ai * HALF + wr * 64 + m * 16 + fr) * ldc + col0;
                f32x4 rv[2][2];
#pragma unroll
                for (int bj = 0; bj < 2; ++bj)
#pragma unroll
                    for (int n = 0; n < 2; ++n) rv[bj][n] = *(const f32x4*)(resid + off + bj * HALF + n * 16);
#pragma unroll
                for (int bj = 0; bj < 2; ++bj)
#pragma unroll
                    for (int n = 0; n < 2; ++n) *(f32x4*)(out + off + bj * HALF + n * 16) = rv[bj][n] * alpha + acc[ai][bj][m][n] * scale;
                asm volatile("" ::: "memory"); }
    }
};
template <class Epi, class Sched, bool ALIGN_EPI = false, bool SP2 = false>
__device__ __forceinline__ void gemm_phase(PG8_LAS unsigned char* lds, const Gemm g, const Sched& S, const Epi& E) {
    const int tid = threadIdx.x, wid = __builtin_amdgcn_readfirstlane(tid >> 6), lane = tid & 63, wr = wid >> 2, wc = wid & 3, fr = lane & 15, fq = lane >> 4;
    const int K = g.K, nt = K / BK;
    unsigned voffA[2], voffB[2];
#pragma unroll
    for (int i = 0; i < 2; ++i) { int R, C; stage_rc(tid * 16 + i * 8192, R, C); const int Rb = Epi::PERM ? ((R & ~31) + perm32(R & 31)) : R;
        voffA[i] = (unsigned)(R * K + C) * 2u; voffB[i] = (unsigned)(Rb * K + C) * 2u; }
    const size_t kstep = (size_t)(BK * 2);
    const size_t hstep = (size_t)HALF * K * 2;
    const size_t tstep = 2 * hstep;
    const unsigned ldsw = (unsigned)wid * 1024u;
    const int aoff = lds_byte(wr * 64 + fr, fq * 8), boff = lds_byte(wc * 32 + fr, fq * 8);
#define PG8_SA(b, h) (((b) * 2 + (h)) * HTB)
#define PG8_SB(b, h) ((4 + (b) * 2 + (h)) * HTB)
#define PG8_STAGE(bufoff, gbase, voff) do { _Pragma("unroll") for (int _i = 0; _i < 2; ++_i) \
        __builtin_amdgcn_global_load_lds((const unsigned*)((const char*)(gbase) + (voff)[_i]), (PG8_LAS unsigned*)(lds + (bufoff) + ldsw + _i * 8192), 16, 0, 0); } while (0)
#define PG8_LDA(dst, b, h) do { _Pragma("unroll") for (int m = 0; m < 4; ++m) _Pragma("unroll") for (int k = 0; k < 2; ++k) dst[m][k] = *(const PG8_LAS bf16x8*)(lds + PG8_SA(b, h) + aoff + m * 2048 + k * 1024); } while (0)
#define PG8_LDB(dst, b, h) do { _Pragma("unroll") for (int n = 0; n < 2; ++n) _Pragma("unroll") for (int k = 0; k < 2; ++k) dst[n][k] = *(const PG8_LAS bf16x8*)(lds + PG8_SB(b, h) + boff + n * 2048 + k * 1024); } while (0)
#define PG8_MMA(ai, bj, At, Bt) do { __builtin_amdgcn_s_setprio(1); _Pragma("unroll") for (int m = 0; m < 4; ++m) _Pragma("unroll") for (int n = 0; n < 2; ++n) _Pragma("unroll") for (int k = 0; k < 2; ++k) \
        acc[ai][bj][m][n] = __builtin_amdgcn_mfma_f32_16x16x32_bf16(Bt[n][k], At[m][k], acc[ai][bj][m][n], 0, 0, 0); __builtin_amdgcn_s_setprio(0); } while (0)
#define PG8_WAIT_V(n) asm volatile("s_waitcnt vmcnt(" #n ")" ::: "memory")
#define PG8_WAIT_L(n) asm volatile("s_waitcnt lgkmcnt(" #n ")" ::: "memory")
#define PG8_BAR __builtin_amdgcn_s_barrier()
#define PG8_SCHED __builtin_amdgcn_sched_barrier(0)
    Unit cur, nxt; int ui = 0;
    if (!S.next(0, cur)) return;
    f32x4 acc[2][2][4][2];
#pragma unroll
    for (int a = 0; a < 2; ++a)
#pragma unroll
        for (int b = 0; b < 2; ++b)
#pragma unroll
            for (int m = 0; m < 4; ++m)
#pragma unroll
                for (int n = 0; n < 2; ++n) acc[a][b][m][n] = (f32x4){0.f, 0.f, 0.f, 0.f};
    bf16x8 At[4][2], B0[2][2], B1[2][2];
    const char* cA = (const char*)g.A + (size_t)cur.pm * tstep; const char* cB = (const char*)g.Bt + (size_t)cur.pn * tstep;
    S.a_ready(cur);
    if constexpr (SP2) {
        PG8_STAGE(PG8_SB(0, 0), cB, voffB); PG8_STAGE(PG8_SB(0, 1), cB + hstep, voffB); PG8_STAGE(PG8_SA(0, 0), cA, voffA); PG8_STAGE(PG8_SA(0, 1), cA + hstep, voffA);
        if (wr == 1) PG8_BAR;
        PG8_WAIT_V(2); PG8_BAR;
        PG8_STAGE(PG8_SB(1, 0), cB + kstep, voffB); PG8_STAGE(PG8_SA(1, 0), cA + kstep, voffA); PG8_STAGE(PG8_SB(1, 1), cB + hstep + kstep, voffB);
        PG8_WAIT_V(6); PG8_BAR;
    } else {
        PG8_STAGE(PG8_SB(0, 0), cB, voffB); PG8_STAGE(PG8_SA(0, 0), cA, voffA); PG8_STAGE(PG8_SB(0, 1), cB + hstep, voffB); PG8_STAGE(PG8_SA(0, 1), cA + hstep, voffA);
        if (wr == 1) PG8_BAR;
        PG8_WAIT_V(4); PG8_BAR;
        PG8_STAGE(PG8_SB(1, 0), cB + kstep, voffB); PG8_STAGE(PG8_SA(1, 0), cA + kstep, voffA); PG8_STAGE(PG8_SB(1, 1), cB + hstep + kstep, voffB);
        PG8_WAIT_V(6); PG8_BAR;
    }
    for (;;) {
        const bool has_next = S.next(ui + 1, nxt);
        const char* nA = has_next ? (const char*)g.A + (size_t)nxt.pm * tstep : cA; const char* nB = has_next ? (const char*)g.Bt + (size_t)nxt.pn * tstep : cB;
        for (int t = 0; t < nt; t += 2) {
            const bool last = (t == nt - 2);
            const char* a1 = cA + (size_t)(t + 1) * kstep;
            const char* a2 = last ? nA : cA + (size_t)(t + 2) * kstep; const char* b2 = last ? nB : cB + (size_t)(t + 2) * kstep;
            const char* a3 = a2 + kstep; const char* b3 = b2 + kstep;
            if (last && has_next) S.a_ready(nxt);
            if constexpr (SP2) {
            PG8_LDB(B0, 0, 0); PG8_LDB(B1, 0, 1); PG8_SCHED; PG8_LDA(At, 0, 0); PG8_STAGE(PG8_SA(1, 1), a1 + hstep, voffA);
            PG8_WAIT_V(8); PG8_WAIT_L(0); PG8_BAR; PG8_MMA(0, 0, At, B0); PG8_MMA(0, 1, At, B1); PG8_BAR; PG8_SCHED;
            PG8_LDA(At, 0, 1); PG8_STAGE(PG8_SB(0, 0), b2, voffB); PG8_STAGE(PG8_SB(0, 1), b2 + hstep, voffB); PG8_STAGE(PG8_SA(0, 0), a2, voffA);
            PG8_WAIT_V(8); PG8_WAIT_L(0); PG8_BAR; PG8_MMA(1, 0, At, B0); PG8_MMA(1, 1, At, B1); PG8_BAR; PG8_SCHED;
            PG8_LDB(B0, 1, 0); PG8_LDB(B1, 1, 1); PG8_SCHED; PG8_LDA(At, 1, 0); PG8_STAGE(PG8_SA(0, 1), a2 + hstep, voffA);
            PG8_WAIT_V(8); PG8_WAIT_L(0); PG8_BAR; PG8_MMA(0, 0, At, B0); PG8_MMA(0, 1, At, B1); PG8_BAR; PG8_SCHED;
            PG8_LDA(At, 1, 1); PG8_STAGE(PG8_SB(1, 0), b3, voffB); PG8_STAGE(PG8_SB(1, 1), b3 + hstep, voffB); PG8_STAGE(PG8_SA(1, 0), a3, voffA);
            PG8_WAIT_V(8); PG8_WAIT_L(0); PG8_BAR; PG8_MMA(1, 0, At, B0); PG8_MMA(1, 1, At, B1); PG8_BAR; PG8_SCHED;
            } else {
            PG8_LDB(B0, 0, 0); PG8_SCHED; PG8_LDA(At, 0, 0); PG8_STAGE(PG8_SA(1, 1), a1 + hstep, voffA);
            PG8_WAIT_L(8); PG8_BAR; PG8_WAIT_L(0); PG8_MMA(0, 0, At, B0); PG8_BAR; PG8_SCHED;
            PG8_LDB(B1, 0, 1); PG8_STAGE(PG8_SB(0, 0), b2, voffB);
            PG8_BAR; PG8_WAIT_L(0); PG8_MMA(0, 1, At, B1); PG8_BAR;
            PG8_LDA(At, 0, 1); PG8_STAGE(PG8_SA(0, 0), a2, voffA);
            PG8_BAR; PG8_WAIT_L(0); PG8_MMA(1, 0, At, B0); PG8_BAR; PG8_SCHED;
            PG8_STAGE(PG8_SB(0, 1), b2 + hstep, voffB);
            PG8_WAIT_V(6); PG8_BAR; PG8_MMA(1, 1, At, B1); PG8_BAR;
            PG8_LDB(B0, 1, 0); PG8_SCHED; PG8_LDA(At, 1, 0); PG8_STAGE(PG8_SA(0, 1), a2 + hstep, voffA);
            PG8_WAIT_L(8); PG8_BAR; PG8_WAIT_L(0); PG8_MMA(0, 0, At, B0); PG8_BAR; PG8_SCHED;
            PG8_LDB(B1, 1, 1); PG8_STAGE(PG8_SB(1, 0), b3, voffB);
            PG8_BAR; PG8_WAIT_L(0); PG8_MMA(0, 1, At, B1); PG8_BAR;
            PG8_LDA(At, 1, 1); PG8_STAGE(PG8_SA(1, 0), a3, voffA);
            PG8_BAR; PG8_WAIT_L(0); PG8_MMA(1, 0, At, B0); PG8_BAR; PG8_SCHED;
            PG8_STAGE(PG8_SB(1, 1), b3 + hstep, voffB);
            PG8_WAIT_V(6); PG8_BAR; PG8_MMA(1, 1, At, B1); PG8_BAR;
            }
        }
        if constexpr (ALIGN_EPI) { if (wr == 0) PG8_BAR; }
        if constexpr (!Epi::AFTER_DRAIN) { E(acc, cur, wr, wc, fr, fq); S.done(cur); }
        if (!has_next) break;
#pragma unroll
        for (int a = 0; a < 2; ++a)
#pragma unroll
            for (int b = 0; b < 2; ++b)
#pragma unroll
                for (int m = 0; m < 4; ++m)
#pragma unroll
                    for (int n = 0; n < 2; ++n) acc[a][b][m][n] = (f32x4){0.f, 0.f, 0.f, 0.f};
        cur = nxt; cA = nA; cB = nB; ++ui;
        if constexpr (ALIGN_EPI) { if (wr == 1) PG8_BAR; }
    }
    PG8_WAIT_V(0);
    if constexpr (!ALIGN_EPI) { if (wr == 0) PG8_BAR; }
    PG8_BAR;
    if constexpr (Epi::AFTER_DRAIN) { E.fused(acc, cur, wr, wc, fr, fq, lds, wid, lane); S.done(cur); }
#undef PG8_SA
#undef PG8_SB
#undef PG8_STAGE
#undef PG8_LDA
#undef PG8_LDB
#undef PG8_MMA
#undef PG8_WAIT_V
#undef PG8_WAIT_L
#undef PG8_BAR
#undef PG8_SCHED
}
}
#define LAS __attribute__((address_space(3)))
#define DI __device__ __forceinline__
typedef unsigned short bf16_t;
typedef short bf16x8 __attribute__((ext_vector_type(8)));
typedef float f32x4 __attribute__((ext_vector_type(4)));
typedef float f32x16 __attribute__((ext_vector_type(16)));
typedef unsigned u32x4 __attribute__((ext_vector_type(4)));
typedef unsigned u32x2 __attribute__((ext_vector_type(2)));
using pg8::pk2;

constexpr int NWAVES = 8, NTHREADS = 512;
constexpr int D = 2048, BATCH = 4, SEQ = 2048, M = BATCH * SEQ, DFF = 5632;
constexpr int AB_IN = 5120, DN_IN = 12352, DN_IN_PAD = 12544;
constexpr float ALPHA = 1.41421356237f;
constexpr float LN_EPS = 1e-5f, RMS_EPS = 1e-6f;
constexpr size_t MiB = (size_t)1 << 20;
constexpr size_t WS_L0 = 0;
constexpr size_t WS_WGU1_0 = 0, WS_WD1_0 = 44 * MiB, WS_WGU2_0 = 66 * MiB, WS_WD2_0 = 110 * MiB, WS_WABIN = 132 * MiB, WS_WABOUT = 152 * MiB;
constexpr size_t WS_WGU1_1 = 160 * MiB, WS_WD1_1 = 204 * MiB, WS_WGU2_1 = 226 * MiB, WS_WD2_1 = 270 * MiB, WS_WDNIN = 292 * MiB, WS_WDNOUT = 341 * MiB;
constexpr size_t WS_XB = 357 * MiB;
constexpr size_t WS_BIG = 389 * MiB;
constexpr size_t WS_BA = WS_BIG + 192 * MiB;
constexpr size_t WS_DNX = 585 * MiB;
constexpr size_t WS_QR = WS_DNX, WS_KR = WS_DNX + 16 * MiB, WS_VT = WS_DNX + 32 * MiB, WS_CAT = WS_DNX + 48 * MiB, WS_KMEAN = WS_DNX + 80 * MiB;
constexpr size_t WS_QN = WS_DNX, WS_KN = WS_DNX + 32 * MiB, WS_V = WS_DNX + 64 * MiB, WS_G = WS_DNX + 128 * MiB, WS_BETA = WS_DNX + 129 * MiB;
constexpr size_t WS_OG = WS_L0;
constexpr size_t WS_WIMG = WS_BIG, WS_UIMG = WS_BIG + 64 * MiB;
constexpr size_t WS_AIMG = WS_L0 + 64 * MiB, WS_QIMG = WS_L0 + 96 * MiB, WS_KTIMG = WS_L0 + 128 * MiB;
constexpr size_t WS_GC = 715 * MiB;
constexpr size_t WS_END = 717 * MiB;
constexpr int LDS_BYTES = 147456;

DI float bflo(unsigned u) { return __uint_as_float(u << 16); }
DI float bfhi(unsigned u) { return __uint_as_float(u & 0xffff0000u); }
DI float bf2f(bf16_t h) { return __uint_as_float((unsigned)h << 16); }
DI bf16_t f2bf(float f) { return (bf16_t)(pk2(f, 0.f) & 0xffffu); }
DI float wave_sum(float v) {
#pragma unroll
    for (int o = 1; o < 64; o <<= 1) v += __shfl_xor(v, o);
    return v;
}
DI float gelu_tanh(float x) { const float t = 1.5957691216f * (x + 0.044715f * x * x * x); return x * __builtin_amdgcn_rcpf(1.0f + __expf(-t)); }
DI int crow(int r, int h) { return (r & 3) + 8 * (r >> 2) + 4 * h; }
#define MFMA32(a, b, c) __builtin_amdgcn_mfma_f32_32x32x16_bf16((a), (b), (c), 0, 0, 0)
DI bf16x8 pack8(float a0, float a1, float a2, float a3, float a4, float a5, float a6, float a7) {
    u32x4 p; p.x = pk2(a0, a1); p.y = pk2(a2, a3); p.z = pk2(a4, a5); p.w = pk2(a6, a7); return __builtin_bit_cast(bf16x8, p);
}

DI void tr_tile(const float* __restrict__ W, int K, int N, bf16_t* __restrict__ WT, int k0, int n0, int drow0, LAS float* scr, int lane) {
#pragma unroll 4
    for (int i = 0; i < 16; ++i) { const int kk = 4 * i + (lane >> 4), c4 = (lane & 15) * 4;
        const f32x4 v = *(const f32x4*)(W + (size_t)(k0 + kk) * N + n0 + c4);
        LAS float* s = scr + kk * 65 + c4; s[0] = v.x; s[1] = v.y; s[2] = v.z; s[3] = v.w; }
    asm volatile("s_waitcnt lgkmcnt(0)" ::: "memory");
    const int c = lane & 7;
#pragma unroll
    for (int j = 0; j < 8; ++j) { const int n = (lane >> 3) + 8 * j; const LAS float* s = scr + (8 * c) * 65 + n;
        u32x4 o; o.x = pk2(s[0], s[65]); o.y = pk2(s[2 * 65], s[3 * 65]); o.z = pk2(s[4 * 65], s[5 * 65]); o.w = pk2(s[6 * 65], s[7 * 65]);
        *(u32x4*)(WT + (size_t)(drow0 + n) * K + k0 + 8 * c) = o; }
    asm volatile("s_waitcnt lgkmcnt(0)" ::: "memory");
}
DI void tr_matrix(const float* W, int K, int N, bf16_t* WT, int mode, LAS float* scr, int gw, int ngw, int lane) {
    const int nb = N / 64, items = (K / 64) * nb;
    for (int it = gw; it < items; it += ngw) {
        const int kb = it / nb, n0 = (it % nb) * 64;
        const int drow0 = mode == 0 ? n0 : ((n0 >> 7) * 256 + (n0 & 127) + (mode == 2 ? 128 : 0));
        tr_tile(W, K, N, WT, kb * 64, n0, drow0, scr, lane);
    }
}

struct Args { const float* in[21]; float* out; unsigned char* ws; int ph_lo, ph_hi; };

DI void p0_prologue(const Args& a, LAS unsigned char* lds, int wave, int lane) {
    LAS float* scr = (LAS float*)(lds + wave * 17408);
    const int gw = blockIdx.x * NWAVES + wave, ngw = gridDim.x * NWAVES;
    unsigned char* ws = a.ws;
    const size_t WGU = (size_t)D * DFF;
    for (int l = 0; l < 2; ++l) {
        bf16_t* gu1 = (bf16_t*)(ws + (l ? WS_WGU1_1 : WS_WGU1_0)); bf16_t* d1 = (bf16_t*)(ws + (l ? WS_WD1_1 : WS_WD1_0));
        bf16_t* gu2 = (bf16_t*)(ws + (l ? WS_WGU2_1 : WS_WGU2_0)); bf16_t* d2 = (bf16_t*)(ws + (l ? WS_WD2_1 : WS_WD2_0));
        tr_matrix(a.in[1] + l * WGU, D, DFF, gu1, 1, scr, gw, ngw, lane);
        tr_matrix(a.in[2] + l * WGU, D, DFF, gu1, 2, scr, gw, ngw, lane);
        tr_matrix(a.in[3] + l * WGU, DFF, D, d1, 0, scr, gw, ngw, lane);
        tr_matrix(a.in[4] + l * WGU, D, DFF, gu2, 1, scr, gw, ngw, lane);
        tr_matrix(a.in[5] + l * WGU, D, DFF, gu2, 2, scr, gw, ngw, lane);
        tr_matrix(a.in[6] + l * WGU, DFF, D, d2, 0, scr, gw, ngw, lane);
    }
    tr_matrix(a.in[9], D, AB_IN, (bf16_t*)(ws + WS_WABIN), 0, scr, gw, ngw, lane);
    tr_matrix(a.in[14], D, D, (bf16_t*)(ws + WS_WABOUT), 0, scr, gw, ngw, lane);
    tr_matrix(a.in[15], D, DN_IN, (bf16_t*)(ws + WS_WDNIN), 0, scr, gw, ngw, lane);
    tr_matrix(a.in[20], 4096, D, (bf16_t*)(ws + WS_WDNOUT), 0, scr, gw, ngw, lane);
    { u32x4* p = (u32x4*)((bf16_t*)(ws + WS_WDNIN) + (size_t)DN_IN * D); const int n16 = (DN_IN_PAD - DN_IN) * D / 8;
      for (int i = blockIdx.x * NTHREADS + threadIdx.x; i < n16; i += gridDim.x * NTHREADS) p[i] = (u32x4){0u, 0u, 0u, 0u}; }
    { const f32x4* x4 = (const f32x4*)a.in[0]; u32x2* xb = (u32x2*)(ws + WS_XB); const int n4 = M * D / 4;
      for (int i = blockIdx.x * NTHREADS + threadIdx.x; i < n4; i += gridDim.x * NTHREADS) { const f32x4 v = x4[i]; xb[i] = (u32x2){pk2(v.x, v.y), pk2(v.z, v.w)}; } }
}

DI void ln_phase(float* Y, bf16_t* XB, const float* g, const float* b, int wave, int lane) {
    const int gw = blockIdx.x * NWAVES + wave, ngw = gridDim.x * NWAVES;
    for (int m = gw; m < M; m += ngw) {
        f32x4* yr = (f32x4*)(Y + (size_t)m * D) + lane;
        f32x4 v[8]; float s = 0.f;
#pragma unroll
        for (int j = 0; j < 8; ++j) { v[j] = yr[64 * j]; s += (v[j].x + v[j].y) + (v[j].z + v[j].w); }
        const float mean = wave_sum(s) * (1.f / D); float s2 = 0.f;
#pragma unroll
        for (int j = 0; j < 8; ++j) { v[j] = v[j] - mean; s2 += (v[j].x * v[j].x + v[j].y * v[j].y) + (v[j].z * v[j].z + v[j].w * v[j].w); }
        const float rstd = rsqrtf(wave_sum(s2) * (1.f / D) + LN_EPS);
        u32x2* o8 = (u32x2*)(XB + (size_t)m * D) + lane;
#pragma unroll
        for (int j = 0; j < 8; ++j) { const f32x4 gg = ((const f32x4*)g)[lane + 64 * j], bb = ((const f32x4*)b)[lane + 64 * j];
            const f32x4 o = v[j] * rstd * gg + bb; yr[64 * j] = o; o8[64 * j] = (u32x2){pk2(o.x, o.y), pk2(o.z, o.w)}; }
    }
}

DI void rope_item(const bf16_t* HC, bf16_t* Qr, bf16_t* Kr, bf16_t* Vt, float* kmean, int item, LAS float* red, int tid) {
    const int h = item & 7, blk = (item >> 3) & 7, b = item >> 6, bh = b * 8 + h;
    const int i = tid & 63, rg = tid >> 6;
    const float inv = expf((-9.210340371976184f * (float)i) * 0.015625f);
    float ks0 = 0.f, ks1 = 0.f;
    for (int rr = 0; rr < 32; ++rr) {
        const int pos = blk * 256 + rr * 8 + rg; const size_t row = (size_t)b * SEQ + pos;
        float sn, cs; sincosf((float)pos * inv, &sn, &cs);
        const bf16_t* hp = HC + row * AB_IN + h * 128 + i;
        const float q1 = bf2f(hp[0]), q2 = bf2f(hp[64]), k1 = bf2f(hp[1024]), k2 = bf2f(hp[1024 + 64]);
        const bf16_t v1 = hp[2048], v2 = hp[2048 + 64];
        const float qa = (q1 * cs - q2 * sn) * 0.08838834764831845f, qb = (q2 * cs + q1 * sn) * 0.08838834764831845f;
        const float ka = k1 * cs - k2 * sn, kb = k2 * cs + k1 * sn;
        const size_t o = ((size_t)bh * SEQ + pos) * 128 + i;
        Qr[o] = f2bf(qa); Qr[o + 64] = f2bf(qb); Kr[o] = f2bf(ka); Kr[o + 64] = f2bf(kb);
        ks0 += ka; ks1 += kb;
        Vt[((size_t)bh * 128 + i) * SEQ + pos] = v1; Vt[((size_t)bh * 128 + i + 64) * SEQ + pos] = v2;
    }
    red[rg * 128 + i] = ks0; red[rg * 128 + 64 + i] = ks1;
    __syncthreads();
    if (tid < 128) { float s = 0.f;
#pragma unroll
        for (int g = 0; g < 8; ++g) s += red[g * 128 + tid];
        kmean[((size_t)bh * 8 + blk) * 128 + tid] = s * (1.f / 256.f); }
    __syncthreads();
}

DI void gmlp_item(const bf16_t* HC, const float* lng, const float* lnb, const float* w_s, const float* b_s, bf16_t* CAT, int item, LAS unsigned char* lds, int wave, int lane) {
    const int g = item & 7, c = (item >> 3) & 15, b = item >> 7;
    const size_t row0 = (size_t)b * SEQ + c * 128;
    LAS bf16_t* vnT = (LAS bf16_t*)lds;
    { const float g0 = lng[g * 128 + 2 * lane], g1 = lng[g * 128 + 2 * lane + 1], b0 = lnb[g * 128 + 2 * lane], b1 = lnb[g * 128 + 2 * lane + 1];
      for (int ss = 0; ss < 16; ++ss) { const int s = wave * 16 + ss;
        const unsigned raw = *(const unsigned*)(HC + (row0 + s) * AB_IN + 4096 + g * 128 + 2 * lane);
        const float v0 = gelu_tanh(bflo(raw)), v1 = gelu_tanh(bfhi(raw));
        const float mu = wave_sum(v0 + v1) * (1.f / 128.f); const float d0 = v0 - mu, d1 = v1 - mu;
        const float rstd = rsqrtf(wave_sum(d0 * d0 + d1 * d1) * (1.f / 128.f) + LN_EPS);
        vnT[(2 * lane) * 136 + s] = f2bf(d0 * rstd * g0 + b0); vnT[(2 * lane + 1) * 136 + s] = f2bf(d1 * rstd * g1 + b1); } }
    __syncthreads();
    const int tt = wave >> 1, dh = wave & 1, r32 = lane & 31, hi = lane >> 5;
    f32x16 acc[2];
#pragma unroll
    for (int j = 0; j < 2; ++j)
#pragma unroll
        for (int r = 0; r < 16; ++r) acc[j][r] = 0.f;
    const int t = 32 * tt + r32; const float* wrow = w_s + ((size_t)g * 128 + t) * 128;
    for (int st = 0; st < 2 * (tt + 1); ++st) { const int s0 = 16 * st + 8 * hi;
        const f32x4 w0 = *(const f32x4*)(wrow + s0), w1 = *(const f32x4*)(wrow + s0 + 4);
        const bf16x8 a = pack8(s0 + 0 <= t ? w0.x : 0.f, s0 + 1 <= t ? w0.y : 0.f, s0 + 2 <= t ? w0.z : 0.f, s0 + 3 <= t ? w0.w : 0.f,
                               s0 + 4 <= t ? w1.x : 0.f, s0 + 5 <= t ? w1.y : 0.f, s0 + 6 <= t ? w1.z : 0.f, s0 + 7 <= t ? w1.w : 0.f);
#pragma unroll
        for (int j = 0; j < 2; ++j) { const bf16x8 bv = *(const LAS bf16x8*)(vnT + (32 * (2 * dh + j) + r32) * 136 + s0); acc[j] = MFMA32(a, bv, acc[j]); } }
#pragma unroll
    for (int j = 0; j < 2; ++j) { const int d = 32 * (2 * dh + j) + r32;
#pragma unroll
        for (int r = 0; r < 16; ++r) { const int tq = 32 * tt + crow(r, hi); const size_t row = row0 + tq;
            const float uval = gelu_tanh(bf2f(HC[row * AB_IN + 3072 + g * 128 + d]));
            CAT[row * D + 1024 + g * 128 + d] = f2bf(uval * (acc[j][r] + b_s[g * 128 + tq])); } }
    __syncthreads();
}

DI void moba_wave(const bf16_t* Qr, const bf16_t* Kr, const bf16_t* Vt, const float* kmean, bf16_t* CAT, int bh, int qt, int lane) {
    const int qi = lane & 31, hi = lane >> 5, q0 = qt * 32, own = q0 >> 8, pos = q0 + qi, b = bh >> 3, h = bh & 7;
    bf16x8 qf[8];
    { const bf16_t* qp = Qr + ((size_t)bh * SEQ + pos) * 128 + 8 * hi;
#pragma unroll
      for (int st = 0; st < 8; ++st) qf[st] = *(const bf16x8*)(qp + 16 * st); }
    unsigned selmask = 0u;
    if (own > 0) {
        f32x16 ga;
#pragma unroll
        for (int r = 0; r < 16; ++r) ga[r] = 0.f;
#pragma unroll
        for (int st = 0; st < 8; ++st) { bf16x8 a = (bf16x8){0, 0, 0, 0, 0, 0, 0, 0};
            if (qi < 8) { const float* kp = kmean + ((size_t)bh * 8 + qi) * 128 + 16 * st + 8 * hi; const f32x4 k0 = *(const f32x4*)kp, k1 = *(const f32x4*)(kp + 4);
                a = pack8(k0.x, k0.y, k0.z, k0.w, k1.x, k1.y, k1.z, k1.w); }
            ga = MFMA32(a, qf[st], ga); }
        float g[8];
#pragma unroll
        for (int r = 0; r < 4; ++r) { const float mine = ga[r], other = __shfl_xor(mine, 32); g[r] = hi ? other : mine; g[4 + r] = hi ? mine : other; }
        const int nsel = own < 3 ? own : 3;
#pragma unroll
        for (int j = 0; j < 8; ++j) { int rank = 0;
#pragma unroll
            for (int i2 = 0; i2 < 8; ++i2) if (i2 != j) rank += (i2 < own && (g[i2] > g[j] || (g[i2] == g[j] && i2 < j))) ? 1 : 0;
            if (j < own && rank < nsel) selmask |= 1u << j; }
    }
    f32x16 o[4];
#pragma unroll
    for (int dt = 0; dt < 4; ++dt)
#pragma unroll
        for (int r = 0; r < 16; ++r) o[dt][r] = 0.f;
    float mrun = -INFINITY, lrun = 0.f;
    for (int j = 0; j <= own; ++j) {
        const bool act = (j == own) || ((selmask >> j) & 1u);
        if (__ballot(act) == 0ull) continue;
        const int nkt = (j == own) ? ((q0 & 255) >> 5) + 1 : 8;
        for (int kt = 0; kt < nkt; ++kt) {
            const int key0 = j * 256 + kt * 32;
            f32x16 s;
#pragma unroll
            for (int r = 0; r < 16; ++r) s[r] = 0.f;
            const bf16_t* kp = Kr + ((size_t)bh * SEQ + key0 + qi) * 128 + 8 * hi;
#pragma unroll
            for (int st = 0; st < 8; ++st) s = MFMA32(*(const bf16x8*)(kp + 16 * st), qf[st], s);
            float mt = -INFINITY;
#pragma unroll
            for (int r = 0; r < 16; ++r) { const int key = key0 + crow(r, hi); const bool ok = act && (j < own || key <= pos); s[r] = ok ? s[r] : -INFINITY; mt = fmaxf(mt, s[r]); }
            mt = fmaxf(mt, __shfl_xor(mt, 32));
            const float mnew = fmaxf(mrun, mt), muse = (mnew == -INFINITY) ? 0.f : mnew;
            const float alpha = __expf(mrun - muse);
            float ls = 0.f;
#pragma unroll
            for (int r = 0; r < 16; ++r) { s[r] = __expf(s[r] - muse); ls += s[r]; }
            lrun = lrun * alpha + ls; mrun = mnew;
#pragma unroll
            for (int dt = 0; dt < 4; ++dt)
#pragma unroll
                for (int r = 0; r < 16; ++r) o[dt][r] *= alpha;
#pragma unroll
            for (int sp = 0; sp < 2; ++sp) {
                const bf16x8 pb = pack8(s[8 * sp], s[8 * sp + 1], s[8 * sp + 2], s[8 * sp + 3], s[8 * sp + 4], s[8 * sp + 5], s[8 * sp + 6], s[8 * sp + 7]);
#pragma unroll
                for (int dt = 0; dt < 4; ++dt) { const bf16_t* vp = Vt + ((size_t)bh * 128 + 32 * dt + qi) * SEQ + key0 + 16 * sp + 4 * hi;
                    const u32x2 lo = *(const u32x2*)vp, hh = *(const u32x2*)(vp + 8);
                    const bf16x8 a = __builtin_bit_cast(bf16x8, (u32x4){lo.x, lo.y, hh.x, hh.y});
                    o[dt] = MFMA32(a, pb, o[dt]); }
            }
        }
    }
    const float ltot = lrun + __shfl_xor(lrun, 32), inv = 1.0f / ltot;
    bf16_t* op = CAT + ((size_t)b * SEQ + pos) * D + h * 128;
#pragma unroll
    for (int dt = 0; dt < 4; ++dt)
#pragma unroll
        for (int g4 = 0; g4 < 4; ++g4) { const int d = 32 * dt + 8 * g4 + 4 * hi;
            *(u32x2*)(op + d) = (u32x2){pk2(o[dt][4 * g4] * inv, o[dt][4 * g4 + 1] * inv), pk2(o[dt][4 * g4 + 2] * inv, o[dt][4 * g4 + 3] * inv)}; }
}

DI void dnp_phase(const bf16_t* QKraw, const bf16_t* Vraw, const float* BA, const float* conv_w, const float* a_log, const float* dt_bias,
                  bf16_t* QN, bf16_t* KN, bf16_t* V, float* G, float* BETA, int wave, int lane) {
    const int gw = blockIdx.x * NWAVES + wave, ngw = gridDim.x * NWAVES;
    for (int it = gw; it < BATCH * 64 * 32; it += ngw) {
        const int rc = it & 31, hs = (it >> 5) & 63, b = it >> 11;
        const int ch = hs * 128 + 2 * lane;
        float w0[4], w1[4];
#pragma unroll
        for (int j = 0; j < 4; ++j) { w0[j] = conv_w[j * 8192 + ch]; w1[j] = conv_w[j * 8192 + ch + 1]; }
        const bf16_t* src = hs < 32 ? QKraw + ch : Vraw + (ch - 4096);
        const int t0 = rc * 64;
        float x0[3], x1[3];
#pragma unroll
        for (int j = 0; j < 3; ++j) { const int t = t0 - 3 + j; unsigned raw = 0u; if (t >= 0) raw = *(const unsigned*)(src + ((size_t)b * SEQ + t) * 4096); x0[j] = bflo(raw); x1[j] = bfhi(raw); }
        for (int tt = 0; tt < 64; ++tt) { const size_t row = (size_t)b * SEQ + t0 + tt;
            const unsigned raw = *(const unsigned*)(src + row * 4096); const float c0 = bflo(raw), c1 = bfhi(raw);
            float y0 = x0[0] * w0[0] + x0[1] * w0[1] + x0[2] * w0[2] + c0 * w0[3];
            float y1 = x1[0] * w1[0] + x1[1] * w1[1] + x1[2] * w1[2] + c1 * w1[3];
            x0[0] = x0[1]; x0[1] = x0[2]; x0[2] = c0; x1[0] = x1[1]; x1[1] = x1[2]; x1[2] = c1;
            y0 = pg8::silu_f(y0); y1 = pg8::silu_f(y1);
            if (hs < 32) { const float ss = wave_sum(y0 * y0 + y1 * y1); const float sc = rsqrtf(ss + RMS_EPS) * (hs < 16 ? 0.08838834764831845f : 1.0f);
                bf16_t* dst = (hs < 16 ? QN + row * 2048 + ch : KN + row * 2048 + (ch - 2048)); *(unsigned*)dst = pk2(y0 * sc, y1 * sc); }
            else *(unsigned*)(V + row * 4096 + (ch - 4096)) = pk2(y0, y1);
        }
    }
    for (int i = blockIdx.x * NTHREADS + threadIdx.x; i < M * 32; i += gridDim.x * NTHREADS) { const int row = i >> 5, h = i & 31;
        const float bb = BA[(size_t)row * 64 + h], aa = BA[(size_t)row * 64 + 32 + h];
        BETA[i] = 1.0f / (1.0f + expf(-bb));
        const float x = aa + dt_bias[h]; const float sp = x > 20.f ? x : log1pf(expf(x));
        G[i] = -expf(a_log[h]) * sp; }
}

constexpr int DA_KS = 0, DA_QS = 17408, DA_VBT = 34816, DA_KBGT = 53248, DA_KT = 71680, DA_AM = 90112, DA_TB = 107520, DA_GC = 116736, DA_BT = 116992, DA_EG = 117248;
DI void dna_item(const bf16_t* QN, const bf16_t* KN, const bf16_t* V, const float* G, const float* BETA,
                 bf16_t* Wimg, bf16_t* Uimg, bf16_t* Aimg, bf16_t* Qimg, bf16_t* KTimg, float* EGt, float* DKt, int item, LAS unsigned char* lds, int tid) {
    const int hv = item & 31, n = (item >> 5) & 31, b = item >> 10, hk = hv >> 1;
    const int lane = tid & 63, wave = __builtin_amdgcn_readfirstlane(tid >> 6), r32 = lane & 31, hi = lane >> 5;
    const size_t row0 = (size_t)b * SEQ + n * 64;
    const int itemk = (b * 32 + n) * 16 + hk;
    LAS bf16_t* Ks = (LAS bf16_t*)(lds + DA_KS); LAS bf16_t* Qs = (LAS bf16_t*)(lds + DA_QS);
    LAS bf16_t* vbT = (LAS bf16_t*)(lds + DA_VBT); LAS bf16_t* kbgT = (LAS bf16_t*)(lds + DA_KBGT); LAS bf16_t* kT = (LAS bf16_t*)(lds + DA_KT);
    LAS float* Am = (LAS float*)(lds + DA_AM); LAS bf16_t* Tb = (LAS bf16_t*)(lds + DA_TB);
    LAS float* gcs = (LAS float*)(lds + DA_GC); LAS float* bts = (LAS float*)(lds + DA_BT); LAS float* egs = (LAS float*)(lds + DA_EG);
    if (wave == 0) { float x = G[(row0 + lane) * 32 + hv];
#pragma unroll
        for (int o = 1; o < 64; o <<= 1) { const float t = __shfl_up(x, o); if (lane >= o) x += t; }
        gcs[lane] = x; egs[lane] = __expf(x); bts[lane] = BETA[(row0 + lane) * 32 + hv];
        const float gl = __shfl(x, 63); const int c5 = lane & 31, ti = (((lane >> 5) * 2 + ((c5 >> 2) & 1)) * 16) + (c5 & 3) + 4 * (c5 >> 3);
        EGt[(size_t)item * 64 + ti] = __expf(x); DKt[(size_t)item * 64 + ti] = __expf(gl - x); }
    __syncthreads();
#pragma unroll
    for (int i = 0; i < 2; ++i) { const int p = tid + 512 * i, e = p >> 4, c8 = (p & 15) * 8;
        const float be = bts[e], bg = be * egs[e];
        const u32x4 kr = *(const u32x4*)(KN + (row0 + e) * 2048 + hk * 128 + c8);
        *(LAS u32x4*)(Ks + e * 136 + c8) = kr;
        const u32x4 qr = *(const u32x4*)(QN + (row0 + e) * 2048 + hk * 128 + c8);
        *(LAS u32x4*)(Qs + e * 136 + c8) = qr;
        const u32x4 vr = *(const u32x4*)(V + (row0 + e) * 4096 + hv * 128 + c8);
        const unsigned kw[4] = {kr.x, kr.y, kr.z, kr.w}, vw[4] = {vr.x, vr.y, vr.z, vr.w};
#pragma unroll
        for (int j = 0; j < 4; ++j) {
            kT[(c8 + 2 * j) * 72 + e] = (bf16_t)(kw[j] & 0xffffu); kT[(c8 + 2 * j + 1) * 72 + e] = (bf16_t)(kw[j] >> 16);
            kbgT[(c8 + 2 * j) * 72 + e] = f2bf(bflo(kw[j]) * bg); kbgT[(c8 + 2 * j + 1) * 72 + e] = f2bf(bfhi(kw[j]) * bg);
            vbT[(c8 + 2 * j) * 72 + e] = f2bf(bflo(vw[j]) * be); vbT[(c8 + 2 * j + 1) * 72 + e] = f2bf(bfhi(vw[j]) * be); } }
    __syncthreads();
    if (wave < 3) { const int ct = wave == 0 ? 0 : 1, et = wave == 2 ? 1 : 0;
        f32x16 acc;
#pragma unroll
        for (int r = 0; r < 16; ++r) acc[r] = 0.f;
#pragma unroll
        for (int st = 0; st < 8; ++st) acc = MFMA32(*(const LAS bf16x8*)(Ks + (32 * ct + r32) * 136 + 16 * st + 8 * hi), *(const LAS bf16x8*)(Ks + (32 * et + r32) * 136 + 16 * st + 8 * hi), acc);
        const int e = 32 * et + r32; const float ge = gcs[e];
#pragma unroll
        for (int r = 0; r < 16; ++r) { const int c = 32 * ct + crow(r, hi); Am[c * 68 + e] = (e < c) ? bts[c] * acc[r] * __expf(gcs[c] - ge) : 0.f; }
    } else if (wave < 6) { const int w3 = wave - 3, et = w3 == 2 ? 1 : 0, ct = w3 == 0 ? 0 : 1;
        f32x16 acc;
#pragma unroll
        for (int r = 0; r < 16; ++r) acc[r] = 0.f;
#pragma unroll
        for (int st = 0; st < 8; ++st) acc = MFMA32(*(const LAS bf16x8*)(Ks + (32 * et + r32) * 136 + 16 * st + 8 * hi), *(const LAS bf16x8*)(Qs + (32 * ct + r32) * 136 + 16 * st + 8 * hi), acc);
        const int c = 32 * ct + r32; const float gcc = gcs[c];
#pragma unroll
        for (int r = 0; r < 16; ++r) { const int e = 32 * et + crow(r, hi); acc[r] = (e <= c) ? acc[r] * __expf(gcc - gcs[e]) : 0.f; }
#pragma unroll
        for (int s = 0; s < 2; ++s) *(u32x4*)(Aimg + ((((size_t)item * 4 + ct * 2 + et) * 2 + s) * 512 + lane * 8)) =
            __builtin_bit_cast(u32x4, pack8(acc[8 * s], acc[8 * s + 1], acc[8 * s + 2], acc[8 * s + 3], acc[8 * s + 4], acc[8 * s + 5], acc[8 * s + 6], acc[8 * s + 7]));
    } else if ((hv & 1) == 0) { const int t2 = tid - 384;
#pragma unroll
        for (int i = 0; i < 8; ++i) { const int p = t2 + 128 * i, ln = p & 63, s = (p >> 6) & 1, tl = p >> 7, lr = ln & 31, lh = ln >> 5;
            const int ct = tl >> 2, kt = tl & 3;
            const LAS bf16_t* src = Qs + (32 * ct + lr) * 136 + 32 * kt + 16 * s + 4 * lh;
            const u32x2 lo = *(const LAS u32x2*)src, hh = *(const LAS u32x2*)(src + 8);
            *(u32x4*)(Qimg + ((((size_t)itemk * 8 + tl) * 2 + s) * 512 + ln * 8)) = (u32x4){lo.x, lo.y, hh.x, hh.y}; }
#pragma unroll
        for (int i = 0; i < 8; ++i) { const int p = t2 + 128 * i, ln = p & 63, s = (p >> 6) & 1, tl = p >> 7, lr = ln & 31, lh = ln >> 5;
            const int kt = tl >> 1, ct = tl & 1;
            const LAS bf16_t* src = kT + (32 * kt + lr) * 72 + 32 * ct + 16 * s + 4 * lh;
            const u32x2 lo = *(const LAS u32x2*)src, hh = *(const LAS u32x2*)(src + 8);
            *(u32x4*)(KTimg + ((((size_t)itemk * 8 + tl) * 2 + s) * 512 + ln * 8)) = (u32x4){lo.x, lo.y, hh.x, hh.y}; }
    }
    __syncthreads();
    if (wave == 0) {
        float T[64]; int zoff; asm volatile("v_mov_b32 %0, 0" : "=v"(zoff));
        const LAS float* Amz = Am + zoff;
#pragma unroll
        for (int i = 0; i < 64; ++i) { float acc = (i == lane) ? 1.f : 0.f;
#pragma unroll
            for (int q = 0; q < (i + 3) / 4; ++q) { const f32x4 a4 = *(const LAS f32x4*)(Amz + i * 68 + 4 * q);
                if (4 * q + 0 < i) acc -= a4.x * T[4 * q + 0];
                if (4 * q + 1 < i) acc -= a4.y * T[4 * q + 1];
                if (4 * q + 2 < i) acc -= a4.z * T[4 * q + 2];
                if (4 * q + 3 < i) acc -= a4.w * T[4 * q + 3]; }
            T[i] = acc; Tb[i * 72 + lane] = f2bf(acc); }
    }
    __syncthreads();
    { const int ct = wave >> 2, vt = wave & 3;
        f32x16 acc;
#pragma unroll
        for (int r = 0; r < 16; ++r) acc[r] = 0.f;
        for (int es = 0; es < 2 * (ct + 1); ++es) acc = MFMA32(*(const LAS bf16x8*)(Tb + (32 * ct + r32) * 72 + 16 * es + 8 * hi), *(const LAS bf16x8*)(vbT + (32 * vt + r32) * 72 + 16 * es + 8 * hi), acc);
        bf16_t* dst = Uimg + (((size_t)item * 4 + vt) * 2 + ct) * 1024 + lane * 16;
#pragma unroll
        for (int s = 0; s < 2; ++s) *(u32x4*)(dst + 8 * s) = __builtin_bit_cast(u32x4, pack8(acc[8 * s], acc[8 * s + 1], acc[8 * s + 2], acc[8 * s + 3], acc[8 * s + 4], acc[8 * s + 5], acc[8 * s + 6], acc[8 * s + 7])); }
    { const int kt = wave >> 1, ct = wave & 1;
        f32x16 acc;
#pragma unroll
        for (int r = 0; r < 16; ++r) acc[r] = 0.f;
        for (int es = 0; es < 2 * (ct + 1); ++es) acc = MFMA32(*(const LAS bf16x8*)(kbgT + (32 * kt + r32) * 72 + 16 * es + 8 * hi), *(const LAS bf16x8*)(Tb + (32 * ct + r32) * 72 + 16 * es + 8 * hi), acc);
#pragma unroll
        for (int s = 0; s < 2; ++s) *(u32x4*)(Wimg + ((((size_t)item * 8 + ct * 4 + kt) * 2 + s) * 512 + lane * 8)) =
            __builtin_bit_cast(u32x4, pack8(-acc[8 * s], -acc[8 * s + 1], -acc[8 * s + 2], -acc[8 * s + 3], -acc[8 * s + 4], -acc[8 * s + 5], -acc[8 * s + 6], -acc[8 * s + 7])); }
    __syncthreads();
}

DI f32x16 ld_img16(const bf16_t* p) { const u32x4 a = *(const u32x4*)p, b = *(const u32x4*)(p + 8); f32x16 v;
    v[0] = bflo(a.x); v[1] = bfhi(a.x); v[2] = bflo(a.y); v[3] = bfhi(a.y); v[4] = bflo(a.z); v[5] = bfhi(a.z); v[6] = bflo(a.w); v[7] = bfhi(a.w);
    v[8] = bflo(b.x); v[9] = bfhi(b.x); v[10] = bflo(b.y); v[11] = bfhi(b.y); v[12] = bflo(b.z); v[13] = bfhi(b.z); v[14] = bflo(b.w); v[15] = bfhi(b.w); return v; }
#define PACKS(x, s) pack8((x)[8 * (s)], (x)[8 * (s) + 1], (x)[8 * (s) + 2], (x)[8 * (s) + 3], (x)[8 * (s) + 4], (x)[8 * (s) + 5], (x)[8 * (s) + 6], (x)[8 * (s) + 7])
#define LDF(p) (((const bf16x8*)(p))[lane])
#define DNB_FENCE asm volatile("" ::: "memory")
#define LD_WQ(F, kt) do { F[0] = LDF(Wp + ((0 * 4 + (kt)) * 2 + 0) * 512); F[1] = LDF(Wp + ((0 * 4 + (kt)) * 2 + 1) * 512); F[2] = LDF(Wp + ((1 * 4 + (kt)) * 2 + 0) * 512); F[3] = LDF(Wp + ((1 * 4 + (kt)) * 2 + 1) * 512); \
                          F[4] = LDF(Qp + ((0 * 4 + (kt)) * 2 + 0) * 512); F[5] = LDF(Qp + ((0 * 4 + (kt)) * 2 + 1) * 512); F[6] = LDF(Qp + ((1 * 4 + (kt)) * 2 + 0) * 512); F[7] = LDF(Qp + ((1 * 4 + (kt)) * 2 + 1) * 512); } while (0)
#define CMP_WQ(F, kt) do { const bf16x8 sb0 = PACKS(S[kt], 0), sb1 = PACKS(S[kt], 1); \
        vn[0] = MFMA32(F[0], sb0, vn[0]); vn[1] = MFMA32(F[2], sb0, vn[1]); o[0] = MFMA32(F[4], sb0, o[0]); o[1] = MFMA32(F[6], sb0, o[1]); \
        vn[0] = MFMA32(F[1], sb1, vn[0]); vn[1] = MFMA32(F[3], sb1, vn[1]); o[0] = MFMA32(F[5], sb1, o[0]); o[1] = MFMA32(F[7], sb1, o[1]); } while (0)
#define LD_KT(F, kt0) do { _Pragma("unroll") for (int q_ = 0; q_ < 8; ++q_) F[q_] = LDF(Kp + ((kt0) * 4 + q_) * 512); } while (0)
#define CMP_KT(F, kt0) do { _Pragma("unroll") for (int k_ = 0; k_ < 2; ++k_) { _Pragma("unroll") for (int r_ = 0; r_ < 16; ++r_) S[(kt0) + k_][r_] *= egl; \
        S[(kt0) + k_] = MFMA32(F[4 * k_ + 0], d00, S[(kt0) + k_]); S[(kt0) + k_] = MFMA32(F[4 * k_ + 1], d01, S[(kt0) + k_]); \
        S[(kt0) + k_] = MFMA32(F[4 * k_ + 2], d10, S[(kt0) + k_]); S[(kt0) + k_] = MFMA32(F[4 * k_ + 3], d11, S[(kt0) + k_]); } } while (0)
#define DNB_SETPTR(nn) do { const size_t item_ = ((size_t)b * 32 + (nn)) * 32 + hv, itemk_ = ((size_t)b * 32 + (nn)) * 16 + hk; \
        Wp = Wimg + item_ * 8192; Qp = Qimg + itemk_ * 8192; Kp = KTimg + itemk_ * 8192; Ap = Aimg + item_ * 4096; \
        Up = Uimg + (item_ * 4 + vs) * 2048; Ep = EG + item_ * 64; Dp = DK + item_ * 64; row0 = (size_t)b * SEQ + (nn) * 64; } while (0)
#define LD_U() do { u0 = ((const u32x4*)Up)[2 * lane]; u1 = ((const u32x4*)Up)[2 * lane + 1]; u2 = ((const u32x4*)Up)[128 + 2 * lane]; u3 = ((const u32x4*)Up)[128 + 2 * lane + 1]; } while (0)
#define DNB_CHUNK(F, nn) do { \
        { const unsigned uu0[8] = {u0.x, u0.y, u0.z, u0.w, u1.x, u1.y, u1.z, u1.w}, uu1[8] = {u2.x, u2.y, u2.z, u2.w, u3.x, u3.y, u3.z, u3.w}; \
          _Pragma("unroll") for (int q_ = 0; q_ < 8; ++q_) { vn[0][2 * q_] = bflo(uu0[q_]); vn[0][2 * q_ + 1] = bfhi(uu0[q_]); vn[1][2 * q_] = bflo(uu1[q_]); vn[1][2 * q_ + 1] = bfhi(uu1[q_]); } } \
        _Pragma("unroll") for (int ct = 0; ct < 2; ++ct) _Pragma("unroll") for (int r = 0; r < 16; ++r) o[ct][r] = 0.f; \
        CMP_WQ(F, 0); DNB_FENCE; LD_WQ(F, 1); DNB_FENCE; \
        CMP_WQ(F, 1); DNB_FENCE; LD_WQ(F, 2); DNB_FENCE; \
        CMP_WQ(F, 2); DNB_FENCE; LD_WQ(F, 3); DNB_FENCE; \
        CMP_WQ(F, 3); DNB_FENCE; \
        _Pragma("unroll") for (int q_ = 0; q_ < 2; ++q_) { F[q_] = LDF(Ap + ((0 * 2 + 0) * 2 + q_) * 512); F[2 + q_] = LDF(Ap + ((1 * 2 + 0) * 2 + q_) * 512); F[4 + q_] = LDF(Ap + ((1 * 2 + 1) * 2 + q_) * 512); } \
        float egl; \
        { f32x4 eg[2][4]; _Pragma("unroll") for (int ct = 0; ct < 2; ++ct) _Pragma("unroll") for (int q_ = 0; q_ < 4; ++q_) eg[ct][q_] = ((const f32x4*)Ep)[ct * 8 + hi * 4 + q_]; \
          DNB_FENCE; \
          _Pragma("unroll") for (int ct = 0; ct < 2; ++ct) _Pragma("unroll") for (int r = 0; r < 16; ++r) o[ct][r] *= eg[ct][r >> 2][r & 3]; \
          egl = __shfl(eg[1][3][3], 63); } \
        { const bf16x8 v00 = PACKS(vn[0], 0), v01 = PACKS(vn[0], 1), v10 = PACKS(vn[1], 0), v11 = PACKS(vn[1], 1); \
          o[0] = MFMA32(F[0], v00, o[0]); o[1] = MFMA32(F[2], v00, o[1]); o[0] = MFMA32(F[1], v01, o[0]); o[1] = MFMA32(F[3], v01, o[1]); o[1] = MFMA32(F[4], v10, o[1]); o[1] = MFMA32(F[5], v11, o[1]); } \
        DNB_FENCE; LD_KT(F, 0); \
        { f32x4 dk[2][4]; _Pragma("unroll") for (int ct = 0; ct < 2; ++ct) _Pragma("unroll") for (int q_ = 0; q_ < 4; ++q_) dk[ct][q_] = ((const f32x4*)Dp)[ct * 8 + hi * 4 + q_]; \
          DNB_FENCE; \
          { bf16_t* op_ = OG + (row0 + 4 * hi) * 4096 + hv * 128 + 32 * vs + r32; \
            _Pragma("unroll") for (int ct = 0; ct < 2; ++ct) _Pragma("unroll") for (int g_ = 0; g_ < 4; ++g_) { \
              _Pragma("unroll") for (int i_ = 0; i_ < 4; ++i_) { *op_ = f2bf(o[ct][4 * g_ + i_]); op_ += 4096; asm volatile("" : "+v"(op_)); } \
              op_ += 4 * 4096; asm volatile("" : "+v"(op_)); } } \
          _Pragma("unroll") for (int ct = 0; ct < 2; ++ct) _Pragma("unroll") for (int r = 0; r < 16; ++r) vn[ct][r] *= dk[ct][r >> 2][r & 3]; } \
        { const bf16x8 d00 = PACKS(vn[0], 0), d01 = PACKS(vn[0], 1), d10 = PACKS(vn[1], 0), d11 = PACKS(vn[1], 1); \
          CMP_KT(F, 0); DNB_FENCE; LD_KT(F, 2); DNB_FENCE; CMP_KT(F, 2); DNB_FENCE; } \
        if ((nn) + 1 < 32) { DNB_SETPTR((nn) + 1); LD_WQ(F, 0); LD_U(); } DNB_FENCE; \
    } while (0)
DI void dnb_wave(const bf16_t* Wimg, const bf16_t* Uimg, const bf16_t* Aimg, const bf16_t* Qimg, const bf16_t* KTimg, const float* EG, const float* DK, bf16_t* OG, int bhv, int vs, int lane) {
    const int b = bhv >> 5, hv = bhv & 31, hk = hv >> 1, r32 = lane & 31, hi = lane >> 5;
    f32x16 S[4], vn[2], o[2];
#pragma unroll
    for (int kt = 0; kt < 4; ++kt)
#pragma unroll
        for (int r = 0; r < 16; ++r) S[kt][r] = 0.f;
    const bf16_t *Wp, *Qp, *Kp, *Ap, *Up; const float *Ep, *Dp; size_t row0;
    bf16x8 F[8]; u32x4 u0, u1, u2, u3;
    DNB_SETPTR(0); LD_WQ(F, 0); LD_U();
    for (int n = 0; n < 32; ++n) { DNB_CHUNK(F, n); }
}

DI void dnc_phase(bf16_t* OG, const bf16_t* Z, const float* norm_g, int wave, int lane) {
    const int gw = blockIdx.x * NWAVES + wave, ngw = gridDim.x * NWAVES;
    const float g0 = norm_g[2 * lane], g1 = norm_g[2 * lane + 1];
    for (int it = gw; it < M * 32; it += ngw) { const size_t off = (size_t)it * 128 + 2 * lane;
        const unsigned raw = *(const unsigned*)(OG + off), zr = *(const unsigned*)(Z + off);
        const float o0 = bflo(raw), o1 = bfhi(raw), z0 = bflo(zr), z1 = bfhi(zr);
        const float sc = rsqrtf(wave_sum(o0 * o0 + o1 * o1) * (1.f / 128.f) + RMS_EPS);
        *(unsigned*)(OG + off) = pk2(o0 * sc * g0 * pg8::silu_f(z0), o1 * sc * g1 * pg8::silu_f(z1)); }
}

constexpr int N_PHASES = 25;
DI void gemm_swiglu(LAS unsigned char* lds, const bf16_t* A, const bf16_t* Wt, bf16_t* H) {
    pg8::Gemm g{A, Wt, M, 2 * DFF, D}; pg8::StaticOrder S; S.init(M, 2 * DFF, (int)gridDim.x, (int)blockIdx.x);
    pg8::EpiSwiGLU E{H, DFF};
    pg8::gemm_phase<pg8::EpiSwiGLU, pg8::StaticOrder, true, true>(lds, g, S, E);
}
DI void gemm_resid(LAS unsigned char* lds, const bf16_t* A, const bf16_t* Wt, int K, const float* resid, float* out, float scale) {
    pg8::Gemm g{A, Wt, M, D, K}; pg8::StaticOrder S; S.init(M, D, (int)gridDim.x, (int)blockIdx.x);
    pg8::EpiResid E{resid, out, D, ALPHA, scale};
    pg8::gemm_phase<pg8::EpiResid, pg8::StaticOrder, true, true>(lds, g, S, E);
}
__global__ void __launch_bounds__(NTHREADS, 2) fwd_kernel(Args args) {
    extern __shared__ __attribute__((aligned(16))) unsigned char lds_raw[];
    LAS unsigned char* lds = (LAS unsigned char*)lds_raw;
    cg::grid_group grid = cg::this_grid();
    const int tid = threadIdx.x, lane = tid & 63, wave = __builtin_amdgcn_readfirstlane(tid >> 6);
    const Args* const ap = &args;
    const int lo = args.ph_lo, hi = args.ph_hi;
#define PHASE(k) if (lo <= (k) && (k) < hi && ((k) == lo || (grid.sync(), true)))
#define ARGS_RELOAD() unsigned char* const ws = ap->ws
#define WSP(T, off) ((T*)(ws + (off)))
    PHASE(0) { ARGS_RELOAD(); p0_prologue(*ap, lds, wave, lane); }
    PHASE(1) { ARGS_RELOAD(); gemm_swiglu(lds, WSP(bf16_t, WS_XB), WSP(bf16_t, WS_WGU1_0), WSP(bf16_t, WS_BIG)); }
    PHASE(2) { ARGS_RELOAD(); gemm_resid(lds, WSP(bf16_t, WS_BIG), WSP(bf16_t, WS_WD1_0), DFF, ap->in[0], ap->out, 0.5f); }
    PHASE(3) { ARGS_RELOAD(); ln_phase(ap->out, WSP(bf16_t, WS_XB), ap->in[7] + 0 * D, ap->in[8] + 0 * D, wave, lane); }
    PHASE(4) { ARGS_RELOAD(); pg8::Gemm g{WSP(bf16_t, WS_XB), WSP(bf16_t, WS_WABIN), M, AB_IN, D}; pg8::StaticOrder S; S.init(M, AB_IN, (int)gridDim.x, (int)blockIdx.x);
        pg8::EpiPlain E{WSP(bf16_t, WS_BIG), AB_IN};
        pg8::gemm_phase<pg8::EpiPlain, pg8::StaticOrder, true, true>(lds, g, S, E); }
    PHASE(5) { ARGS_RELOAD();
        for (int it = blockIdx.x; it < 256; it += gridDim.x)
            rope_item(WSP(bf16_t, WS_BIG), WSP(bf16_t, WS_QR), WSP(bf16_t, WS_KR), WSP(bf16_t, WS_VT), WSP(float, WS_KMEAN), it, (LAS float*)lds, tid);
        for (int it = blockIdx.x; it < 512; it += gridDim.x)
            gmlp_item(WSP(bf16_t, WS_BIG), ap->in[10], ap->in[11], ap->in[12], ap->in[13], WSP(bf16_t, WS_CAT), it, lds, wave, lane);
    }
    PHASE(6) { ARGS_RELOAD();
        for (int wg = blockIdx.x; wg < 256; wg += gridDim.x) { const int bh = wg >> 3, sub = wg & 7;
            moba_wave(WSP(bf16_t, WS_QR), WSP(bf16_t, WS_KR), WSP(bf16_t, WS_VT), WSP(float, WS_KMEAN), WSP(bf16_t, WS_CAT), bh, wave * 8 + sub, lane); }
    }
    PHASE(7) { ARGS_RELOAD(); gemm_resid(lds, WSP(bf16_t, WS_CAT), WSP(bf16_t, WS_WABOUT), D, ap->out, ap->out, 1.0f); }
    PHASE(8) { ARGS_RELOAD(); ln_phase(ap->out, WSP(bf16_t, WS_XB), ap->in[7] + 1 * D, ap->in[8] + 1 * D, wave, lane); }
    PHASE(9) { ARGS_RELOAD(); gemm_swiglu(lds, WSP(bf16_t, WS_XB), WSP(bf16_t, WS_WGU2_0), WSP(bf16_t, WS_BIG)); }
    PHASE(10) { ARGS_RELOAD(); gemm_resid(lds, WSP(bf16_t, WS_BIG), WSP(bf16_t, WS_WD2_0), DFF, ap->out, ap->out, 0.5f); }
    PHASE(11) { ARGS_RELOAD(); ln_phase(ap->out, WSP(bf16_t, WS_XB), ap->in[7] + 2 * D, ap->in[8] + 2 * D, wave, lane); }
    PHASE(12) { ARGS_RELOAD(); gemm_swiglu(lds, WSP(bf16_t, WS_XB), WSP(bf16_t, WS_WGU1_1), WSP(bf16_t, WS_BIG)); }
    PHASE(13) { ARGS_RELOAD(); gemm_resid(lds, WSP(bf16_t, WS_BIG), WSP(bf16_t, WS_WD1_1), DFF, ap->out, ap->out, 0.5f); }
    PHASE(14) { ARGS_RELOAD(); ln_phase(ap->out, WSP(bf16_t, WS_XB), ap->in[7] + 3 * D, ap->in[8] + 3 * D, wave, lane); }
    PHASE(15) { ARGS_RELOAD(); pg8::Gemm g{WSP(bf16_t, WS_XB), WSP(bf16_t, WS_WDNIN), M, DN_IN_PAD, D}; pg8::StaticOrder S; S.init(M, DN_IN_PAD, (int)gridDim.x, (int)blockIdx.x);
        pg8::EpiDnIn E{WSP(bf16_t, WS_BIG), WSP(float, WS_BA)};
        pg8::gemm_phase<pg8::EpiDnIn, pg8::StaticOrder, true, true>(lds, g, S, E); }
    PHASE(16) { ARGS_RELOAD(); dnp_phase(WSP(bf16_t, WS_BIG), WSP(bf16_t, WS_BIG) + (size_t)M * 4096, WSP(float, WS_BA), ap->in[16], ap->in[17], ap->in[18],
                          WSP(bf16_t, WS_QN), WSP(bf16_t, WS_KN), WSP(bf16_t, WS_V), WSP(float, WS_G), WSP(float, WS_BETA), wave, lane); }
    PHASE(17) { ARGS_RELOAD();
        for (int it = blockIdx.x; it < 4096; it += gridDim.x)
            dna_item(WSP(bf16_t, WS_QN), WSP(bf16_t, WS_KN), WSP(bf16_t, WS_V), WSP(float, WS_G), WSP(float, WS_BETA),
                     WSP(bf16_t, WS_WIMG), WSP(bf16_t, WS_UIMG), WSP(bf16_t, WS_AIMG), WSP(bf16_t, WS_QIMG), WSP(bf16_t, WS_KTIMG), WSP(float, WS_GC), WSP(float, WS_GC + MiB), it, lds, tid);
    }
    PHASE(18) { ARGS_RELOAD();
        if (wave < 4) for (int it = blockIdx.x; it < 128; it += gridDim.x)
            dnb_wave(WSP(bf16_t, WS_WIMG), WSP(bf16_t, WS_UIMG), WSP(bf16_t, WS_AIMG), WSP(bf16_t, WS_QIMG), WSP(bf16_t, WS_KTIMG), WSP(float, WS_GC), WSP(float, WS_GC + MiB), WSP(bf16_t, WS_OG), it, wave, lane);
    }
    PHASE(19) { ARGS_RELOAD(); dnc_phase(WSP(bf16_t, WS_OG), WSP(bf16_t, WS_BIG) + (size_t)2 * M * 4096, ap->in[19], wave, lane); }
    PHASE(20) { ARGS_RELOAD(); gemm_resid(lds, WSP(bf16_t, WS_OG), WSP(bf16_t, WS_WDNOUT), 4096, ap->out, ap->out, 1.0f); }
    PHASE(21) { ARGS_RELOAD(); ln_phase(ap->out, WSP(bf16_t, WS_XB), ap->in[7] + 4 * D, ap->in[8] + 4 * D, wave, lane); }
    PHASE(22) { ARGS_RELOAD(); gemm_swiglu(lds, WSP(bf16_t, WS_XB), WSP(bf16_t, WS_WGU2_1), WSP(bf16_t, WS_BIG)); }
    PHASE(23) { ARGS_RELOAD(); gemm_resid(lds, WSP(bf16_t, WS_BIG), WSP(bf16_t, WS_WD2_1), DFF, ap->out, ap->out, 0.5f); }
    PHASE(24) { ARGS_RELOAD(); ln_phase(ap->out, WSP(bf16_t, WS_XB), ap->in[7] + 5 * D, ap->in[8] + 5 * D, wave, lane); }
}

extern "C" void kernel_launch(void* const* d_in, const int* in_sizes, int n_in, void* d_out, int out_size, void* d_ws, size_t ws_size, hipStream_t stream) {
    static int grid = 0;
    if (grid == 0) {
        if (n_in != 21 || out_size != M * D || ws_size < WS_END) { fprintf(stderr, "kernel_launch: unexpected shapes (n_in %d out %d ws %zu)\n", n_in, out_size, ws_size); grid = -1; return; }
        int dev = 0, cus = 0, per_cu = 0;
        (void)hipGetDevice(&dev); (void)hipDeviceGetAttribute(&cus, hipDeviceAttributeMultiprocessorCount, dev);
        (void)hipFuncSetAttribute((const void*)fwd_kernel, hipFuncAttributeMaxDynamicSharedMemorySize, LDS_BYTES);
        (void)hipOccupancyMaxActiveBlocksPerMultiprocessor(&per_cu, (const void*)fwd_kernel, NTHREADS, LDS_BYTES);
        if (per_cu < 1) { fprintf(stderr, "kernel_launch: occupancy query says %d blocks/CU\n", per_cu); per_cu = 1; }
        (void)hipGetLastError();
        grid = cus;
    }
    if (grid < 0) return;
    Args a{};
    for (int i = 0; i < 21; ++i) a.in[i] = (const float*)d_in[i];
    a.out = (float*)d_out; a.ws = (unsigned char*)d_ws; a.ph_lo = 0; a.ph_hi = N_PHASES;
    void* kargs[] = {&a};
    hipError_t e = hipLaunchCooperativeKernel((const void*)fwd_kernel, dim3(grid), dim3(NTHREADS), kargs, LDS_BYTES, stream);
    if (e != hipSuccess) fprintf(stderr, "kernel_launch: cooperative launch failed: %s (grid %d)\n", hipGetErrorString(e), grid);
}
```

```cpp
#include <hip/hip_runtime.h>
#include <hip/hip_cooperative_groups.h>
#include <cstdio>
#include <cstdint>
namespace cg = cooperative_groups;
namespace pg8 {
#define PG8_LAS __attribute__((address_space(3)))
typedef unsigned short bf16_t;
typedef short bf16x8 __attribute__((ext_vector_type(8)));
typedef float f32x4 __attribute__((ext_vector_type(4)));
typedef unsigned u32x4 __attribute__((ext_vector_type(4)));
constexpr int BM = 256, BK = 64, HALF = 128, HTB = HALF * BK * 2  , STAGE_BYTES = 8 * HTB, NXCD = 8, WGM = 8;

__host__ __device__ __forceinline__ int lds_byte(int r, int c) { const int st = (r >> 4) * 2 + (c >> 5), rr = r & 15, cc = c & 31, ob = rr * 64 + cc * 2; return st * 1024 + (ob ^ (((ob >> 9) & 1) << 5)); }
__host__ __device__ __forceinline__ void stage_rc(int b, int& R, int& C) { const int st = b / 1024, sb = b % 1024, swz = sb ^ (((sb >> 9) & 1) << 5); R = (st >> 1) * 16 + swz / 64; C = (st & 1) * 32 + (swz % 64) / 2; }
__host__ __device__ __forceinline__ int perm32(int rho) { const int n = rho >> 4, i = rho & 15; return 8 * (i >> 2) + 4 * n + (i & 3); }

struct Unit { int pm, pn; };
struct Gemm { const bf16_t* A; const bf16_t* Bt; int M, N, K; };

struct StaticOrder {
    int nM, nN, nwg, G, c;
    __host__ __device__ void init(int M, int N, int G_, int c_) { nM = M / BM; nN = N / BM; nwg = nM * nN; G = G_; c = c_; }
    __host__ __device__ bool next(int i, Unit& u) const {
        const long L = (long)i * G + c; if (L >= nwg) return false;
        int wgid = (int)L; { const int q = nwg / NXCD, r = nwg % NXCD, xcd = wgid % NXCD, off = wgid / NXCD; wgid = (xcd < r ? xcd * (q + 1) : r * (q + 1) + (xcd - r) * q) + off; }
        const int nig = WGM * nN, gid = wgid / nig, fm = gid * WGM, gsz = (nM - fm) < WGM ? (nM - fm) : WGM;
        u.pm = fm + ((wgid % nig) % gsz); u.pn = (wgid % nig) / gsz; return true;
    }
    __device__ __forceinline__ void a_ready(const Unit&) const {}
    __device__ __forceinline__ void done(const Unit&) const {}
};

__device__ __forceinline__ unsigned cvt_pk_bf16(float lo, float hi) { unsigned r; asm volatile("v_cvt_pk_bf16_f32 %0, %1, %2" : "=v"(r) : "v"(lo), "v"(hi)); return r; }
typedef float f32x2 __attribute__((ext_vector_type(2)));
typedef __bf16 bf16x2_t __attribute__((ext_vector_type(2)));
__device__ __forceinline__ unsigned pk2(float lo, float hi) { f32x2 v = {lo, hi}; bf16x2_t b = __builtin_convertvector(v, bf16x2_t); return __builtin_bit_cast(unsigned, b); }
__device__ __forceinline__ float silu_f(float g) { return g * __builtin_amdgcn_rcpf(1.0f + __expf(-g)); }

struct EpiPlain {
    static constexpr bool PERM = true, AFTER_DRAIN = false;
    bf16_t* O; int ldc;
    __device__ __forceinline__ void operator()(const f32x4 (&acc)[2][2][4][2], const Unit& u, int wr, int wc, int fr, int fq) const {
        const int row0 = u.pm * BM + wr * 64 + fr, col0 = u.pn * BM + wc * 32 + 8 * fq;
#pragma unroll
        for (int ai = 0; ai < 2; ++ai)
#pragma unroll
            for (int m = 0; m < 4; ++m) { bf16_t* rowp = O + (size_t)(row0 + ai * HALF + m * 16) * ldc + col0;
#pragma unroll
                for (int bj = 0; bj < 2; ++bj) { const f32x4 v0 = acc[ai][bj][m][0], v1 = acc[ai][bj][m][1];
                    u32x4 w; w.x = pk2(v0[0], v0[1]); w.y = pk2(v0[2], v0[3]); w.z = pk2(v1[0], v1[1]); w.w = pk2(v1[2], v1[3]);
                    *(u32x4*)(rowp + bj * HALF) = w; } }
    }
};
struct EpiDnIn {
    static constexpr bool PERM = true, AFTER_DRAIN = false;
    bf16_t* O; float* BA;
    __device__ __forceinline__ void operator()(const f32x4 (&acc)[2][2][4][2], const Unit& u, int wr, int wc, int fr, int fq) const {
        const int row0 = u.pm * BM + wr * 64 + fr;
        if (u.pn < 48) {
            bf16_t* base = O + (size_t)(u.pn >> 4) * ((size_t)8192 * 4096);
            const int col0 = (u.pn & 15) * BM + wc * 32 + 8 * fq;
#pragma unroll
            for (int ai = 0; ai < 2; ++ai)
#pragma unroll
                for (int m = 0; m < 4; ++m) { bf16_t* rowp = base + (size_t)(row0 + ai * HALF + m * 16) * 4096 + col0;
#pragma unroll
                    for (int bj = 0; bj < 2; ++bj) { const f32x4 v0 = acc[ai][bj][m][0], v1 = acc[ai][bj][m][1];
                        u32x4 w; w.x = pk2(v0[0], v0[1]); w.y = pk2(v0[2], v0[3]); w.z = pk2(v1[0], v1[1]); w.w = pk2(v1[2], v1[3]);
                        *(u32x4*)(rowp + bj * HALF) = w; } }
        } else if (wc < 2) {
            const int col0 = wc * 32 + 8 * fq;
#pragma unroll
            for (int ai = 0; ai < 2; ++ai)
#pragma unroll
                for (int m = 0; m < 4; ++m) { float* rowp = BA + (size_t)(row0 + ai * HALF + m * 16) * 64 + col0;
                    *(f32x4*)(rowp) = acc[ai][0][m][0]; *(f32x4*)(rowp + 4) = acc[ai][0][m][1]; }
        }
    }
};
struct EpiSwiGLU {
    static constexpr bool PERM = true, AFTER_DRAIN = false;
    bf16_t* O; int ldc;
    __device__ __forceinline__ void operator()(const f32x4 (&acc)[2][2][4][2], const Unit& u, int wr, int wc, int fr, int fq) const {
        const int row0 = u.pm * BM + wr * 64 + fr, col0 = u.pn * HALF + wc * 32 + 8 * fq;
#pragma unroll
        for (int ai = 0; ai < 2; ++ai)
#pragma unroll
            for (int m = 0; m < 4; ++m) { bf16_t* rowp = O + (size_t)(row0 + ai * HALF + m * 16) * ldc + col0;
                const f32x4 g0 = acc[ai][0][m][0], g1 = acc[ai][0][m][1], u0 = acc[ai][1][m][0], u1 = acc[ai][1][m][1];
                u32x4 w;
                w.x = pk2(silu_f(g0[0]) * u0[0], silu_f(g0[1]) * u0[1]); w.y = pk2(silu_f(g0[2]) * u0[2], silu_f(g0[3]) * u0[3]);
                w.z = pk2(silu_f(g1[0]) * u1[0], silu_f(g1[1]) * u1[1]); w.w = pk2(silu_f(g1[2]) * u1[2], silu_f(g1[3]) * u1[3]);
                *(u32x4*)(rowp) = w; }
    }
};
struct EpiResid {
    static constexpr bool PERM = false, AFTER_DRAIN = false;
    const float* resid; float* out; int ldc; float alpha, scale;
    __device__ __forceinline__ void operator()(const f32x4 (&acc)[2][2][4][2], const Unit& u, int wr, int wc, int fr, int fq) const {
        const int col0 = u.pn * BM + wc * 32 + 4 * fq;
#pragma unroll
        for (int ai = 0; ai < 2; ++ai)
#pragma unroll
            for (int m = 0; m < 4; ++m) { const size_t off = (size_t)(u.pm * BM + ai * HALF + wr * 64 + m * 16 + fr) * ldc + col0;
                f32x4 rv[2][2];
#pragma unroll
                for (int bj = 0; bj < 2; ++bj)
#pragma unroll
                    for (int n = 0; n < 2; ++n) rv[bj][n] = *(const f32x4*)(resid + off + bj * HALF + n * 16);
#pragma unroll
                for (int bj = 0; bj < 2; ++bj)
#pragma unroll
                    for (int n = 0; n < 2; ++n) *(f32x4*)(out + off + bj * HALF + n * 16) = rv[bj][n] * alpha + acc[ai][bj][m][n] * scale;
                asm volatile("" ::: "memory"); }
    }
};
template <class Epi, class Sched, bool ALIGN_EPI = false, bool SP2 = false>
__device__ __forceinline__ void gemm_phase(PG8_LAS unsigned char* lds, const Gemm g, const Sched& S, const Epi& E) {
    const int tid = threadIdx.x, wid = __builtin_amdgcn_readfirstlane(tid >> 6), lane = tid & 63, wr = wid >> 2, wc = wid & 3, fr = lane & 15, fq = lane >> 4;
    const int K = g.K, nt = K / BK;
    unsigned voffA[2], voffB[2];
#pragma unroll
    for (int i = 0; i < 2; ++i) { int R, C; stage_rc(tid * 16 + i * 8192, R, C); const int Rb = Epi::PERM ? ((R & ~31) + perm32(R & 31)) : R;
        voffA[i] = (unsigned)(R * K + C) * 2u; voffB[i] = (unsigned)(Rb * K + C) * 2u; }
    const size_t kstep = (size_t)(BK * 2);
    const size_t hstep = (size_t)HALF * K * 2;
    const size_t tstep = 2 * hstep;
    const unsigned ldsw = (unsigned)wid * 1024u;
    const int aoff = lds_byte(wr * 64 + fr, fq * 8), boff = lds_byte(wc * 32 + fr, fq * 8);
#define PG8_SA(b, h) (((b) * 2 + (h)) * HTB)
#define PG8_SB(b, h) ((4 + (b) * 2 + (h)) * HTB)
#define PG8_STAGE(bufoff, gbase, voff) do { _Pragma("unroll") for (int _i = 0; _i < 2; ++_i) \
        __builtin_amdgcn_global_load_lds((const unsigned*)((const char*)(gbase) + (voff)[_i]), (PG8_LAS unsigned*)(lds + (bufoff) + ldsw + _i * 8192), 16, 0, 0); } while (0)
#define PG8_LDA(dst, b, h) do { _Pragma("unroll") for (int m = 0; m < 4; ++m) _Pragma("unroll") for (int k = 0; k < 2; ++k) dst[m][k] = *(const PG8_LAS bf16x8*)(lds + PG8_SA(b, h) + aoff + m * 2048 + k * 1024); } while (0)
#define PG8_LDB(dst, b, h) do { _Pragma("unroll") for (int n = 0; n < 2; ++n) _Pragma("unroll") for (int k = 0; k < 2; ++k) dst[n][k] = *(const PG8_LAS bf16x8*)(lds + PG8_SB(b, h) + boff + n * 2048 + k * 1024); } while (0)
#define PG8_MMA(ai, bj, At, Bt) do { __builtin_amdgcn_s_setprio(1); _Pragma("unroll") for (int m = 0; m < 4; ++m) _Pragma("unroll") for (int n = 0; n < 2; ++n) _Pragma("unroll") for (int k = 0; k < 2; ++k) \
        acc[ai][bj][m][n] = __builtin_amdgcn_mfma_f32_16x16x32_bf16(Bt[n][k], At[m][k], acc[ai][bj][m][n], 0, 0, 0); __builtin_amdgcn_s_setprio(0); } while (0)
#define PG8_WAIT_V(n) asm volatile("s_waitcnt vmcnt(" #n ")" ::: "memory")
#define PG8_WAIT_L(n) asm volatile("s_waitcnt lgkmcnt(" #n ")" ::: "memory")
#define PG8_BAR __builtin_amdgcn_s_barrier()
#define PG8_SCHED __builtin_amdgcn_sched_barrier(0)
    Unit cur, nxt; int ui = 0;
    if (!S.next(0, cur)) return;
    f32x4 acc[2][2][4][2];
#pragma unroll
    for (int a = 0; a < 2; ++a)
#pragma unroll
        for (int b = 0; b < 2; ++b)
#pragma unroll
            for (int m = 0; m < 4; ++m)
#pragma unroll
                for (int n = 0; n < 2; ++n) acc[a][b][m][n] = (f32x4){0.f, 0.f, 0.f, 0.f};
    bf16x8 At[4][2], B0[2][2], B1[2][2];
    const char* cA = (const char*)g.A + (size_t)cur.pm * tstep; const char* cB = (const char*)g.Bt + (size_t)cur.pn * tstep;
    S.a_ready(cur);
    if constexpr (SP2) {
        PG8_STAGE(PG8_SB(0, 0), cB, voffB); PG8_STAGE(PG8_SB(0, 1), cB + hstep, voffB); PG8_STAGE(PG8_SA(0, 0), cA, voffA); PG8_STAGE(PG8_SA(0, 1), cA + hstep, voffA);
        if (wr == 1) PG8_BAR;
        PG8_WAIT_V(2); PG8_BAR;
        PG8_STAGE(PG8_SB(1, 0), cB + kstep, voffB); PG8_STAGE(PG8_SA(1, 0), cA + kstep, voffA); PG8_STAGE(PG8_SB(1, 1), cB + hstep + kstep, voffB);
        PG8_WAIT_V(6); PG8_BAR;
    } else {
        PG8_STAGE(PG8_SB(0, 0), cB, voffB); PG8_STAGE(PG8_SA(0, 0), cA, voffA); PG8_STAGE(PG8_SB(0, 1), cB + hstep, voffB); PG8_STAGE(PG8_SA(0, 1), cA + hstep, voffA);
        if (wr == 1) PG8_BAR;
        PG8_WAIT_V(4); PG8_BAR;
        PG8_STAGE(PG8_SB(1, 0), cB + kstep, voffB); PG8_STAGE(PG8_SA(1, 0), cA + kstep, voffA); PG8_STAGE(PG8_SB(1, 1), cB + hstep + kstep, voffB);
        PG8_WAIT_V(6); PG8_BAR;
    }
    for (;;) {
        const bool has_next = S.next(ui + 1, nxt);
        const char* nA = has_next ? (const char*)g.A + (size_t)nxt.pm * tstep : cA; const char* nB = has_next ? (const char*)g.Bt + (size_t)nxt.pn * tstep : cB;
        for (int t = 0; t < nt; t += 2) {
            const bool last = (t == nt - 2);
            const char* a1 = cA + (size_t)(t + 1) * kstep;
            const char* a2 = last ? nA : cA + (size_t)(t + 2) * kstep; const char* b2 = last ? nB : cB + (size_t)(t + 2) * kstep;
            const char* a3 = a2 + kstep; const char* b3 = b2 + kstep;
            if (last && has_next) S.a_ready(nxt);
            if constexpr (SP2) {
            PG8_LDB(B0, 0, 0); PG8_LDB(B1, 0, 1); PG8_SCHED; PG8_LDA(At, 0, 0); PG8_STAGE(PG8_SA(1, 1), a1 + hstep, voffA);
            PG8_WAIT_V(8); PG8_WAIT_L(0); PG8_BAR; PG8_MMA(0, 0, At, B0); PG8_MMA(0, 1, At, B1); PG8_BAR; PG8_SCHED;
            PG8_LDA(At, 0, 1); PG8_STAGE(PG8_SB(0, 0), b2, voffB); PG8_STAGE(PG8_SB(0, 1), b2 + hstep, voffB); PG8_STAGE(PG8_SA(0, 0), a2, voffA);
            PG8_WAIT_V(8); PG8_WAIT_L(0); PG8_BAR; PG8_MMA(1, 0, At, B0); PG8_MMA(1, 1, At, B1); PG8_BAR; PG8_SCHED;
            PG8_LDB(B0, 1, 0); PG8_LDB(B1, 1, 1); PG8_SCHED; PG8_LDA(At, 1, 0); PG8_STAGE(PG8_SA(0, 1), a2 + hstep, voffA);
            PG8_WAIT_V(8); PG8_WAIT_L(0); PG8_BAR; PG8_MMA(0, 0, At, B0); PG8_MMA(0, 1, At, B1); PG8_BAR; PG8_SCHED;
            PG8_LDA(At, 1, 1); PG8_STAGE(PG8_SB(1, 0), b3, voffB); PG8_STAGE(PG8_SB(1, 1), b3 + hstep, voffB); PG8_STAGE(PG8_SA(1, 0), a3, voffA);
            PG8_WAIT_V(8); PG8_WAIT_L(0); PG8_BAR; PG8_MMA(1, 0, At, B0); PG8_MMA(1, 1, At, B1); PG8_BAR; PG8_SCHED;
            } else {
            PG8_LDB(B0, 0, 0); PG8_SCHED; PG8_LDA(At, 0, 0); PG8_STAGE(PG8_SA(1, 1), a1 + hstep, voffA);
            PG8_WAIT_L(8); PG8_BAR; PG8_WAIT_L(0); PG8_MMA(0, 0, At, B0); PG8_BAR; PG8_SCHED;
            PG8_LDB(B1, 0, 1); PG8_STAGE(PG8_SB(0, 0), b2, voffB);
            PG8_BAR; PG8_WAIT_L(0); PG8_MMA(0, 1, At, B1); PG8_BAR;
            PG8_LDA(At, 0, 1); PG8_STAGE(PG8_SA(0, 0), a2, voffA);
            PG8_BAR; PG8_WAIT_L(0); PG8_MMA(1, 0, At, B0); PG8_BAR; PG8_SCHED;
            PG8_STAGE(PG8_SB(0, 1), b2 + hstep, voffB);
            PG8_WAIT_V(6); PG8_BAR; PG8_MMA(1, 1, At, B1); PG8_BAR;
            PG8_LDB(B0, 1, 0); PG8_SCHED; PG8_LDA(At, 1, 0); PG8_STAGE(PG8_SA(0, 1), a2 + hstep, voffA);
            PG8_WAIT_L(8); PG8_BAR; PG8_WAIT_L(0); PG8_MMA(0, 0, At, B0); PG8_BAR; PG8_SCHED;
            PG8_LDB(B1, 1, 1); PG8_STAGE(PG8_SB(1, 0), b3, voffB);
            PG8_BAR; PG8_WAIT_L(0); PG8_MMA(0, 1, At, B1); PG8_BAR;
            PG8_LDA(At, 1, 1); PG8_STAGE(PG8_SA(1, 0), a3, voffA);
            PG8_BAR; PG8_WAIT_L(0); PG8_MMA(1, 0, At, B0); PG8_BAR; PG8_SCHED;
            PG8_STAGE(PG8_SB(1, 1), b3 + hstep, voffB);
            PG8_WAIT_V(6); PG8_BAR; PG8_MMA(1, 1, At, B1); PG8_BAR;
            }
        }
        if constexpr (ALIGN_EPI) { if (wr == 0) PG8_BAR; }
        if constexpr (!Epi::AFTER_DRAIN) { E(acc, cur, wr, wc, fr, fq); S.done(cur); }
        if (!has_next) break;
#pragma unroll
        for (int a = 0; a < 2; ++a)
#pragma unroll
            for (int b = 0; b < 2; ++b)
#pragma unroll
                for (int m = 0; m < 4; ++m)
#pragma unroll
                    for (int n = 0; n < 2; ++n) acc[a][b][m][n] = (f32x4){0.f, 0.f, 0.f, 0.f};
        cur = nxt; cA = nA; cB = nB; ++ui;
        if constexpr (ALIGN_EPI) { if (wr == 1) PG8_BAR; }
    }
    PG8_WAIT_V(0);
    if constexpr (!ALIGN_EPI) { if (wr == 0) PG8_BAR; }
    PG8_BAR;
    if constexpr (Epi::AFTER_DRAIN) { E.fused(acc, cur, wr, wc, fr, fq, lds, wid, lane); S.done(cur); }
#undef PG8_SA
#undef PG8_SB
#undef PG8_STAGE
#undef PG8_LDA
#undef PG8_LDB
#undef PG8_MMA
#undef PG8_WAIT_V
#undef PG8_WAIT_L
#undef PG8_BAR
#undef PG8_SCHED
}
}
#define LAS __attribute__((address_space(3)))
#define DI __device__ __forceinline__
typedef unsigned short bf16_t;
typedef short bf16x8 __attribute__((ext_vector_type(8)));
typedef float f32x4 __attribute__((ext_vector_type(4)));
typedef float f32x16 __attribute__((ext_vector_type(16)));
typedef unsigned u32x4 __attribute__((ext_vector_type(4)));
typedef unsigned u32x2 __attribute__((ext_vector_type(2)));
using pg8::pk2;

constexpr int NWAVES = 8, NTHREADS = 512;
constexpr int D = 2048, BATCH = 4, SEQ = 2048, M = BATCH * SEQ, DFF = 5632;
constexpr int AB_IN = 5120, DN_IN = 12352, DN_IN_PAD = 12544;
constexpr float ALPHA = 1.41421356237f;
constexpr float LN_EPS = 1e-5f, RMS_EPS = 1e-6f;
constexpr size_t MiB = (size_t)1 << 20;
constexpr size_t WS_L0 = 0;
constexpr size_t WS_WGU1_0 = 0, WS_WD1_0 = 44 * MiB, WS_WGU2_0 = 66 * MiB, WS_WD2_0 = 110 * MiB, WS_WABIN = 132 * MiB, WS_WABOUT = 152 * MiB;
constexpr size_t WS_WGU1_1 = 160 * MiB, WS_WD1_1 = 204 * MiB, WS_WGU2_1 = 226 * MiB, WS_WD2_1 = 270 * MiB, WS_WDNIN = 292 * MiB, WS_WDNOUT = 341 * MiB;
constexpr size_t WS_XB = 357 * MiB;
constexpr size_t WS_BIG = 389 * MiB;
constexpr size_t WS_BA = WS_BIG + 192 * MiB;
constexpr size_t WS_DNX = 585 * MiB;
constexpr size_t WS_QR = WS_DNX, WS_KR = WS_DNX + 16 * MiB, WS_VT = WS_DNX + 32 * MiB, WS_CAT = WS_DNX + 48 * MiB, WS_KMEAN = WS_DNX + 80 * MiB;
constexpr size_t WS_QN = WS_DNX, WS_KN = WS_DNX + 32 * MiB, WS_V = WS_DNX + 64 * MiB, WS_G = WS_DNX + 128 * MiB, WS_BETA = WS_DNX + 129 * MiB;
constexpr size_t WS_OG = WS_L0;
constexpr size_t WS_WIMG = WS_BIG, WS_UIMG = WS_BIG + 64 * MiB;
constexpr size_t WS_AIMG = WS_L0 + 64 * MiB, WS_QIMG = WS_L0 + 96 * MiB, WS_KTIMG = WS_L0 + 128 * MiB;
constexpr size_t WS_GC = 715 * MiB;
constexpr size_t WS_BAR = 717 * MiB, BAR_BYTES = 16384;
constexpr size_t WS_END = 718 * MiB;
constexpr int LDS_BYTES = 147456;

DI float bflo(unsigned u) { return __uint_as_float(u << 16); }
DI float bfhi(unsigned u) { return __uint_as_float(u & 0xffff0000u); }
DI float bf2f(bf16_t h) { return __uint_as_float((unsigned)h << 16); }
DI bf16_t f2bf(float f) { return (bf16_t)(pk2(f, 0.f) & 0xffffu); }
DI float wave_sum(float v) {
#pragma unroll
    for (int o = 1; o < 64; o <<= 1) v += __shfl_xor(v, o);
    return v;
}
DI float gelu_tanh(float x) { const float t = 1.5957691216f * (x + 0.044715f * x * x * x); return x * __builtin_amdgcn_rcpf(1.0f + __expf(-t)); }
DI int crow(int r, int h) { return (r & 3) + 8 * (r >> 2) + 4 * h; }
#define MFMA32(a, b, c) __builtin_amdgcn_mfma_f32_32x32x16_bf16((a), (b), (c), 0, 0, 0)
DI bf16x8 pack8(float a0, float a1, float a2, float a3, float a4, float a5, float a6, float a7) {
    u32x4 p; p.x = pk2(a0, a1); p.y = pk2(a2, a3); p.z = pk2(a4, a5); p.w = pk2(a6, a7); return __builtin_bit_cast(bf16x8, p);
}

DI void tr_tile(const float* __restrict__ W, int K, int N, bf16_t* __restrict__ WT, int k0, int n0, int drow0, LAS float* scr, int lane) {
#pragma unroll 4
    for (int i = 0; i < 16; ++i) { const int kk = 4 * i + (lane >> 4), c4 = (lane & 15) * 4;
        const f32x4 v = *(const f32x4*)(W + (size_t)(k0 + kk) * N + n0 + c4);
        LAS float* s = scr + kk * 65 + c4; s[0] = v.x; s[1] = v.y; s[2] = v.z; s[3] = v.w; }
    asm volatile("s_waitcnt lgkmcnt(0)" ::: "memory");
    const int c = lane & 7;
#pragma unroll
    for (int j = 0; j < 8; ++j) { const int n = (lane >> 3) + 8 * j; const LAS float* s = scr + (8 * c) * 65 + n;
        u32x4 o; o.x = pk2(s[0], s[65]); o.y = pk2(s[2 * 65], s[3 * 65]); o.z = pk2(s[4 * 65], s[5 * 65]); o.w = pk2(s[6 * 65], s[7 * 65]);
        *(u32x4*)(WT + (size_t)(drow0 + n) * K + k0 + 8 * c) = o; }
    asm volatile("s_waitcnt lgkmcnt(0)" ::: "memory");
}
DI void tr_matrix(const float* W, int K, int N, bf16_t* WT, int mode, LAS float* scr, int gw, int ngw, int lane) {
    const int nb = N / 64, items = (K / 64) * nb;
    for (int it = gw; it < items; it += ngw) {
        const int kb = it / nb, n0 = (it % nb) * 64;
        const int drow0 = mode == 0 ? n0 : ((n0 >> 7) * 256 + (n0 & 127) + (mode == 2 ? 128 : 0));
        tr_tile(W, K, N, WT, kb * 64, n0, drow0, scr, lane);
    }
}

struct Args { const float* in[21]; float* out; unsigned char* ws; int ph_lo, ph_hi; };

DI void p0_prologue(const Args& a, LAS unsigned char* lds, int wave, int lane) {
    LAS float* scr = (LAS float*)(lds + wave * 17408);
    const int gw = blockIdx.x * NWAVES + wave, ngw = gridDim.x * NWAVES;
    unsigned char* ws = a.ws;
    const size_t WGU = (size_t)D * DFF;
    for (int l = 0; l < 2; ++l) {
        bf16_t* gu1 = (bf16_t*)(ws + (l ? WS_WGU1_1 : WS_WGU1_0)); bf16_t* d1 = (bf16_t*)(ws + (l ? WS_WD1_1 : WS_WD1_0));
        bf16_t* gu2 = (bf16_t*)(ws + (l ? WS_WGU2_1 : WS_WGU2_0)); bf16_t* d2 = (bf16_t*)(ws + (l ? WS_WD2_1 : WS_WD2_0));
        tr_matrix(a.in[1] + l * WGU, D, DFF, gu1, 1, scr, gw, ngw, lane);
        tr_matrix(a.in[2] + l * WGU, D, DFF, gu1, 2, scr, gw, ngw, lane);
        tr_matrix(a.in[3] + l * WGU, DFF, D, d1, 0, scr, gw, ngw, lane);
        tr_matrix(a.in[4] + l * WGU, D, DFF, gu2, 1, scr, gw, ngw, lane);
        tr_matrix(a.in[5] + l * WGU, D, DFF, gu2, 2, scr, gw, ngw, lane);
        tr_matrix(a.in[6] + l * WGU, DFF, D, d2, 0, scr, gw, ngw, lane);
    }
    tr_matrix(a.in[9], D, AB_IN, (bf16_t*)(ws + WS_WABIN), 0, scr, gw, ngw, lane);
    tr_matrix(a.in[14], D, D, (bf16_t*)(ws + WS_WABOUT), 0, scr, gw, ngw, lane);
    tr_matrix(a.in[15], D, DN_IN, (bf16_t*)(ws + WS_WDNIN), 0, scr, gw, ngw, lane);
    tr_matrix(a.in[20], 4096, D, (bf16_t*)(ws + WS_WDNOUT), 0, scr, gw, ngw, lane);
    { u32x4* p = (u32x4*)((bf16_t*)(ws + WS_WDNIN) + (size_t)DN_IN * D); const int n16 = (DN_IN_PAD - DN_IN) * D / 8;
      for (int i = blockIdx.x * NTHREADS + threadIdx.x; i < n16; i += gridDim.x * NTHREADS) p[i] = (u32x4){0u, 0u, 0u, 0u}; }
    { const f32x4* x4 = (const f32x4*)a.in[0]; u32x2* xb = (u32x2*)(ws + WS_XB); const int n4 = M * D / 4;
      for (int i = blockIdx.x * NTHREADS + threadIdx.x; i < n4; i += gridDim.x * NTHREADS) { const f32x4 v = x4[i]; xb[i] = (u32x2){pk2(v.x, v.y), pk2(v.z, v.w)}; } }
}

DI void ln_phase(float* Y, bf16_t* XB, const float* g, const float* b, int wave, int lane) {
    const int gw = blockIdx.x * NWAVES + wave, ngw = gridDim.x * NWAVES;
    for (int m = gw; m < M; m += ngw) {
        f32x4* yr = (f32x4*)(Y + (size_t)m * D) + lane;
        f32x4 v[8]; float s = 0.f;
#pragma unroll
        for (int j = 0; j < 8; ++j) { v[j] = yr[64 * j]; s += (v[j].x + v[j].y) + (v[j].z + v[j].w); }
        const float mean = wave_sum(s) * (1.f / D); float s2 = 0.f;
#pragma unroll
        for (int j = 0; j < 8; ++j) { v[j] = v[j] - mean; s2 += (v[j].x * v[j].x + v[j].y * v[j].y) + (v[j].z * v[j].z + v[j].w * v[j].w); }
        const float rstd = rsqrtf(wave_sum(s2) * (1.f / D) + LN_EPS);
        u32x2* o8 = (u32x2*)(XB + (size_t)m * D) + lane;
#pragma unroll
        for (int j = 0; j < 8; ++j) { const f32x4 gg = ((const f32x4*)g)[lane + 64 * j], bb = ((const f32x4*)b)[lane + 64 * j];
            const f32x4 o = v[j] * rstd * gg + bb; yr[64 * j] = o; o8[64 * j] = (u32x2){pk2(o.x, o.y), pk2(o.z, o.w)}; }
    }
}

DI void rope_item(const bf16_t* HC, bf16_t* Qr, bf16_t* Kr, bf16_t* Vt, float* kmean, int item, LAS float* red, int tid) {
    const int h = item & 7, blk = (item >> 3) & 7, b = item >> 6, bh = b * 8 + h;
    const int i = tid & 63, rg = tid >> 6;
    const float inv = expf((-9.210340371976184f * (float)i) * 0.015625f);
    float ks0 = 0.f, ks1 = 0.f;
    for (int rr = 0; rr < 32; ++rr) {
        const int pos = blk * 256 + rr * 8 + rg; const size_t row = (size_t)b * SEQ + pos;
        float sn, cs; sincosf((float)pos * inv, &sn, &cs);
        const bf16_t* hp = HC + row * AB_IN + h * 128 + i;
        const float q1 = bf2f(hp[0]), q2 = bf2f(hp[64]), k1 = bf2f(hp[1024]), k2 = bf2f(hp[1024 + 64]);
        const bf16_t v1 = hp[2048], v2 = hp[2048 + 64];
        const float qa = (q1 * cs - q2 * sn) * 0.08838834764831845f, qb = (q2 * cs + q1 * sn) * 0.08838834764831845f;
        const float ka = k1 * cs - k2 * sn, kb = k2 * cs + k1 * sn;
        const size_t o = ((size_t)bh * SEQ + pos) * 128 + i;
        Qr[o] = f2bf(qa); Qr[o + 64] = f2bf(qb); Kr[o] = f2bf(ka); Kr[o + 64] = f2bf(kb);
        ks0 += ka; ks1 += kb;
        Vt[((size_t)bh * 128 + i) * SEQ + pos] = v1; Vt[((size_t)bh * 128 + i + 64) * SEQ + pos] = v2;
    }
    red[rg * 128 + i] = ks0; red[rg * 128 + 64 + i] = ks1;
    __syncthreads();
    if (tid < 128) { float s = 0.f;
#pragma unroll
        for (int g = 0; g < 8; ++g) s += red[g * 128 + tid];
        kmean[((size_t)bh * 8 + blk) * 128 + tid] = s * (1.f / 256.f); }
    __syncthreads();
}

DI void gmlp_item(const bf16_t* HC, const float* lng, const float* lnb, const float* w_s, const float* b_s, bf16_t* CAT, int item, LAS unsigned char* lds, int wave, int lane) {
    const int g = item & 7, c = (item >> 3) & 15, b = item >> 7;
    const size_t row0 = (size_t)b * SEQ + c * 128;
    LAS bf16_t* vnT = (LAS bf16_t*)lds;
    { const float g0 = lng[g * 128 + 2 * lane], g1 = lng[g * 128 + 2 * lane + 1], b0 = lnb[g * 128 + 2 * lane], b1 = lnb[g * 128 + 2 * lane + 1];
      for (int ss = 0; ss < 16; ++ss) { const int s = wave * 16 + ss;
        const unsigned raw = *(const unsigned*)(HC + (row0 + s) * AB_IN + 4096 + g * 128 + 2 * lane);
        const float v0 = gelu_tanh(bflo(raw)), v1 = gelu_tanh(bfhi(raw));
        const float mu = wave_sum(v0 + v1) * (1.f / 128.f); const float d0 = v0 - mu, d1 = v1 - mu;
        const float rstd = rsqrtf(wave_sum(d0 * d0 + d1 * d1) * (1.f / 128.f) + LN_EPS);
        vnT[(2 * lane) * 136 + s] = f2bf(d0 * rstd * g0 + b0); vnT[(2 * lane + 1) * 136 + s] = f2bf(d1 * rstd * g1 + b1); } }
    __syncthreads();
    const int tt = wave >> 1, dh = wave & 1, r32 = lane & 31, hi = lane >> 5;
    f32x16 acc[2];
#pragma unroll
    for (int j = 0; j < 2; ++j)
#pragma unroll
        for (int r = 0; r < 16; ++r) acc[j][r] = 0.f;
    const int t = 32 * tt + r32; const float* wrow = w_s + ((size_t)g * 128 + t) * 128;
    for (int st = 0; st < 2 * (tt + 1); ++st) { const int s0 = 16 * st + 8 * hi;
        const f32x4 w0 = *(const f32x4*)(wrow + s0), w1 = *(const f32x4*)(wrow + s0 + 4);
        const bf16x8 a = pack8(s0 + 0 <= t ? w0.x : 0.f, s0 + 1 <= t ? w0.y : 0.f, s0 + 2 <= t ? w0.z : 0.f, s0 + 3 <= t ? w0.w : 0.f,
                               s0 + 4 <= t ? w1.x : 0.f, s0 + 5 <= t ? w1.y : 0.f, s0 + 6 <= t ? w1.z : 0.f, s0 + 7 <= t ? w1.w : 0.f);
#pragma unroll
        for (int j = 0; j < 2; ++j) { const bf16x8 bv = *(const LAS bf16x8*)(vnT + (32 * (2 * dh + j) + r32) * 136 + s0); acc[j] = MFMA32(a, bv, acc[j]); } }
#pragma unroll
    for (int j = 0; j < 2; ++j) { const int d = 32 * (2 * dh + j) + r32;
#pragma unroll
        for (int r = 0; r < 16; ++r) { const int tq = 32 * tt + crow(r, hi); const size_t row = row0 + tq;
            const float uval = gelu_tanh(bf2f(HC[row * AB_IN + 3072 + g * 128 + d]));
            CAT[row * D + 1024 + g * 128 + d] = f2bf(uval * (acc[j][r] + b_s[g * 128 + tq])); } }
    __syncthreads();
}

DI void moba_wave(const bf16_t* Qr, const bf16_t* Kr, const bf16_t* Vt, const float* kmean, bf16_t* CAT, int bh, int qt, int lane) {
    const int qi = lane & 31, hi = lane >> 5, q0 = qt * 32, own = q0 >> 8, pos = q0 + qi, b = bh >> 3, h = bh & 7;
    bf16x8 qf[8];
    { const bf16_t* qp = Qr + ((size_t)bh * SEQ + pos) * 128 + 8 * hi;
#pragma unroll
      for (int st = 0; st < 8; ++st) qf[st] = *(const bf16x8*)(qp + 16 * st); }
    unsigned selmask = 0u;
    if (own > 0) {
        f32x16 ga;
#pragma unroll
        for (int r = 0; r < 16; ++r) ga[r] = 0.f;
#pragma unroll
        for (int st = 0; st < 8; ++st) { bf16x8 a = (bf16x8){0, 0, 0, 0, 0, 0, 0, 0};
            if (qi < 8) { const float* kp = kmean + ((size_t)bh * 8 + qi) * 128 + 16 * st + 8 * hi; const f32x4 k0 = *(const f32x4*)kp, k1 = *(const f32x4*)(kp + 4);
                a = pack8(k0.x, k0.y, k0.z, k0.w, k1.x, k1.y, k1.z, k1.w); }
            ga = MFMA32(a, qf[st], ga); }
        float g[8];
#pragma unroll
        for (int r = 0; r < 4; ++r) { const float mine = ga[r], other = __shfl_xor(mine, 32); g[r] = hi ? other : mine; g[4 + r] = hi ? mine : other; }
        const int nsel = own < 3 ? own : 3;
#pragma unroll
        for (int j = 0; j < 8; ++j) { int rank = 0;
#pragma unroll
            for (int i2 = 0; i2 < 8; ++i2) if (i2 != j) rank += (i2 < own && (g[i2] > g[j] || (g[i2] == g[j] && i2 < j))) ? 1 : 0;
            if (j < own && rank < nsel) selmask |= 1u << j; }
    }
    f32x16 o[4];
#pragma unroll
    for (int dt = 0; dt < 4; ++dt)
#pragma unroll
        for (int r = 0; r < 16; ++r) o[dt][r] = 0.f;
    float mrun = -INFINITY, lrun = 0.f;
    for (int j = 0; j <= own; ++j) {
        const bool act = (j == own) || ((selmask >> j) & 1u);
        if (__ballot(act) == 0ull) continue;
        const int nkt = (j == own) ? ((q0 & 255) >> 5) + 1 : 8;
        for (int kt = 0; kt < nkt; ++kt) {
            const int key0 = j * 256 + kt * 32;
            f32x16 s;
#pragma unroll
            for (int r = 0; r < 16; ++r) s[r] = 0.f;
            const bf16_t* kp = Kr + ((size_t)bh * SEQ + key0 + qi) * 128 + 8 * hi;
#pragma unroll
            for (int st = 0; st < 8; ++st) s = MFMA32(*(const bf16x8*)(kp + 16 * st), qf[st], s);
            float mt = -INFINITY;
#pragma unroll
            for (int r = 0; r < 16; ++r) { const int key = key0 + crow(r, hi); const bool ok = act && (j < own || key <= pos); s[r] = ok ? s[r] : -INFINITY; mt = fmaxf(mt, s[r]); }
            mt = fmaxf(mt, __shfl_xor(mt, 32));
            const float mnew = fmaxf(mrun, mt), muse = (mnew == -INFINITY) ? 0.f : mnew;
            const float alpha = __expf(mrun - muse);
            float ls = 0.f;
#pragma unroll
            for (int r = 0; r < 16; ++r) { s[r] = __expf(s[r] - muse); ls += s[r]; }
            lrun = lrun * alpha + ls; mrun = mnew;
#pragma unroll
            for (int dt = 0; dt < 4; ++dt)
#pragma unroll
                for (int r = 0; r < 16; ++r) o[dt][r] *= alpha;
#pragma unroll
            for (int sp = 0; sp < 2; ++sp) {
                const bf16x8 pb = pack8(s[8 * sp], s[8 * sp + 1], s[8 * sp + 2], s[8 * sp + 3], s[8 * sp + 4], s[8 * sp + 5], s[8 * sp + 6], s[8 * sp + 7]);
#pragma unroll
                for (int dt = 0; dt < 4; ++dt) { const bf16_t* vp = Vt + ((size_t)bh * 128 + 32 * dt + qi) * SEQ + key0 + 16 * sp + 4 * hi;
                    const u32x2 lo = *(const u32x2*)vp, hh = *(const u32x2*)(vp + 8);
                    const bf16x8 a = __builtin_bit_cast(bf16x8, (u32x4){lo.x, lo.y, hh.x, hh.y});
                    o[dt] = MFMA32(a, pb, o[dt]); }
            }
        }
    }
    const float ltot = lrun + __shfl_xor(lrun, 32), inv = 1.0f / ltot;
    bf16_t* op = CAT + ((size_t)b * SEQ + pos) * D + h * 128;
#pragma unroll
    for (int dt = 0; dt < 4; ++dt)
#pragma unroll
        for (int g4 = 0; g4 < 4; ++g4) { const int d = 32 * dt + 8 * g4 + 4 * hi;
            *(u32x2*)(op + d) = (u32x2){pk2(o[dt][4 * g4] * inv, o[dt][4 * g4 + 1] * inv), pk2(o[dt][4 * g4 + 2] * inv, o[dt][4 * g4 + 3] * inv)}; }
}

DI void dnp_phase(const bf16_t* QKraw, const bf16_t* Vraw, const float* BA, const float* conv_w, const float* a_log, const float* dt_bias,
                  bf16_t* QN, bf16_t* KN, bf16_t* V, float* G, float* BETA, int wave, int lane) {
    const int gw = blockIdx.x * NWAVES + wave, ngw = gridDim.x * NWAVES;
    for (int it = gw; it < BATCH * 64 * 32; it += ngw) {
        const int rc = it & 31, hs = (it >> 5) & 63, b = it >> 11;
        const int ch = hs * 128 + 2 * lane;
        float w0[4], w1[4];
#pragma unroll
        for (int j = 0; j < 4; ++j) { w0[j] = conv_w[j * 8192 + ch]; w1[j] = conv_w[j * 8192 + ch + 1]; }
        const bf16_t* src = hs < 32 ? QKraw + ch : Vraw + (ch - 4096);
        const int t0 = rc * 64;
        float x0[3], x1[3];
#pragma unroll
        for (int j = 0; j < 3; ++j) { const int t = t0 - 3 + j; unsigned raw = 0u; if (t >= 0) raw = *(const unsigned*)(src + ((size_t)b * SEQ + t) * 4096); x0[j] = bflo(raw); x1[j] = bfhi(raw); }
        for (int tt = 0; tt < 64; ++tt) { const size_t row = (size_t)b * SEQ + t0 + tt;
            const unsigned raw = *(const unsigned*)(src + row * 4096); const float c0 = bflo(raw), c1 = bfhi(raw);
            float y0 = x0[0] * w0[0] + x0[1] * w0[1] + x0[2] * w0[2] + c0 * w0[3];
            float y1 = x1[0] * w1[0] + x1[1] * w1[1] + x1[2] * w1[2] + c1 * w1[3];
            x0[0] = x0[1]; x0[1] = x0[2]; x0[2] = c0; x1[0] = x1[1]; x1[1] = x1[2]; x1[2] = c1;
            y0 = pg8::silu_f(y0); y1 = pg8::silu_f(y1);
            if (hs < 32) { const float ss = wave_sum(y0 * y0 + y1 * y1); const float sc = rsqrtf(ss + RMS_EPS) * (hs < 16 ? 0.08838834764831845f : 1.0f);
                bf16_t* dst = (hs < 16 ? QN + row * 2048 + ch : KN + row * 2048 + (ch - 2048)); *(unsigned*)dst = pk2(y0 * sc, y1 * sc); }
            else *(unsigned*)(V + row * 4096 + (ch - 4096)) = pk2(y0, y1);
        }
    }
    for (int i = blockIdx.x * NTHREADS + threadIdx.x; i < M * 32; i += gridDim.x * NTHREADS) { const int row = i >> 5, h = i & 31;
        const float bb = BA[(size_t)row * 64 + h], aa = BA[(size_t)row * 64 + 32 + h];
        BETA[i] = 1.0f / (1.0f + expf(-bb));
        const float x = aa + dt_bias[h]; const float sp = x > 20.f ? x : log1pf(expf(x));
        G[i] = -expf(a_log[h]) * sp; }
}

constexpr int DA_KS = 0, DA_QS = 17408, DA_VBT = 34816, DA_KBGT = 53248, DA_KT = 71680, DA_AM = 90112, DA_TB = 107520, DA_GC = 116736, DA_BT = 116992, DA_EG = 117248;
DI void dna_item(const bf16_t* QN, const bf16_t* KN, const bf16_t* V, const float* G, const float* BETA,
                 bf16_t* Wimg, bf16_t* Uimg, bf16_t* Aimg, bf16_t* Qimg, bf16_t* KTimg, float* EGt, float* DKt, int item, LAS unsigned char* lds, int tid) {
    const int hv = item & 31, n = (item >> 5) & 31, b = item >> 10, hk = hv >> 1;
    const int lane = tid & 63, wave = __builtin_amdgcn_readfirstlane(tid >> 6), r32 = lane & 31, hi = lane >> 5;
    const size_t row0 = (size_t)b * SEQ + n * 64;
    const int itemk = (b * 32 + n) * 16 + hk;
    LAS bf16_t* Ks = (LAS bf16_t*)(lds + DA_KS); LAS bf16_t* Qs = (LAS bf16_t*)(lds + DA_QS);
    LAS bf16_t* vbT = (LAS bf16_t*)(lds + DA_VBT); LAS bf16_t* kbgT = (LAS bf16_t*)(lds + DA_KBGT); LAS bf16_t* kT = (LAS bf16_t*)(lds + DA_KT);
    LAS float* Am = (LAS float*)(lds + DA_AM); LAS bf16_t* Tb = (LAS bf16_t*)(lds + DA_TB);
    LAS float* gcs = (LAS float*)(lds + DA_GC); LAS float* bts = (LAS float*)(lds + DA_BT); LAS float* egs = (LAS float*)(lds + DA_EG);
    if (wave == 0) { float x = G[(row0 + lane) * 32 + hv];
#pragma unroll
        for (int o = 1; o < 64; o <<= 1) { const float t = __shfl_up(x, o); if (lane >= o) x += t; }
        gcs[lane] = x; egs[lane] = __expf(x); bts[lane] = BETA[(row0 + lane) * 32 + hv];
        const float gl = __shfl(x, 63); const int c5 = lane & 31, ti = (((lane >> 5) * 2 + ((c5 >> 2) & 1)) * 16) + (c5 & 3) + 4 * (c5 >> 3);
        EGt[(size_t)item * 64 + ti] = __expf(x); DKt[(size_t)item * 64 + ti] = __expf(gl - x); }
    __syncthreads();
#pragma unroll
    for (int i = 0; i < 2; ++i) { const int p = tid + 512 * i, e = p >> 4, c8 = (p & 15) * 8;
        const float be = bts[e], bg = be * egs[e];
        const u32x4 kr = *(const u32x4*)(KN + (row0 + e) * 2048 + hk * 128 + c8);
        *(LAS u32x4*)(Ks + e * 136 + c8) = kr;
        const u32x4 qr = *(const u32x4*)(QN + (row0 + e) * 2048 + hk * 128 + c8);
        *(LAS u32x4*)(Qs + e * 136 + c8) = qr;
        const u32x4 vr = *(const u32x4*)(V + (row0 + e) * 4096 + hv * 128 + c8);
        const unsigned kw[4] = {kr.x, kr.y, kr.z, kr.w}, vw[4] = {vr.x, vr.y, vr.z, vr.w};
#pragma unroll
        for (int j = 0; j < 4; ++j) {
            kT[(c8 + 2 * j) * 72 + e] = (bf16_t)(kw[j] & 0xffffu); kT[(c8 + 2 * j + 1) * 72 + e] = (bf16_t)(kw[j] >> 16);
            kbgT[(c8 + 2 * j) * 72 + e] = f2bf(bflo(kw[j]) * bg); kbgT[(c8 + 2 * j + 1) * 72 + e] = f2bf(bfhi(kw[j]) * bg);
            vbT[(c8 + 2 * j) * 72 + e] = f2bf(bflo(vw[j]) * be); vbT[(c8 + 2 * j + 1) * 72 + e] = f2bf(bfhi(vw[j]) * be); } }
    __syncthreads();
    if (wave < 3) { const int ct = wave == 0 ? 0 : 1, et = wave == 2 ? 1 : 0;
        f32x16 acc;
#pragma unroll
        for (int r = 0; r < 16; ++r) acc[r] = 0.f;
#pragma unroll
        for (int st = 0; st < 8; ++st) acc = MFMA32(*(const LAS bf16x8*)(Ks + (32 * ct + r32) * 136 + 16 * st + 8 * hi), *(const LAS bf16x8*)(Ks + (32 * et + r32) * 136 + 16 * st + 8 * hi), acc);
        const int e = 32 * et + r32; const float ge = gcs[e];
#pragma unroll
        for (int r = 0; r < 16; ++r) { const int c = 32 * ct + crow(r, hi); Am[c * 68 + e] = (e < c) ? bts[c] * acc[r] * __expf(gcs[c] - ge) : 0.f; }
    } else if (wave < 6) { const int w3 = wave - 3, et = w3 == 2 ? 1 : 0, ct = w3 == 0 ? 0 : 1;
        f32x16 acc;
#pragma unroll
        for (int r = 0; r < 16; ++r) acc[r] = 0.f;
#pragma unroll
        for (int st = 0; st < 8; ++st) acc = MFMA32(*(const LAS bf16x8*)(Ks + (32 * et + r32) * 136 + 16 * st + 8 * hi), *(const LAS bf16x8*)(Qs + (32 * ct + r32) * 136 + 16 * st + 8 * hi), acc);
        const int c = 32 * ct + r32; const float gcc = gcs[c];
#pragma unroll
        for (int r = 0; r < 16; ++r) { const int e = 32 * et + crow(r, hi); acc[r] = (e <= c) ? acc[r] * __expf(gcc - gcs[e]) : 0.f; }
#pragma unroll
        for (int s = 0; s < 2; ++s) *(u32x4*)(Aimg + ((((size_t)item * 4 + ct * 2 + et) * 2 + s) * 512 + lane * 8)) =
            __builtin_bit_cast(u32x4, pack8(acc[8 * s], acc[8 * s + 1], acc[8 * s + 2], acc[8 * s + 3], acc[8 * s + 4], acc[8 * s + 5], acc[8 * s + 6], acc[8 * s + 7]));
    } else if ((hv & 1) == 0) { const int t2 = tid - 384;
#pragma unroll
        for (int i = 0; i < 8; ++i) { const int p = t2 + 128 * i, ln = p & 63, s = (p >> 6) & 1, tl = p >> 7, lr = ln & 31, lh = ln >> 5;
            const int ct = tl >> 2, kt = tl & 3;
            const LAS bf16_t* src = Qs + (32 * ct + lr) * 136 + 32 * kt + 16 * s + 4 * lh;
            const u32x2 lo = *(const LAS u32x2*)src, hh = *(const LAS u32x2*)(src + 8);
            *(u32x4*)(Qimg + ((((size_t)itemk * 8 + tl) * 2 + s) * 512 + ln * 8)) = (u32x4){lo.x, lo.y, hh.x, hh.y}; }
#pragma unroll
        for (int i = 0; i < 8; ++i) { const int p = t2 + 128 * i, ln = p & 63, s = (p >> 6) & 1, tl = p >> 7, lr = ln & 31, lh = ln >> 5;
            const int kt = tl >> 1, ct = tl & 1;
            const LAS bf16_t* src = kT + (32 * kt + lr) * 72 + 32 * ct + 16 * s + 4 * lh;
            const u32x2 lo = *(const LAS u32x2*)src, hh = *(const LAS u32x2*)(src + 8);
            *(u32x4*)(KTimg + ((((size_t)itemk * 8 + tl) * 2 + s) * 512 + ln * 8)) = (u32x4){lo.x, lo.y, hh.x, hh.y}; }
    }
    __syncthreads();
    if (wave == 0) {
        float T[64]; int zoff; asm volatile("v_mov_b32 %0, 0" : "=v"(zoff));
        const LAS float* Amz = Am + zoff;
#pragma unroll
        for (int i = 0; i < 64; ++i) { float acc = (i == lane) ? 1.f : 0.f;
#pragma unroll
            for (int q = 0; q < (i + 3) / 4; ++q) { const f32x4 a4 = *(const LAS f32x4*)(Amz + i * 68 + 4 * q);
                if (4 * q + 0 < i) acc -= a4.x * T[4 * q + 0];
                if (4 * q + 1 < i) acc -= a4.y * T[4 * q + 1];
                if (4 * q + 2 < i) acc -= a4.z * T[4 * q + 2];
                if (4 * q + 3 < i) acc -= a4.w * T[4 * q + 3]; }
            T[i] = acc; Tb[i * 72 + lane] = f2bf(acc); }
    }
    __syncthreads();
    { const int ct = wave >> 2, vt = wave & 3;
        f32x16 acc;
#pragma unroll
        for (int r = 0; r < 16; ++r) acc[r] = 0.f;
        for (int es = 0; es < 2 * (ct + 1); ++es) acc = MFMA32(*(const LAS bf16x8*)(Tb + (32 * ct + r32) * 72 + 16 * es + 8 * hi), *(const LAS bf16x8*)(vbT + (32 * vt + r32) * 72 + 16 * es + 8 * hi), acc);
        bf16_t* dst = Uimg + (((size_t)item * 4 + vt) * 2 + ct) * 1024 + lane * 16;
#pragma unroll
        for (int s = 0; s < 2; ++s) *(u32x4*)(dst + 8 * s) = __builtin_bit_cast(u32x4, pack8(acc[8 * s], acc[8 * s + 1], acc[8 * s + 2], acc[8 * s + 3], acc[8 * s + 4], acc[8 * s + 5], acc[8 * s + 6], acc[8 * s + 7])); }
    { const int kt = wave >> 1, ct = wave & 1;
        f32x16 acc;
#pragma unroll
        for (int r = 0; r < 16; ++r) acc[r] = 0.f;
        for (int es = 0; es < 2 * (ct + 1); ++es) acc = MFMA32(*(const LAS bf16x8*)(kbgT + (32 * kt + r32) * 72 + 16 * es + 8 * hi), *(const LAS bf16x8*)(Tb + (32 * ct + r32) * 72 + 16 * es + 8 * hi), acc);
#pragma unroll
        for (int s = 0; s < 2; ++s) *(u32x4*)(Wimg + ((((size_t)item * 8 + ct * 4 + kt) * 2 + s) * 512 + lane * 8)) =
            __builtin_bit_cast(u32x4, pack8(-acc[8 * s], -acc[8 * s + 1], -acc[8 * s + 2], -acc[8 * s + 3], -acc[8 * s + 4], -acc[8 * s + 5], -acc[8 * s + 6], -acc[8 * s + 7])); }
    __syncthreads();
}

DI f32x16 ld_img16(const bf16_t* p) { const u32x4 a = *(const u32x4*)p, b = *(const u32x4*)(p + 8); f32x16 v;
    v[0] = bflo(a.x); v[1] = bfhi(a.x); v[2] = bflo(a.y); v[3] = bfhi(a.y); v[4] = bflo(a.z); v[5] = bfhi(a.z); v[6] = bflo(a.w); v[7] = bfhi(a.w);
    v[8] = bflo(b.x); v[9] = bfhi(b.x); v[10] = bflo(b.y); v[11] = bfhi(b.y); v[12] = bflo(b.z); v[13] = bfhi(b.z); v[14] = bflo(b.w); v[15] = bfhi(b.w); return v; }
#define PACKS(x, s) pack8((x)[8 * (s)], (x)[8 * (s) + 1], (x)[8 * (s) + 2], (x)[8 * (s) + 3], (x)[8 * (s) + 4], (x)[8 * (s) + 5], (x)[8 * (s) + 6], (x)[8 * (s) + 7])
#define LDF(p) (((const bf16x8*)(p))[lane])
#define DNB_FENCE asm volatile("" ::: "memory")
#define LD_WQ(F, kt) do { F[0] = LDF(Wp + ((0 * 4 + (kt)) * 2 + 0) * 512); F[1] = LDF(Wp + ((0 * 4 + (kt)) * 2 + 1) * 512); F[2] = LDF(Wp + ((1 * 4 + (kt)) * 2 + 0) * 512); F[3] = LDF(Wp + ((1 * 4 + (kt)) * 2 + 1) * 512); \
                          F[4] = LDF(Qp + ((0 * 4 + (kt)) * 2 + 0) * 512); F[5] = LDF(Qp + ((0 * 4 + (kt)) * 2 + 1) * 512); F[6] = LDF(Qp + ((1 * 4 + (kt)) * 2 + 0) * 512); F[7] = LDF(Qp + ((1 * 4 + (kt)) * 2 + 1) * 512); } while (0)
#define CMP_WQ(F, kt) do { const bf16x8 sb0 = PACKS(S[kt], 0), sb1 = PACKS(S[kt], 1); \
        vn[0] = MFMA32(F[0], sb0, vn[0]); vn[1] = MFMA32(F[2], sb0, vn[1]); o[0] = MFMA32(F[4], sb0, o[0]); o[1] = MFMA32(F[6], sb0, o[1]); \
        vn[0] = MFMA32(F[1], sb1, vn[0]); vn[1] = MFMA32(F[3], sb1, vn[1]); o[0] = MFMA32(F[5], sb1, o[0]); o[1] = MFMA32(F[7], sb1, o[1]); } while (0)
#define LD_KT(F, kt0) do { _Pragma("unroll") for (int q_ = 0; q_ < 8; ++q_) F[q_] = LDF(Kp + ((kt0) * 4 + q_) * 512); } while (0)
#define CMP_KT(F, kt0) do { _Pragma("unroll") for (int k_ = 0; k_ < 2; ++k_) { _Pragma("unroll") for (int r_ = 0; r_ < 16; ++r_) S[(kt0) + k_][r_] *= egl; \
        S[(kt0) + k_] = MFMA32(F[4 * k_ + 0], d00, S[(kt0) + k_]); S[(kt0) + k_] = MFMA32(F[4 * k_ + 1], d01, S[(kt0) + k_]); \
        S[(kt0) + k_] = MFMA32(F[4 * k_ + 2], d10, S[(kt0) + k_]); S[(kt0) + k_] = MFMA32(F[4 * k_ + 3], d11, S[(kt0) + k_]); } } while (0)
#define DNB_SETPTR(nn) do { const size_t item_ = ((size_t)b * 32 + (nn)) * 32 + hv, itemk_ = ((size_t)b * 32 + (nn)) * 16 + hk; \
        Wp = Wimg + item_ * 8192; Qp = Qimg + itemk_ * 8192; Kp = KTimg + itemk_ * 8192; Ap = Aimg + item_ * 4096; \
        Up = Uimg + (item_ * 4 + vs) * 2048; Ep = EG + item_ * 64; Dp = DK + item_ * 64; row0 = (size_t)b * SEQ + (nn) * 64; } while (0)
#define LD_U() do { u0 = ((const u32x4*)Up)[2 * lane]; u1 = ((const u32x4*)Up)[2 * lane + 1]; u2 = ((const u32x4*)Up)[128 + 2 * lane]; u3 = ((const u32x4*)Up)[128 + 2 * lane + 1]; } while (0)
#define DNB_CHUNK(F, nn) do { \
        { const unsigned uu0[8] = {u0.x, u0.y, u0.z, u0.w, u1.x, u1.y, u1.z, u1.w}, uu1[8] = {u2.x, u2.y, u2.z, u2.w, u3.x, u3.y, u3.z, u3.w}; \
          _Pragma("unroll") for (int q_ = 0; q_ < 8; ++q_) { vn[0][2 * q_] = bflo(uu0[q_]); vn[0][2 * q_ + 1] = bfhi(uu0[q_]); vn[1][2 * q_] = bflo(uu1[q_]); vn[1][2 * q_ + 1] = bfhi(uu1[q_]); } } \
        _Pragma("unroll") for (int ct = 0; ct < 2; ++ct) _Pragma("unroll") for (int r = 0; r < 16; ++r) o[ct][r] = 0.f; \
        CMP_WQ(F, 0); DNB_FENCE; LD_WQ(F, 1); DNB_FENCE; \
        CMP_WQ(F, 1); DNB_FENCE; LD_WQ(F, 2); DNB_FENCE; \
        CMP_WQ(F, 2); DNB_FENCE; LD_WQ(F, 3); DNB_FENCE; \
        CMP_WQ(F, 3); DNB_FENCE; \
        _Pragma("unroll") for (int q_ = 0; q_ < 2; ++q_) { F[q_] = LDF(Ap + ((0 * 2 + 0) * 2 + q_) * 512); F[2 + q_] = LDF(Ap + ((1 * 2 + 0) * 2 + q_) * 512); F[4 + q_] = LDF(Ap + ((1 * 2 + 1) * 2 + q_) * 512); } \
        float egl; \
        { f32x4 eg[2][4]; _Pragma("unroll") for (int ct = 0; ct < 2; ++ct) _Pragma("unroll") for (int q_ = 0; q_ < 4; ++q_) eg[ct][q_] = ((const f32x4*)Ep)[ct * 8 + hi * 4 + q_]; \
          DNB_FENCE; \
          _Pragma("unroll") for (int ct = 0; ct < 2; ++ct) _Pragma("unroll") for (int r = 0; r < 16; ++r) o[ct][r] *= eg[ct][r >> 2][r & 3]; \
          egl = __shfl(eg[1][3][3], 63); } \
        { const bf16x8 v00 = PACKS(vn[0], 0), v01 = PACKS(vn[0], 1), v10 = PACKS(vn[1], 0), v11 = PACKS(vn[1], 1); \
          o[0] = MFMA32(F[0], v00, o[0]); o[1] = MFMA32(F[2], v00, o[1]); o[0] = MFMA32(F[1], v01, o[0]); o[1] = MFMA32(F[3], v01, o[1]); o[1] = MFMA32(F[4], v10, o[1]); o[1] = MFMA32(F[5], v11, o[1]); } \
        DNB_FENCE; LD_KT(F, 0); \
        { f32x4 dk[2][4]; _Pragma("unroll") for (int ct = 0; ct < 2; ++ct) _Pragma("unroll") for (int q_ = 0; q_ < 4; ++q_) dk[ct][q_] = ((const f32x4*)Dp)[ct * 8 + hi * 4 + q_]; \
          DNB_FENCE; \
          { bf16_t* op_ = OG + (row0 + 4 * hi) * 4096 + hv * 128 + 32 * vs + r32; \
            _Pragma("unroll") for (int ct = 0; ct < 2; ++ct) _Pragma("unroll") for (int g_ = 0; g_ < 4; ++g_) { \
              _Pragma("unroll") for (int i_ = 0; i_ < 4; ++i_) { *op_ = f2bf(o[ct][4 * g_ + i_]); op_ += 4096; asm volatile("" : "+v"(op_)); } \
              op_ += 4 * 4096; asm volatile("" : "+v"(op_)); } } \
          _Pragma("unroll") for (int ct = 0; ct < 2; ++ct) _Pragma("unroll") for (int r = 0; r < 16; ++r) vn[ct][r] *= dk[ct][r >> 2][r & 3]; } \
        { const bf16x8 d00 = PACKS(vn[0], 0), d01 = PACKS(vn[0], 1), d10 = PACKS(vn[1], 0), d11 = PACKS(vn[1], 1); \
          CMP_KT(F, 0); DNB_FENCE; LD_KT(F, 2); DNB_FENCE; CMP_KT(F, 2); DNB_FENCE; } \
        if ((nn) + 1 < 32) { DNB_SETPTR((nn) + 1); LD_WQ(F, 0); LD_U(); } DNB_FENCE; \
    } while (0)
DI void dnb_wave(const bf16_t* Wimg, const bf16_t* Uimg, const bf16_t* Aimg, const bf16_t* Qimg, const bf16_t* KTimg, const float* EG, const float* DK, bf16_t* OG, int bhv, int vs, int lane) {
    const int b = bhv >> 5, hv = bhv & 31, hk = hv >> 1, r32 = lane & 31, hi = lane >> 5;
    f32x16 S[4], vn[2], o[2];
#pragma unroll
    for (int kt = 0; kt < 4; ++kt)
#pragma unroll
        for (int r = 0; r < 16; ++r) S[kt][r] = 0.f;
    const bf16_t *Wp, *Qp, *Kp, *Ap, *Up; const float *Ep, *Dp; size_t row0;
    bf16x8 F[8]; u32x4 u0, u1, u2, u3;
    DNB_SETPTR(0); LD_WQ(F, 0); LD_U();
    for (int n = 0; n < 32; ++n) { DNB_CHUNK(F, n); }
}

DI void dnc_phase(bf16_t* OG, const bf16_t* Z, const float* norm_g, int wave, int lane) {
    const int gw = blockIdx.x * NWAVES + wave, ngw = gridDim.x * NWAVES;
    const float g0 = norm_g[2 * lane], g1 = norm_g[2 * lane + 1];
    for (int it = gw; it < M * 32; it += ngw) { const size_t off = (size_t)it * 128 + 2 * lane;
        const unsigned raw = *(const unsigned*)(OG + off), zr = *(const unsigned*)(Z + off);
        const float o0 = bflo(raw), o1 = bfhi(raw), z0 = bflo(zr), z1 = bfhi(zr);
        const float sc = rsqrtf(wave_sum(o0 * o0 + o1 * o1) * (1.f / 128.f) + RMS_EPS);
        *(unsigned*)(OG + off) = pk2(o0 * sc * g0 * pg8::silu_f(z0), o1 * sc * g1 * pg8::silu_f(z1)); }
}

#define XB_TMO      128
#define XB_XCNT(j)  (256  + 64 * (j))
#define XB_XSUB(j)  (1280 + 64 * (j))
#define XB_XGEN(j)  (2304 + 64 * (j))
#define XB_TOP      3328
#define XB_TOPGEN   3392
#define XCD_BAR_WORDS 3456
#define XB_SPIN_CAP (1u << 18)

__device__ __forceinline__ unsigned xb_ld(unsigned* p)              { return __hip_atomic_load(p, __ATOMIC_RELAXED, __HIP_MEMORY_SCOPE_AGENT); }
__device__ __forceinline__ unsigned xb_add(unsigned* p, unsigned v) { return __hip_atomic_fetch_add(p, v, __ATOMIC_RELAXED, __HIP_MEMORY_SCOPE_AGENT); }
__device__ __forceinline__ unsigned xb_xcc_id() { return (unsigned)__builtin_amdgcn_s_getreg((3 << 11) | 20) & 0xFu; }
#define XB_SPIN(cond, bar) do { unsigned _sp = 0; while (cond) { __builtin_amdgcn_s_sleep(1); \
    if ((++_sp & 255u) == 0u) { if (xb_ld(&(bar)[XB_TMO])) break; if (_sp > XB_SPIN_CAP) { atomicAdd(&(bar)[XB_TMO], 1u); break; } } } } while (0)

struct XcdBarrier {
    unsigned* bar; unsigned x;
    volatile LAS unsigned* st;
};

__device__ __forceinline__ XcdBarrier xcd_barrier_post(unsigned* bar, volatile LAS unsigned* st) {
    XcdBarrier b; b.bar = bar; b.x = xb_xcc_id(); b.st = st;
    if (threadIdx.x == 0) (void)xb_add(&bar[XB_XCNT(b.x)], 1u);
    return b;
}
__device__ __forceinline__ void xcd_barrier_complete(unsigned* bar, unsigned x, unsigned& nloc, unsigned& nx) {
    const unsigned G = gridDim.x * gridDim.y * gridDim.z;
    unsigned sum, cnt, mine, sp = 0u;
    for (;;) {
        sum = 0u; cnt = 0u; mine = 0u;
#pragma unroll
        for (unsigned j = 0; j < 16; ++j) { const unsigned c = xb_ld(&bar[XB_XCNT(j)]); sum += c; cnt += (c > 0u) ? 1u : 0u; mine = (j == x) ? c : mine; }
        if (sum == G) break;
        __builtin_amdgcn_s_sleep(1);
        if ((++sp & 255u) == 0u) { if (xb_ld(&bar[XB_TMO])) break; if (sp > XB_SPIN_CAP) { atomicAdd(&bar[XB_TMO], 1u); break; } }
    }
    nloc = mine > 0u ? mine : 1u; nx = cnt > 0u ? cnt : 1u;
}

__device__ __forceinline__ void xcd_barrier(const XcdBarrier& b) {
    asm volatile("s_waitcnt vmcnt(0)" ::: "memory");
    __syncthreads();
    if (threadIdx.x == 0) {
        unsigned* bar = b.bar;
        __builtin_amdgcn_s_waitcnt(0);
        unsigned nloc = b.st[0], nx = b.st[1];
        if (nloc == 0u) { xcd_barrier_complete(bar, b.x, nloc, nx); b.st[0] = nloc; b.st[1] = nx; }
        const unsigned old = xb_add(&bar[XB_XSUB(b.x)], 1u);
        const unsigned gen = old / nloc;
        if (old + 1u == (gen + 1u) * nloc) {
            __builtin_amdgcn_fence(__ATOMIC_RELEASE, "agent");
            asm volatile("s_waitcnt vmcnt(0)" ::: "memory");
            const unsigned og = xb_add(&bar[XB_TOP], 1u);
            const unsigned tg = og / nx;
            if (og + 1u == (tg + 1u) * nx) xb_add(&bar[XB_TOPGEN], 1u);
            else XB_SPIN(xb_ld(&bar[XB_TOPGEN]) == tg, bar);
            __builtin_amdgcn_fence(__ATOMIC_ACQUIRE, "agent");
            xb_add(&bar[XB_XGEN(b.x)], 1u);
            asm volatile("s_waitcnt vmcnt(0)" ::: "memory");
        } else {
            XB_SPIN(xb_ld(&bar[XB_XGEN(b.x)]) == gen, bar);
            __builtin_amdgcn_fence(__ATOMIC_ACQUIRE, "agent");
            asm volatile("s_waitcnt vmcnt(0)" ::: "memory");
        }
    }
    __syncthreads();
}

constexpr int N_PHASES = 25;
DI void gemm_swiglu(LAS unsigned char* lds, const bf16_t* A, const bf16_t* Wt, bf16_t* H) {
    pg8::Gemm g{A, Wt, M, 2 * DFF, D}; pg8::StaticOrder S; S.init(M, 2 * DFF, (int)gridDim.x, (int)blockIdx.x);
    pg8::EpiSwiGLU E{H, DFF};
    pg8::gemm_phase<pg8::EpiSwiGLU, pg8::StaticOrder, true, true>(lds, g, S, E);
}
DI void gemm_resid(LAS unsigned char* lds, const bf16_t* A, const bf16_t* Wt, int K, const float* resid, float* out, float scale) {
    pg8::Gemm g{A, Wt, M, D, K}; pg8::StaticOrder S; S.init(M, D, (int)gridDim.x, (int)blockIdx.x);
    pg8::EpiResid E{resid, out, D, ALPHA, scale};
    pg8::gemm_phase<pg8::EpiResid, pg8::StaticOrder, true, true>(lds, g, S, E);
}
__global__ void __launch_bounds__(NTHREADS, 2) fwd_kernel(Args args) {
    extern __shared__ __attribute__((aligned(16))) unsigned char lds_raw[];
    LAS unsigned char* lds = (LAS unsigned char*)lds_raw;
    cg::grid_group grid = cg::this_grid();
    const int tid = threadIdx.x, lane = tid & 63, wave = __builtin_amdgcn_readfirstlane(tid >> 6);
    const Args* const ap = &args;
    const int lo = args.ph_lo, hi = args.ph_hi;
    { volatile LAS unsigned* st = (volatile LAS unsigned*)(lds + LDS_BYTES - 64); if (tid < 16) st[tid] = 0u; }
    __syncthreads();
    const XcdBarrier xbar = xcd_barrier_post((unsigned*)(args.ws + WS_BAR), (volatile LAS unsigned*)(lds + LDS_BYTES - 64));
#define PHASE(k) if (lo <= (k) && (k) < hi && ((k) == lo || (((k) == lo + 1) ? (grid.sync(), true) : (xcd_barrier(xbar), true))))
#define ARGS_RELOAD() unsigned char* const ws = ap->ws
#define WSP(T, off) ((T*)(ws + (off)))
    PHASE(0) { ARGS_RELOAD(); p0_prologue(*ap, lds, wave, lane); }
    PHASE(1) { ARGS_RELOAD(); gemm_swiglu(lds, WSP(bf16_t, WS_XB), WSP(bf16_t, WS_WGU1_0), WSP(bf16_t, WS_BIG)); }
    PHASE(2) { ARGS_RELOAD(); gemm_resid(lds, WSP(bf16_t, WS_BIG), WSP(bf16_t, WS_WD1_0), DFF, ap->in[0], ap->out, 0.5f); }
    PHASE(3) { ARGS_RELOAD(); ln_phase(ap->out, WSP(bf16_t, WS_XB), ap->in[7] + 0 * D, ap->in[8] + 0 * D, wave, lane); }
    PHASE(4) { ARGS_RELOAD(); pg8::Gemm g{WSP(bf16_t, WS_XB), WSP(bf16_t, WS_WABIN), M, AB_IN, D}; pg8::StaticOrder S; S.init(M, AB_IN, (int)gridDim.x, (int)blockIdx.x);
        pg8::EpiPlain E{WSP(bf16_t, WS_BIG), AB_IN};
        pg8::gemm_phase<pg8::EpiPlain, pg8::StaticOrder, true, true>(lds, g, S, E); }
    PHASE(5) { ARGS_RELOAD();
        for (int it = blockIdx.x; it < 256; it += gridDim.x)
            rope_item(WSP(bf16_t, WS_BIG), WSP(bf16_t, WS_QR), WSP(bf16_t, WS_KR), WSP(bf16_t, WS_VT), WSP(float, WS_KMEAN), it, (LAS float*)lds, tid);
        for (int it = blockIdx.x; it < 512; it += gridDim.x)
            gmlp_item(WSP(bf16_t, WS_BIG), ap->in[10], ap->in[11], ap->in[12], ap->in[13], WSP(bf16_t, WS_CAT), it, lds, wave, lane);
    }
    PHASE(6) { ARGS_RELOAD();
        for (int wg = blockIdx.x; wg < 256; wg += gridDim.x) { const int bh = wg >> 3, sub = wg & 7;
            moba_wave(WSP(bf16_t, WS_QR), WSP(bf16_t, WS_KR), WSP(bf16_t, WS_VT), WSP(float, WS_KMEAN), WSP(bf16_t, WS_CAT), bh, wave * 8 + sub, lane); }
    }
    PHASE(7) { ARGS_RELOAD(); gemm_resid(lds, WSP(bf16_t, WS_CAT), WSP(bf16_t, WS_WABOUT), D, ap->out, ap->out, 1.0f); }
    PHASE(8) { ARGS_RELOAD(); ln_phase(ap->out, WSP(bf16_t, WS_XB), ap->in[7] + 1 * D, ap->in[8] + 1 * D, wave, lane); }
    PHASE(9) { ARGS_RELOAD(); gemm_swiglu(lds, WSP(bf16_t, WS_XB), WSP(bf16_t, WS_WGU2_0), WSP(bf16_t, WS_BIG)); }
    PHASE(10) { ARGS_RELOAD(); gemm_resid(lds, WSP(bf16_t, WS_BIG), WSP(bf16_t, WS_WD2_0), DFF, ap->out, ap->out, 0.5f); }
    PHASE(11) { ARGS_RELOAD(); ln_phase(ap->out, WSP(bf16_t, WS_XB), ap->in[7] + 2 * D, ap->in[8] + 2 * D, wave, lane); }
    PHASE(12) { ARGS_RELOAD(); gemm_swiglu(lds, WSP(bf16_t, WS_XB), WSP(bf16_t, WS_WGU1_1), WSP(bf16_t, WS_BIG)); }
    PHASE(13) { ARGS_RELOAD(); gemm_resid(lds, WSP(bf16_t, WS_BIG), WSP(bf16_t, WS_WD1_1), DFF, ap->out, ap->out, 0.5f); }
    PHASE(14) { ARGS_RELOAD(); ln_phase(ap->out, WSP(bf16_t, WS_XB), ap->in[7] + 3 * D, ap->in[8] + 3 * D, wave, lane); }
    PHASE(15) { ARGS_RELOAD(); pg8::Gemm g{WSP(bf16_t, WS_XB), WSP(bf16_t, WS_WDNIN), M, DN_IN_PAD, D}; pg8::StaticOrder S; S.init(M, DN_IN_PAD, (int)gridDim.x, (int)blockIdx.x);
        pg8::EpiDnIn E{WSP(bf16_t, WS_BIG), WSP(float, WS_BA)};
        pg8::gemm_phase<pg8::EpiDnIn, pg8::StaticOrder, true, true>(lds, g, S, E); }
    PHASE(16) { ARGS_RELOAD(); dnp_phase(WSP(bf16_t, WS_BIG), WSP(bf16_t, WS_BIG) + (size_t)M * 4096, WSP(float, WS_BA), ap->in[16], ap->in[17], ap->in[18],
                          WSP(bf16_t, WS_QN), WSP(bf16_t, WS_KN), WSP(bf16_t, WS_V), WSP(float, WS_G), WSP(float, WS_BETA), wave, lane); }
    PHASE(17) { ARGS_RELOAD();
        for (int it = blockIdx.x; it < 4096; it += gridDim.x)
            dna_item(WSP(bf16_t, WS_QN), WSP(bf16_t, WS_KN), WSP(bf16_t, WS_V), WSP(float, WS_G), WSP(float, WS_BETA),
                     WSP(bf16_t, WS_WIMG), WSP(bf16_t, WS_UIMG), WSP(bf16_t, WS_AIMG), WSP(bf16_t, WS_QIMG), WSP(bf16_t, WS_KTIMG), WSP(float, WS_GC), WSP(float, WS_GC + MiB), it, lds, tid);
    }
    PHASE(18) { ARGS_RELOAD();
        if (wave < 4) for (int it = blockIdx.x; it < 128; it += gridDim.x)
            dnb_wave(WSP(bf16_t, WS_WIMG), WSP(bf16_t, WS_UIMG), WSP(bf16_t, WS_AIMG), WSP(bf16_t, WS_QIMG), WSP(bf16_t, WS_KTIMG), WSP(float, WS_GC), WSP(float, WS_GC + MiB), WSP(bf16_t, WS_OG), it, wave, lane);
    }
    PHASE(19) { ARGS_RELOAD(); dnc_phase(WSP(bf16_t, WS_OG), WSP(bf16_t, WS_BIG) + (size_t)2 * M * 4096, ap->in[19], wave, lane); }
    PHASE(20) { ARGS_RELOAD(); gemm_resid(lds, WSP(bf16_t, WS_OG), WSP(bf16_t, WS_WDNOUT), 4096, ap->out, ap->out, 1.0f); }
    PHASE(21) { ARGS_RELOAD(); ln_phase(ap->out, WSP(bf16_t, WS_XB), ap->in[7] + 4 * D, ap->in[8] + 4 * D, wave, lane); }
    PHASE(22) { ARGS_RELOAD(); gemm_swiglu(lds, WSP(bf16_t, WS_XB), WSP(bf16_t, WS_WGU2_1), WSP(bf16_t, WS_BIG)); }
    PHASE(23) { ARGS_RELOAD(); gemm_resid(lds, WSP(bf16_t, WS_BIG), WSP(bf16_t, WS_WD2_1), DFF, ap->out, ap->out, 0.5f); }
    PHASE(24) { ARGS_RELOAD(); ln_phase(ap->out, WSP(bf16_t, WS_XB), ap->in[7] + 5 * D, ap->in[8] + 5 * D, wave, lane); }
}

extern "C" void kernel_launch(void* const* d_in, const int* in_sizes, int n_in, void* d_out, int out_size, void* d_ws, size_t ws_size, hipStream_t stream) {
    static int grid = 0;
    if (grid == 0) {
        if (n_in != 21 || out_size != M * D || ws_size < WS_END) { fprintf(stderr, "kernel_launch: unexpected shapes (n_in %d out %d ws %zu)\n", n_in, out_size, ws_size); grid = -1; return; }
        int dev = 0, cus = 0, per_cu = 0;
        (void)hipGetDevice(&dev); (void)hipDeviceGetAttribute(&cus, hipDeviceAttributeMultiprocessorCount, dev);
        (void)hipFuncSetAttribute((const void*)fwd_kernel, hipFuncAttributeMaxDynamicSharedMemorySize, LDS_BYTES);
        (void)hipOccupancyMaxActiveBlocksPerMultiprocessor(&per_cu, (const void*)fwd_kernel, NTHREADS, LDS_BYTES);
        if (per_cu < 1) { fprintf(stderr, "kernel_launch: occupancy query says %d blocks/CU\n", per_cu); per_cu = 1; }
        (void)hipGetLastError();
        grid = cus;
    }
    if (grid < 0) return;
    Args a{};
    for (int i = 0; i < 21; ++i) a.in[i] = (const float*)d_in[i];
    a.out = (float*)d_out; a.ws = (unsigned char*)d_ws; a.ph_lo = 0; a.ph_hi = N_PHASES;
    (void)hipMemsetAsync((char*)d_ws + WS_BAR, 0, BAR_BYTES, stream);
    void* kargs[] = {&a};
    hipError_t e = hipLaunchCooperativeKernel((const void*)fwd_kernel, dim3(grid), dim3(NTHREADS), kargs, LDS_BYTES, stream);
    if (e != hipSuccess) fprintf(stderr, "kernel_launch: cooperative launch failed: %s (grid %d)\n", hipGetErrorString(e), grid);
}
```

```cpp
#include <hip/hip_runtime.h>
#include <hip/hip_cooperative_groups.h>
#include <cstdio>
#include <cstdint>
namespace cg = cooperative_groups;
namespace pg8 {
#define PG8_LAS __attribute__((address_space(3)))
typedef unsigned short bf16_t;
typedef short bf16x8 __attribute__((ext_vector_type(8)));
typedef float f32x4 __attribute__((ext_vector_type(4)));
typedef unsigned u32x4 __attribute__((ext_vector_type(4)));
constexpr int BM = 256, BK = 64, HALF = 128, HTB = HALF * BK * 2  , STAGE_BYTES = 8 * HTB, NXCD = 8, WGM = 8;

__host__ __device__ __forceinline__ int lds_byte(int r, int c) { const int st = (r >> 4) * 2 + (c >> 5), rr = r & 15, cc = c & 31, ob = rr * 64 + cc * 2; return st * 1024 + (ob ^ (((ob >> 9) & 1) << 5)); }
__host__ __device__ __forceinline__ void stage_rc(int b, int& R, int& C) { const int st = b / 1024, sb = b % 1024, swz = sb ^ (((sb >> 9) & 1) << 5); R = (st >> 1) * 16 + swz / 64; C = (st & 1) * 32 + (swz % 64) / 2; }
__host__ __device__ __forceinline__ int perm32(int rho) { const int n = rho >> 4, i = rho & 15; return 8 * (i >> 2) + 4 * n + (i & 3); }

struct Unit { int pm, pn; };
struct Gemm { const bf16_t* A; const bf16_t* Bt; int M, N, K; };

struct StaticOrder {
    int nM, nN, nwg, G, c;
    __host__ __device__ void init(int M, int N, int G_, int c_) { nM = M / BM; nN = N / BM; nwg = nM * nN; G = G_; c = c_; }
    __host__ __device__ bool next(int i, Unit& u) const {
        const long L = (long)i * G + c; if (L >= nwg) return false;
        int wgid = (int)L; { const int q = nwg / NXCD, r = nwg % NXCD, xcd = wgid % NXCD, off = wgid / NXCD; wgid = (xcd < r ? xcd * (q + 1) : r * (q + 1) + (xcd - r) * q) + off; }
        const int nig = WGM * nN, gid = wgid / nig, fm = gid * WGM, gsz = (nM - fm) < WGM ? (nM - fm) : WGM;
        u.pm = fm + ((wgid % nig) % gsz); u.pn = (wgid % nig) / gsz; return true;
    }
    __device__ __forceinline__ void a_ready(const Unit&) const {}
    __device__ __forceinline__ void done(const Unit&) const {}
};

__device__ __forceinline__ unsigned cvt_pk_bf16(float lo, float hi) { unsigned r; asm volatile("v_cvt_pk_bf16_f32 %0, %1, %2" : "=v"(r) : "v"(lo), "v"(hi)); return r; }
typedef float f32x2 __attribute__((ext_vector_type(2)));
typedef __bf16 bf16x2_t __attribute__((ext_vector_type(2)));
__device__ __forceinline__ unsigned pk2(float lo, float hi) { f32x2 v = {lo, hi}; bf16x2_t b = __builtin_convertvector(v, bf16x2_t); return __builtin_bit_cast(unsigned, b); }
__device__ __forceinline__ float silu_f(float g) { return g * __builtin_amdgcn_rcpf(1.0f + __expf(-g)); }

struct EpiPlain {
    static constexpr bool PERM = true, AFTER_DRAIN = false;
    bf16_t* O; int ldc;
    __device__ __forceinline__ void operator()(const f32x4 (&acc)[2][2][4][2], const Unit& u, int wr, int wc, int fr, int fq) const {
        const int row0 = u.pm * BM + wr * 64 + fr, col0 = u.pn * BM + wc * 32 + 8 * fq;
#pragma unroll
        for (int ai = 0; ai < 2; ++ai)
#pragma unroll
            for (int m = 0; m < 4; ++m) { bf16_t* rowp = O + (size_t)(row0 + ai * HALF + m * 16) * ldc + col0;
#pragma unroll
                for (int bj = 0; bj < 2; ++bj) { const f32x4 v0 = acc[ai][bj][m][0], v1 = acc[ai][bj][m][1];
                    u32x4 w; w.x = pk2(v0[0], v0[1]); w.y = pk2(v0[2], v0[3]); w.z = pk2(v1[0], v1[1]); w.w = pk2(v1[2], v1[3]);
                    *(u32x4*)(rowp + bj * HALF) = w; } }
    }
};
struct EpiDnIn {
    static constexpr bool PERM = true, AFTER_DRAIN = false;
    bf16_t* O; float* BA;
    __device__ __forceinline__ void operator()(const f32x4 (&acc)[2][2][4][2], const Unit& u, int wr, int wc, int fr, int fq) const {
        const int row0 = u.pm * BM + wr * 64 + fr;
        if (u.pn < 48) {
            bf16_t* base = O + (size_t)(u.pn >> 4) * ((size_t)8192 * 4096);
            const int col0 = (u.pn & 15) * BM + wc * 32 + 8 * fq;
#pragma unroll
            for (int ai = 0; ai < 2; ++ai)
#pragma unroll
                for (int m = 0; m < 4; ++m) { bf16_t* rowp = base + (size_t)(row0 + ai * HALF + m * 16) * 4096 + col0;
#pragma unroll
                    for (int bj = 0; bj < 2; ++bj) { const f32x4 v0 = acc[ai][bj][m][0], v1 = acc[ai][bj][m][1];
                        u32x4 w; w.x = pk2(v0[0], v0[1]); w.y = pk2(v0[2], v0[3]); w.z = pk2(v1[0], v1[1]); w.w = pk2(v1[2], v1[3]);
                        *(u32x4*)(rowp + bj * HALF) = w; } }
        } else if (wc < 2) {
            const int col0 = wc * 32 + 8 * fq;
#pragma unroll
            for (int ai = 0; ai < 2; ++ai)
#pragma unroll
                for (int m = 0; m < 4; ++m) { float* rowp = BA + (size_t)(row0 + ai * HALF + m * 16) * 64 + col0;
                    *(f32x4*)(rowp) = acc[ai][0][m][0]; *(f32x4*)(rowp + 4) = acc[ai][0][m][1]; }
        }
    }
};
struct EpiSwiGLU {
    static constexpr bool PERM = true, AFTER_DRAIN = false;
    bf16_t* O; int ldc;
    __device__ __forceinline__ void operator()(const f32x4 (&acc)[2][2][4][2], const Unit& u, int wr, int wc, int fr, int fq) const {
        const int row0 = u.pm * BM + wr * 64 + fr, col0 = u.pn * HALF + wc * 32 + 8 * fq;
#pragma unroll
        for (int ai = 0; ai < 2; ++ai)
#pragma unroll
            for (int m = 0; m < 4; ++m) { bf16_t* rowp = O + (size_t)(row0 + ai * HALF + m * 16) * ldc + col0;
                const f32x4 g0 = acc[ai][0][m][0], g1 = acc[ai][0][m][1], u0 = acc[ai][1][m][0], u1 = acc[ai][1][m][1];
                u32x4 w;
                w.x = pk2(silu_f(g0[0]) * u0[0], silu_f(g0[1]) * u0[1]); w.y = pk2(silu_f(g0[2]) * u0[2], silu_f(g0[3]) * u0[3]);
                w.z = pk2(silu_f(g1[0]) * u1[0], silu_f(g1[1]) * u1[1]); w.w = pk2(silu_f(g1[2]) * u1[2], silu_f(g1[3]) * u1[3]);
                *(u32x4*)(rowp) = w; }
    }
};
struct EpiResid {
    static constexpr bool PERM = false, AFTER_DRAIN = false;
    const float* resid; float* out; int ldc; float alpha, scale;
    __device__ __forceinline__ void operator()(const f32x4 (&acc)[2][2][4][2], const Unit& u, int wr, int wc, int fr, int fq) const {
        const int col0 = u.pn * BM + wc * 32 + 4 * fq;
#pragma unroll
        for (int ai = 0; ai < 2; ++ai)
#pragma unroll
            for (int m = 0; m < 4; ++m) { const size_t off = (size_t)(u.pm * BM + ai * HALF + wr * 64 + m * 16 + fr) * ldc + col0;
                f32x4 rv[2][2];
#pragma unroll
                for (int bj = 0; bj < 2; ++bj)
#pragma unroll
                    for (int n = 0; n < 2; ++n) rv[bj][n] = *(const f32x4*)(resid + off + bj * HALF + n * 16);
#pragma unroll
                for (int bj = 0; bj < 2; ++bj)
#pragma unroll
                    for (int n = 0; n < 2; ++n) *(f32x4*)(out + off + bj * HALF + n * 16) = rv[bj][n] * alpha + acc[ai][bj][m][n] * scale;
                asm volatile("" ::: "memory"); }
    }
};
template <class Epi, class Sched, bool ALIGN_EPI = false, bool SP2 = false>
__device__ __forceinline__ void gemm_phase(PG8_LAS unsigned char* lds, const Gemm g, const Sched& S, const Epi& E) {
    const int tid = threadIdx.x, wid = __builtin_amdgcn_readfirstlane(tid >> 6), lane = tid & 63, wr = wid >> 2, wc = wid & 3, fr = lane & 15, fq = lane >> 4;
    const int K = g.K, nt = K / BK;
    unsigned voffA[2], voffB[2];
#pragma unroll
    for (int i = 0; i < 2; ++i) { int R, C; stage_rc(tid * 16 + i * 8192, R, C); const int Rb = Epi::PERM ? ((R & ~31) + perm32(R & 31)) : R;
        voffA[i] = (unsigned)(R * K + C) * 2u; voffB[i] = (unsigned)(Rb * K + C) * 2u; }
    const size_t kstep = (size_t)(BK * 2);
    const size_t hstep = (size_t)HALF * K * 2;
    const size_t tstep = 2 * hstep;
    const unsigned ldsw = (unsigned)wid * 1024u;
    const int aoff = lds_byte(wr * 64 + fr, fq * 8), boff = lds_byte(wc * 32 + fr, fq * 8);
#define PG8_SA(b, h) (((b) * 2 + (h)) * HTB)
#define PG8_SB(b, h) ((4 + (b) * 2 + (h)) * HTB)
#define PG8_STAGE(bufoff, gbase, voff) do { _Pragma("unroll") for (int _i = 0; _i < 2; ++_i) \
        __builtin_amdgcn_global_load_lds((const unsigned*)((const char*)(gbase) + (voff)[_i]), (PG8_LAS unsigned*)(lds + (bufoff) + ldsw + _i * 8192), 16, 0, 0); } while (0)
#define PG8_LDA(dst, b, h) do { _Pragma("unroll") for (int m = 0; m < 4; ++m) _Pragma("unroll") for (int k = 0; k < 2; ++k) dst[m][k] = *(const PG8_LAS bf16x8*)(lds + PG8_SA(b, h) + aoff + m * 2048 + k * 1024); } while (0)
#define PG8_LDB(dst, b, h) do { _Pragma("unroll") for (int n = 0; n < 2; ++n) _Pragma("unroll") for (int k = 0; k < 2; ++k) dst[n][k] = *(const PG8_LAS bf16x8*)(lds + PG8_SB(b, h) + boff + n * 2048 + k * 1024); } while (0)
#define PG8_MMA(ai, bj, At, Bt) do { __builtin_amdgcn_s_setprio(1); _Pragma("unroll") for (int m = 0; m < 4; ++m) _Pragma("unroll") for (int n = 0; n < 2; ++n) _Pragma("unroll") for (int k = 0; k < 2; ++k) \
        acc[ai][bj][m][n] = __builtin_amdgcn_mfma_f32_16x16x32_bf16(Bt[n][k], At[m][k], acc[ai][bj][m][n], 0, 0, 0); __builtin_amdgcn_s_setprio(0); } while (0)
#define PG8_WAIT_V(n) asm volatile("s_waitcnt vmcnt(" #n ")" ::: "memory")
#define PG8_WAIT_L(n) asm volatile("s_waitcnt lgkmcnt(" #n ")" ::: "memory")
#define PG8_BAR __builtin_amdgcn_s_barrier()
#define PG8_SCHED __builtin_amdgcn_sched_barrier(0)
    Unit cur, nxt; int ui = 0;
    if (!S.next(0, cur)) return;
    f32x4 acc[2][2][4][2];
#pragma unroll
    for (int a = 0; a < 2; ++a)
#pragma unroll
        for (int b = 0; b < 2; ++b)
#pragma unroll
            for (int m = 0; m < 4; ++m)
#pragma unroll
                for (int n = 0; n < 2; ++n) acc[a][b][m][n] = (f32x4){0.f, 0.f, 0.f, 0.f};
    bf16x8 At[4][2], B0[2][2], B1[2][2];
    const char* cA = (const char*)g.A + (size_t)cur.pm * tstep; const char* cB = (const char*)g.Bt + (size_t)cur.pn * tstep;
    S.a_ready(cur);
    if constexpr (SP2) {
        PG8_STAGE(PG8_SB(0, 0), cB, voffB); PG8_STAGE(PG8_SB(0, 1), cB + hstep, voffB); PG8_STAGE(PG8_SA(0, 0), cA, voffA); PG8_STAGE(PG8_SA(0, 1), cA + hstep, voffA);
        if (wr == 1) PG8_BAR;
        PG8_WAIT_V(2); PG8_BAR;
        PG8_STAGE(PG8_SB(1, 0), cB + kstep, voffB); PG8_STAGE(PG8_SA(1, 0), cA + kstep, voffA); PG8_STAGE(PG8_SB(1, 1), cB + hstep + kstep, voffB);
        PG8_WAIT_V(6); PG8_BAR;
    } else {
        PG8_STAGE(PG8_SB(0, 0), cB, voffB); PG8_STAGE(PG8_SA(0, 0), cA, voffA); PG8_STAGE(PG8_SB(0, 1), cB + hstep, voffB); PG8_STAGE(PG8_SA(0, 1), cA + hstep, voffA);
        if (wr == 1) PG8_BAR;
        PG8_WAIT_V(4); PG8_BAR;
        PG8_STAGE(PG8_SB(1, 0), cB + kstep, voffB); PG8_STAGE(PG8_SA(1, 0), cA + kstep, voffA); PG8_STAGE(PG8_SB(1, 1), cB + hstep + kstep, voffB);
        PG8_WAIT_V(6); PG8_BAR;
    }
    for (;;) {
        const bool has_next = S.next(ui + 1, nxt);
        const char* nA = has_next ? (const char*)g.A + (size_t)nxt.pm * tstep : cA; const char* nB = has_next ? (const char*)g.Bt + (size_t)nxt.pn * tstep : cB;
        for (int t = 0; t < nt; t += 2) {
            const bool last = (t == nt - 2);
            const char* a1 = cA + (size_t)(t + 1) * kstep;
            const char* a2 = last ? nA : cA + (size_t)(t + 2) * kstep; const char* b2 = last ? nB : cB + (size_t)(t + 2) * kstep;
            const char* a3 = a2 + kstep; const char* b3 = b2 + kstep;
            if (last && has_next) S.a_ready(nxt);
            if constexpr (SP2) {
            PG8_LDB(B0, 0, 0); PG8_LDB(B1, 0, 1); PG8_SCHED; PG8_LDA(At, 0, 0); PG8_STAGE(PG8_SA(1, 1), a1 + hstep, voffA);
            PG8_WAIT_V(8); PG8_WAIT_L(0); PG8_BAR; PG8_MMA(0, 0, At, B0); PG8_MMA(0, 1, At, B1); PG8_BAR; PG8_SCHED;
            PG8_LDA(At, 0, 1); PG8_STAGE(PG8_SB(0, 0), b2, voffB); PG8_STAGE(PG8_SB(0, 1), b2 + hstep, voffB); PG8_STAGE(PG8_SA(0, 0), a2, voffA);
            PG8_WAIT_V(8); PG8_WAIT_L(0); PG8_BAR; PG8_MMA(1, 0, At, B0); PG8_MMA(1, 1, At, B1); PG8_BAR; PG8_SCHED;
            PG8_LDB(B0, 1, 0); PG8_LDB(B1, 1, 1); PG8_SCHED; PG8_LDA(At, 1, 0); PG8_STAGE(PG8_SA(0, 1), a2 + hstep, voffA);
            PG8_WAIT_V(8); PG8_WAIT_L(0); PG8_BAR; PG8_MMA(0, 0, At, B0); PG8_MMA(0, 1, At, B1); PG8_BAR; PG8_SCHED;
            PG8_LDA(At, 1, 1); PG8_STAGE(PG8_SB(1, 0), b3, voffB); PG8_STAGE(PG8_SB(1, 1), b3 + hstep, voffB); PG8_STAGE(PG8_SA(1, 0), a3, voffA);
            PG8_WAIT_V(8); PG8_WAIT_L(0); PG8_BAR; PG8_MMA(1, 0, At, B0); PG8_MMA(1, 1, At, B1); PG8_BAR; PG8_SCHED;
            } else {
            PG8_LDB(B0, 0, 0); PG8_SCHED; PG8_LDA(At, 0, 0); PG8_STAGE(PG8_SA(1, 1), a1 + hstep, voffA);
            PG8_WAIT_L(8); PG8_BAR; PG8_WAIT_L(0); PG8_MMA(0, 0, At, B0); PG8_BAR; PG8_SCHED;
            PG8_LDB(B1, 0, 1); PG8_STAGE(PG8_SB(0, 0), b2, voffB);
            PG8_BAR; PG8_WAIT_L(0); PG8_MMA(0, 1, At, B1); PG8_BAR;
            PG8_LDA(At, 0, 1); PG8_STAGE(PG8_SA(0, 0), a2, voffA);
            PG8_BAR; PG8_WAIT_L(0); PG8_MMA(1, 0, At, B0); PG8_BAR; PG8_SCHED;
            PG8_STAGE(PG8_SB(0, 1), b2 + hstep, voffB);
            PG8_WAIT_V(6); PG8_BAR; PG8_MMA(1, 1, At, B1); PG8_BAR;
            PG8_LDB(B0, 1, 0); PG8_SCHED; PG8_LDA(At, 1, 0); PG8_STAGE(PG8_SA(0, 1), a2 + hstep, voffA);
            PG8_WAIT_L(8); PG8_BAR; PG8_WAIT_L(0); PG8_MMA(0, 0, At, B0); PG8_BAR; PG8_SCHED;
            PG8_LDB(B1, 1, 1); PG8_STAGE(PG8_SB(1, 0), b3, voffB);
            PG8_BAR; PG8_WAIT_L(0); PG8_MMA(0, 1, At, B1); PG8_BAR;
            PG8_LDA(At, 1, 1); PG8_STAGE(PG8_SA(1, 0), a3, voffA);
            PG8_BAR; PG8_WAIT_L(0); PG8_MMA(1, 0, At, B0); PG8_BAR; PG8_SCHED;
            PG8_STAGE(PG8_SB(1, 1), b3 + hstep, voffB);
            PG8_WAIT_V(6); PG8_BAR; PG8_MMA(1, 1, At, B1); PG8_BAR;
            }
        }
        if constexpr (ALIGN_EPI) { if (wr == 0) PG8_BAR; }
        if constexpr (!Epi::AFTER_DRAIN) { E(acc, cur, wr, wc, fr, fq); S.done(cur); }
        if (!has_next) break;
#pragma unroll
        for (int a = 0; a < 2; ++a)
#pragma unroll
            for (int b = 0; b < 2; ++b)
#pragma unroll
                for (int m = 0; m < 4; ++m)
#pragma unroll
                    for (int n = 0; n < 2; ++n) acc[a][b][m][n] = (f32x4){0.f, 0.f, 0.f, 0.f};
        cur = nxt; cA = nA; cB = nB; ++ui;
        if constexpr (ALIGN_EPI) { if (wr == 1) PG8_BAR; }
    }
    PG8_WAIT_V(0);
    if constexpr (!ALIGN_EPI) { if (wr == 0) PG8_BAR; }
    PG8_BAR;
    if constexpr (Epi::AFTER_DRAIN) { E.fused(acc, cur, wr, wc, fr, fq, lds, wid, lane); S.done(cur); }
#undef PG8_SA
#undef PG8_SB
#undef PG8_STAGE
#undef PG8_LDA
#undef PG8_LDB
#undef PG8_MMA
#undef PG8_WAIT_V
#undef PG8_WAIT_L
#undef PG8_BAR
#undef PG8_SCHED
}
}
#define LAS __attribute__((address_space(3)))
#define DI __device__ __forceinline__
typedef unsigned short bf16_t;
typedef short bf16x8 __attribute__((ext_vector_type(8)));
typedef float f32x4 __attribute__((ext_vector_type(4)));
typedef float f32x16 __attribute__((ext_vector_type(16)));
typedef unsigned u32x4 __attribute__((ext_vector_type(4)));
typedef unsigned u32x2 __attribute__((ext_vector_type(2)));
using pg8::pk2;

constexpr int NWAVES = 8, NTHREADS = 512;
constexpr int D = 2048, BATCH = 4, SEQ = 2048, M = BATCH * SEQ, DFF = 5632;
constexpr int AB_IN = 5120, DN_IN = 12352, DN_IN_PAD = 12544;
constexpr float ALPHA = 1.41421356237f;
constexpr float LN_EPS = 1e-5f, RMS_EPS = 1e-6f;
constexpr size_t MiB = (size_t)1 << 20;
constexpr size_t WS_L0 = 0;
constexpr size_t WS_WGU1_0 = 0, WS_WD1_0 = 44 * MiB, WS_WGU2_0 = 66 * MiB, WS_WD2_0 = 110 * MiB, WS_WABIN = 132 * MiB, WS_WABOUT = 152 * MiB;
constexpr size_t WS_WGU1_1 = 160 * MiB, WS_WD1_1 = 204 * MiB, WS_WGU2_1 = 226 * MiB, WS_WD2_1 = 270 * MiB, WS_WDNIN = 292 * MiB, WS_WDNOUT = 341 * MiB;
constexpr size_t WS_XB = 357 * MiB;
constexpr size_t WS_BIG = 389 * MiB;
constexpr size_t WS_BA = WS_BIG + 192 * MiB;
constexpr size_t WS_DNX = 585 * MiB;
constexpr size_t WS_QR = WS_DNX, WS_KR = WS_DNX + 16 * MiB, WS_VT = WS_DNX + 32 * MiB, WS_CAT = WS_DNX + 48 * MiB, WS_KMEAN = WS_DNX + 80 * MiB;
constexpr size_t WS_QN = WS_DNX, WS_KN = WS_DNX + 32 * MiB, WS_V = WS_DNX + 64 * MiB, WS_G = WS_DNX + 128 * MiB, WS_BETA = WS_DNX + 129 * MiB;
constexpr size_t WS_OG = WS_L0;
constexpr size_t WS_WIMG = WS_BIG, WS_UIMG = WS_BIG + 64 * MiB;
constexpr size_t WS_AIMG = WS_L0 + 64 * MiB, WS_QIMG = WS_L0 + 96 * MiB, WS_KTIMG = WS_L0 + 128 * MiB;
constexpr size_t WS_GC = 715 * MiB;
constexpr size_t WS_BAR = 717 * MiB, BAR_BYTES = 16384;
constexpr size_t WS_END = 718 * MiB;
constexpr int LDS_BYTES = 147456;

DI float bflo(unsigned u) { return __uint_as_float(u << 16); }
DI float bfhi(unsigned u) { return __uint_as_float(u & 0xffff0000u); }
DI float bf2f(bf16_t h) { return __uint_as_float((unsigned)h << 16); }
DI bf16_t f2bf(float f) { return (bf16_t)(pk2(f, 0.f) & 0xffffu); }
DI float wave_sum(float v) {
#pragma unroll
    for (int o = 1; o < 64; o <<= 1) v += __shfl_xor(v, o);
    return v;
}
DI float gelu_tanh(float x) { const float t = 1.5957691216f * (x + 0.044715f * x * x * x); return x * __builtin_amdgcn_rcpf(1.0f + __expf(-t)); }
DI int crow(int r, int h) { return (r & 3) + 8 * (r >> 2) + 4 * h; }
#define MFMA32(a, b, c) __builtin_amdgcn_mfma_f32_32x32x16_bf16((a), (b), (c), 0, 0, 0)
DI bf16x8 pack8(float a0, float a1, float a2, float a3, float a4, float a5, float a6, float a7) {
    u32x4 p; p.x = pk2(a0, a1); p.y = pk2(a2, a3); p.z = pk2(a4, a5); p.w = pk2(a6, a7); return __builtin_bit_cast(bf16x8, p);
}

DI void tr_tile(const float* __restrict__ W, int K, int N, bf16_t* __restrict__ WT, int k0, int n0, int drow0, LAS float* scr, int lane) {
#pragma unroll 4
    for (int i = 0; i < 16; ++i) { const int kk = 4 * i + (lane >> 4), c4 = (lane & 15) * 4;
        const f32x4 v = *(const f32x4*)(W + (size_t)(k0 + kk) * N + n0 + c4);
        LAS float* s = scr + kk * 65 + c4; s[0] = v.x; s[1] = v.y; s[2] = v.z; s[3] = v.w; }
    asm volatile("s_waitcnt lgkmcnt(0)" ::: "memory");
    const int c = lane & 7;
#pragma unroll
    for (int j = 0; j < 8; ++j) { const int n = (lane >> 3) + 8 * j; const LAS float* s = scr + (8 * c) * 65 + n;
        u32x4 o; o.x = pk2(s[0], s[65]); o.y = pk2(s[2 * 65], s[3 * 65]); o.z = pk2(s[4 * 65], s[5 * 65]); o.w = pk2(s[6 * 65], s[7 * 65]);
        *(u32x4*)(WT + (size_t)(drow0 + n) * K + k0 + 8 * c) = o; }
    asm volatile("s_waitcnt lgkmcnt(0)" ::: "memory");
}
DI void tr_matrix(const float* W, int K, int N, bf16_t* WT, int mode, LAS float* scr, int gw, int ngw, int lane) {
    const int nb = N / 64, items = (K / 64) * nb;
    for (int it = gw; it < items; it += ngw) {
        const int kb = it / nb, n0 = (it % nb) * 64;
        const int drow0 = mode == 0 ? n0 : ((n0 >> 7) * 256 + (n0 & 127) + (mode == 2 ? 128 : 0));
        tr_tile(W, K, N, WT, kb * 64, n0, drow0, scr, lane);
    }
}

struct Args { const float* in[21]; float* out; unsigned char* ws; int ph_lo, ph_hi; };

DI void p0_prologue(const Args& a, LAS unsigned char* lds, int wave, int lane) {
    LAS float* scr = (LAS float*)(lds + wave * 17408);
    const int gw = blockIdx.x * NWAVES + wave, ngw = gridDim.x * NWAVES;
    unsigned char* ws = a.ws;
    const size_t WGU = (size_t)D * DFF;
    for (int l = 0; l < 2; ++l) {
        bf16_t* gu1 = (bf16_t*)(ws + (l ? WS_WGU1_1 : WS_WGU1_0)); bf16_t* d1 = (bf16_t*)(ws + (l ? WS_WD1_1 : WS_WD1_0));
        bf16_t* gu2 = (bf16_t*)(ws + (l ? WS_WGU2_1 : WS_WGU2_0)); bf16_t* d2 = (bf16_t*)(ws + (l ? WS_WD2_1 : WS_WD2_0));
        tr_matrix(a.in[1] + l * WGU, D, DFF, gu1, 1, scr, gw, ngw, lane);
        tr_matrix(a.in[2] + l * WGU, D, DFF, gu1, 2, scr, gw, ngw, lane);
        tr_matrix(a.in[3] + l * WGU, DFF, D, d1, 0, scr, gw, ngw, lane);
        tr_matrix(a.in[4] + l * WGU, D, DFF, gu2, 1, scr, gw, ngw, lane);
        tr_matrix(a.in[5] + l * WGU, D, DFF, gu2, 2, scr, gw, ngw, lane);
        tr_matrix(a.in[6] + l * WGU, DFF, D, d2, 0, scr, gw, ngw, lane);
    }
    tr_matrix(a.in[9], D, AB_IN, (bf16_t*)(ws + WS_WABIN), 0, scr, gw, ngw, lane);
    tr_matrix(a.in[14], D, D, (bf16_t*)(ws + WS_WABOUT), 0, scr, gw, ngw, lane);
    tr_matrix(a.in[15], D, DN_IN, (bf16_t*)(ws + WS_WDNIN), 0, scr, gw, ngw, lane);
    tr_matrix(a.in[20], 4096, D, (bf16_t*)(ws + WS_WDNOUT), 0, scr, gw, ngw, lane);
    { u32x4* p = (u32x4*)((bf16_t*)(ws + WS_WDNIN) + (size_t)DN_IN * D); const int n16 = (DN_IN_PAD - DN_IN) * D / 8;
      for (int i = blockIdx.x * NTHREADS + threadIdx.x; i < n16; i += gridDim.x * NTHREADS) p[i] = (u32x4){0u, 0u, 0u, 0u}; }
    { const f32x4* x4 = (const f32x4*)a.in[0]; u32x2* xb = (u32x2*)(ws + WS_XB); const int n4 = M * D / 4;
      for (int i = blockIdx.x * NTHREADS + threadIdx.x; i < n4; i += gridDim.x * NTHREADS) { const f32x4 v = x4[i]; xb[i] = (u32x2){pk2(v.x, v.y), pk2(v.z, v.w)}; } }
}

DI void ln_phase(float* Y, bf16_t* XB, const float* g, const float* b, int wave, int lane) {
    const int gw = blockIdx.x * NWAVES + wave, ngw = gridDim.x * NWAVES;
    for (int m = gw; m < M; m += ngw) {
        f32x4* yr = (f32x4*)(Y + (size_t)m * D) + lane;
        f32x4 v[8]; float s = 0.f;
#pragma unroll
        for (int j = 0; j < 8; ++j) { v[j] = yr[64 * j]; s += (v[j].x + v[j].y) + (v[j].z + v[j].w); }
        const float mean = wave_sum(s) * (1.f / D); float s2 = 0.f;
#pragma unroll
        for (int j = 0; j < 8; ++j) { v[j] = v[j] - mean; s2 += (v[j].x * v[j].x + v[j].y * v[j].y) + (v[j].z * v[j].z + v[j].w * v[j].w); }
        const float rstd = rsqrtf(wave_sum(s2) * (1.f / D) + LN_EPS);
        u32x2* o8 = (u32x2*)(XB + (size_t)m * D) + lane;
#pragma unroll
        for (int j = 0; j < 8; ++j) { const f32x4 gg = ((const f32x4*)g)[lane + 64 * j], bb = ((const f32x4*)b)[lane + 64 * j];
            const f32x4 o = v[j] * rstd * gg + bb; yr[64 * j] = o; o8[64 * j] = (u32x2){pk2(o.x, o.y), pk2(o.z, o.w)}; }
    }
}

DI void rope_item(const bf16_t* HC, bf16_t* Qr, bf16_t* Kr, bf16_t* Vt, float* kmean, int item, LAS float* red, int tid) {
    const int h = item & 7, blk = (item >> 3) & 7, b = item >> 6, bh = b * 8 + h;
    const int i = tid & 63, rg = tid >> 6;
    const float inv = expf((-9.210340371976184f * (float)i) * 0.015625f);
    float ks0 = 0.f, ks1 = 0.f;
    for (int rr = 0; rr < 32; ++rr) {
        const int pos = blk * 256 + rr * 8 + rg; const size_t row = (size_t)b * SEQ + pos;
        float sn, cs; sincosf((float)pos * inv, &sn, &cs);
        const bf16_t* hp = HC + row * AB_IN + h * 128 + i;
        const float q1 = bf2f(hp[0]), q2 = bf2f(hp[64]), k1 = bf2f(hp[1024]), k2 = bf2f(hp[1024 + 64]);
        const bf16_t v1 = hp[2048], v2 = hp[2048 + 64];
        const float qa = (q1 * cs - q2 * sn) * 0.08838834764831845f, qb = (q2 * cs + q1 * sn) * 0.08838834764831845f;
        const float ka = k1 * cs - k2 * sn, kb = k2 * cs + k1 * sn;
        const size_t o = ((size_t)bh * SEQ + pos) * 128 + i;
        Qr[o] = f2bf(qa); Qr[o + 64] = f2bf(qb); Kr[o] = f2bf(ka); Kr[o + 64] = f2bf(kb);
        ks0 += ka; ks1 += kb;
        Vt[((size_t)bh * 128 + i) * SEQ + pos] = v1; Vt[((size_t)bh * 128 + i + 64) * SEQ + pos] = v2;
    }
    red[rg * 128 + i] = ks0; red[rg * 128 + 64 + i] = ks1;
    __syncthreads();
    if (tid < 128) { float s = 0.f;
#pragma unroll
        for (int g = 0; g < 8; ++g) s += red[g * 128 + tid];
        kmean[((size_t)bh * 8 + blk) * 128 + tid] = s * (1.f / 256.f); }
    __syncthreads();
}

DI void gmlp_item(const bf16_t* HC, const float* lng, const float* lnb, const float* w_s, const float* b_s, bf16_t* CAT, int item, LAS unsigned char* lds, int wave, int lane) {
    const int g = item & 7, c = (item >> 3) & 15, b = item >> 7;
    const size_t row0 = (size_t)b * SEQ + c * 128;
    LAS bf16_t* vnT = (LAS bf16_t*)lds;
    { const float g0 = lng[g * 128 + 2 * lane], g1 = lng[g * 128 + 2 * lane + 1], b0 = lnb[g * 128 + 2 * lane], b1 = lnb[g * 128 + 2 * lane + 1];
      for (int ss = 0; ss < 16; ++ss) { const int s = wave * 16 + ss;
        const unsigned raw = *(const unsigned*)(HC + (row0 + s) * AB_IN + 4096 + g * 128 + 2 * lane);
        const float v0 = gelu_tanh(bflo(raw)), v1 = gelu_tanh(bfhi(raw));
        const float mu = wave_sum(v0 + v1) * (1.f / 128.f); const float d0 = v0 - mu, d1 = v1 - mu;
        const float rstd = rsqrtf(wave_sum(d0 * d0 + d1 * d1) * (1.f / 128.f) + LN_EPS);
        vnT[(2 * lane) * 136 + s] = f2bf(d0 * rstd * g0 + b0); vnT[(2 * lane + 1) * 136 + s] = f2bf(d1 * rstd * g1 + b1); } }
    __syncthreads();
    const int tt = wave >> 1, dh = wave & 1, r32 = lane & 31, hi = lane >> 5;
    f32x16 acc[2];
#pragma unroll
    for (int j = 0; j < 2; ++j)
#pragma unroll
        for (int r = 0; r < 16; ++r) acc[j][r] = 0.f;
    const int t = 32 * tt + r32; const float* wrow = w_s + ((size_t)g * 128 + t) * 128;
    for (int st = 0; st < 2 * (tt + 1); ++st) { const int s0 = 16 * st + 8 * hi;
        const f32x4 w0 = *(const f32x4*)(wrow + s0), w1 = *(const f32x4*)(wrow + s0 + 4);
        const bf16x8 a = pack8(s0 + 0 <= t ? w0.x : 0.f, s0 + 1 <= t ? w0.y : 0.f, s0 + 2 <= t ? w0.z : 0.f, s0 + 3 <= t ? w0.w : 0.f,
                               s0 + 4 <= t ? w1.x : 0.f, s0 + 5 <= t ? w1.y : 0.f, s0 + 6 <= t ? w1.z : 0.f, s0 + 7 <= t ? w1.w : 0.f);
#pragma unroll
        for (int j = 0; j < 2; ++j) { const bf16x8 bv = *(const LAS bf16x8*)(vnT + (32 * (2 * dh + j) + r32) * 136 + s0); acc[j] = MFMA32(a, bv, acc[j]); } }
#pragma unroll
    for (int j = 0; j < 2; ++j) { const int d = 32 * (2 * dh + j) + r32;
#pragma unroll
        for (int r = 0; r < 16; ++r) { const int tq = 32 * tt + crow(r, hi); const size_t row = row0 + tq;
            const float uval = gelu_tanh(bf2f(HC[row * AB_IN + 3072 + g * 128 + d]));
            CAT[row * D + 1024 + g * 128 + d] = f2bf(uval * (acc[j][r] + b_s[g * 128 + tq])); } }
    __syncthreads();
}

DI void moba_wave(const bf16_t* Qr, const bf16_t* Kr, const bf16_t* Vt, const float* kmean, bf16_t* CAT, int bh, int qt, int lane) {
    const int qi = lane & 31, hi = lane >> 5, q0 = qt * 32, own = q0 >> 8, pos = q0 + qi, b = bh >> 3, h = bh & 7;
    bf16x8 qf[8];
    { const bf16_t* qp = Qr + ((size_t)bh * SEQ + pos) * 128 + 8 * hi;
#pragma unroll
      for (int st = 0; st < 8; ++st) qf[st] = *(const bf16x8*)(qp + 16 * st); }
    unsigned selmask = 0u;
    if (own > 0) {
        f32x16 ga;
#pragma unroll
        for (int r = 0; r < 16; ++r) ga[r] = 0.f;
#pragma unroll
        for (int st = 0; st < 8; ++st) { bf16x8 a = (bf16x8){0, 0, 0, 0, 0, 0, 0, 0};
            if (qi < 8) { const float* kp = kmean + ((size_t)bh * 8 + qi) * 128 + 16 * st + 8 * hi; const f32x4 k0 = *(const f32x4*)kp, k1 = *(const f32x4*)(kp + 4);
                a = pack8(k0.x, k0.y, k0.z, k0.w, k1.x, k1.y, k1.z, k1.w); }
            ga = MFMA32(a, qf[st], ga); }
        float g[8];
#pragma unroll
        for (int r = 0; r < 4; ++r) { const float mine = ga[r], other = __shfl_xor(mine, 32); g[r] = hi ? other : mine; g[4 + r] = hi ? mine : other; }
        const int nsel = own < 3 ? own : 3;
#pragma unroll
        for (int j = 0; j < 8; ++j) { int rank = 0;
#pragma unroll
            for (int i2 = 0; i2 < 8; ++i2) if (i2 != j) rank += (i2 < own && (g[i2] > g[j] || (g[i2] == g[j] && i2 < j))) ? 1 : 0;
            if (j < own && rank < nsel) selmask |= 1u << j; }
    }
    f32x16 o[4];
#pragma unroll
    for (int dt = 0; dt < 4; ++dt)
#pragma unroll
        for (int r = 0; r < 16; ++r) o[dt][r] = 0.f;
    float mrun = -INFINITY, lrun = 0.f;
    for (int j = 0; j <= own; ++j) {
        const bool act = (j == own) || ((selmask >> j) & 1u);
        if (__ballot(act) == 0ull) continue;
        const int nkt = (j == own) ? ((q0 & 255) >> 5) + 1 : 8;
        for (int kt = 0; kt < nkt; ++kt) {
            const int key0 = j * 256 + kt * 32;
            f32x16 s;
#pragma unroll
            for (int r = 0; r < 16; ++r) s[r] = 0.f;
            const bf16_t* kp = Kr + ((size_t)bh * SEQ + key0 + qi) * 128 + 8 * hi;
#pragma unroll
            for (int st = 0; st < 8; ++st) s = MFMA32(*(const bf16x8*)(kp + 16 * st), qf[st], s);
            float mt = -INFINITY;
#pragma unroll
            for (int r = 0; r < 16; ++r) { const int key = key0 + crow(r, hi); const bool ok = act && (j < own || key <= pos); s[r] = ok ? s[r] : -INFINITY; mt = fmaxf(mt, s[r]); }
            mt = fmaxf(mt, __shfl_xor(mt, 32));
            const float mnew = fmaxf(mrun, mt), muse = (mnew == -INFINITY) ? 0.f : mnew;
            const float alpha = __expf(mrun - muse);
            float ls = 0.f;
#pragma unroll
            for (int r = 0; r < 16; ++r) { s[r] = __expf(s[r] - muse); ls += s[r]; }
            lrun = lrun * alpha + ls; mrun = mnew;
#pragma unroll
            for (int dt = 0; dt < 4; ++dt)
#pragma unroll
                for (int r = 0; r < 16; ++r) o[dt][r] *= alpha;
#pragma unroll
            for (int sp = 0; sp < 2; ++sp) {
                const bf16x8 pb = pack8(s[8 * sp], s[8 * sp + 1], s[8 * sp + 2], s[8 * sp + 3], s[8 * sp + 4], s[8 * sp + 5], s[8 * sp + 6], s[8 * sp + 7]);
#pragma unroll
                for (int dt = 0; dt < 4; ++dt) { const bf16_t* vp = Vt + ((size_t)bh * 128 + 32 * dt + qi) * SEQ + key0 + 16 * sp + 4 * hi;
                    const u32x2 lo = *(const u32x2*)vp, hh = *(const u32x2*)(vp + 8);
                    const bf16x8 a = __builtin_bit_cast(bf16x8, (u32x4){lo.x, lo.y, hh.x, hh.y});
                    o[dt] = MFMA32(a, pb, o[dt]); }
            }
        }
    }
    const float ltot = lrun + __shfl_xor(lrun, 32), inv = 1.0f / ltot;
    bf16_t* op = CAT + ((size_t)b * SEQ + pos) * D + h * 128;
#pragma unroll
    for (int dt = 0; dt < 4; ++dt)
#pragma unroll
        for (int g4 = 0; g4 < 4; ++g4) { const int d = 32 * dt + 8 * g4 + 4 * hi;
            *(u32x2*)(op + d) = (u32x2){pk2(o[dt][4 * g4] * inv, o[dt][4 * g4 + 1] * inv), pk2(o[dt][4 * g4 + 2] * inv, o[dt][4 * g4 + 3] * inv)}; }
}

DI float sum16(float v) {
    v += __shfl_xor(v, 1); v += __shfl_xor(v, 2); v += __shfl_xor(v, 4); v += __shfl_xor(v, 8); return v;
}
DI void unpack8(const u32x4 r, float (&x)[8]) { x[0] = bflo(r.x); x[1] = bfhi(r.x); x[2] = bflo(r.y); x[3] = bfhi(r.y); x[4] = bflo(r.z); x[5] = bfhi(r.z); x[6] = bflo(r.w); x[7] = bfhi(r.w); }
DI void dnp_phase(const bf16_t* QKraw, const bf16_t* Vraw, const float* BA, const float* conv_w, const float* a_log, const float* dt_bias,
                  bf16_t* QN, bf16_t* KN, bf16_t* V, float* G, float* BETA, int wave, int lane) {
    const int gw = blockIdx.x * NWAVES + wave, ngw = gridDim.x * NWAVES;
    const int rs = lane >> 4, c8 = (lane & 15) * 8;
    for (int it = gw; it < BATCH * 64 * 32; it += ngw) {
        const int rc = it & 31, hs = (it >> 5) & 63, b = it >> 11;
        const int ch = hs * 128 + c8;
        float w[4][8];
#pragma unroll
        for (int j = 0; j < 4; ++j) { const f32x4 a = *(const f32x4*)(conv_w + j * 8192 + ch), c = *(const f32x4*)(conv_w + j * 8192 + ch + 4);
            w[j][0] = a.x; w[j][1] = a.y; w[j][2] = a.z; w[j][3] = a.w; w[j][4] = c.x; w[j][5] = c.y; w[j][6] = c.z; w[j][7] = c.w; }
        const bf16_t* src = hs < 32 ? QKraw + ch : Vraw + (ch - 4096);
        const int t0 = rc * 64 + rs * 16;
        u32x4 raw[19];
#pragma unroll
        for (int j = 0; j < 19; ++j) { const int t = t0 - 3 + j; raw[j] = (u32x4){0u, 0u, 0u, 0u}; if (t >= 0) raw[j] = *(const u32x4*)(src + ((size_t)b * SEQ + t) * 4096); }
        float xa[8], xb[8], xc[8], xd[8];
        unpack8(raw[0], xa); unpack8(raw[1], xb); unpack8(raw[2], xc);
#pragma unroll
        for (int tt = 0; tt < 16; ++tt) { const size_t row = (size_t)b * SEQ + t0 + tt;
            unpack8(raw[tt + 3], xd);
            float y[8]; float ss = 0.f;
#pragma unroll
            for (int i = 0; i < 8; ++i) { y[i] = pg8::silu_f(xa[i] * w[0][i] + xb[i] * w[1][i] + xc[i] * w[2][i] + xd[i] * w[3][i]); ss += y[i] * y[i]; xa[i] = xb[i]; xb[i] = xc[i]; xc[i] = xd[i]; }
            float sc = 1.0f;
            if (hs < 32) { sc = rsqrtf(sum16(ss) + RMS_EPS) * (hs < 16 ? 0.08838834764831845f : 1.0f); }
            u32x4 o; o.x = pk2(y[0] * sc, y[1] * sc); o.y = pk2(y[2] * sc, y[3] * sc); o.z = pk2(y[4] * sc, y[5] * sc); o.w = pk2(y[6] * sc, y[7] * sc);
            bf16_t* dst = hs < 16 ? QN + row * 2048 + ch : (hs < 32 ? KN + row * 2048 + (ch - 2048) : V + row * 4096 + (ch - 4096));
            *(u32x4*)dst = o; }
    }
    for (int i = blockIdx.x * NTHREADS + threadIdx.x; i < M * 32; i += gridDim.x * NTHREADS) { const int row = i >> 5, h = i & 31;
        const float bb = BA[(size_t)row * 64 + h], aa = BA[(size_t)row * 64 + 32 + h];
        BETA[i] = 1.0f / (1.0f + expf(-bb));
        const float x = aa + dt_bias[h]; const float sp = x > 20.f ? x : log1pf(expf(x));
        G[i] = -expf(a_log[h]) * sp; }
}

constexpr int DA_KS = 0, DA_QS = 17408, DA_VBT = 34816, DA_KBGT = 53248, DA_KT = 71680, DA_AM = 90112, DA_TB = 107520, DA_GC = 116736, DA_BT = 116992, DA_EG = 117248;
DI void dna_item(const bf16_t* QN, const bf16_t* KN, const bf16_t* V, const float* G, const float* BETA,
                 bf16_t* Wimg, bf16_t* Uimg, bf16_t* Aimg, bf16_t* Qimg, bf16_t* KTimg, float* EGt, float* DKt, int item, LAS unsigned char* lds, int tid) {
    const int hv = item & 31, n = (item >> 5) & 31, b = item >> 10, hk = hv >> 1;
    const int lane = tid & 63, wave = __builtin_amdgcn_readfirstlane(tid >> 6), r32 = lane & 31, hi = lane >> 5;
    const size_t row0 = (size_t)b * SEQ + n * 64;
    const int itemk = (b * 32 + n) * 16 + hk;
    LAS bf16_t* Ks = (LAS bf16_t*)(lds + DA_KS); LAS bf16_t* Qs = (LAS bf16_t*)(lds + DA_QS);
    LAS bf16_t* vbT = (LAS bf16_t*)(lds + DA_VBT); LAS bf16_t* kbgT = (LAS bf16_t*)(lds + DA_KBGT); LAS bf16_t* kT = (LAS bf16_t*)(lds + DA_KT);
    LAS float* Am = (LAS float*)(lds + DA_AM); LAS bf16_t* Tb = (LAS bf16_t*)(lds + DA_TB);
    LAS float* gcs = (LAS float*)(lds + DA_GC); LAS float* bts = (LAS float*)(lds + DA_BT); LAS float* egs = (LAS float*)(lds + DA_EG);
    if (wave == 0) { float x = G[(row0 + lane) * 32 + hv];
#pragma unroll
        for (int o = 1; o < 64; o <<= 1) { const float t = __shfl_up(x, o); if (lane >= o) x += t; }
        gcs[lane] = x; egs[lane] = __expf(x); bts[lane] = BETA[(row0 + lane) * 32 + hv];
        const float gl = __shfl(x, 63); const int c5 = lane & 31, ti = (((lane >> 5) * 2 + ((c5 >> 2) & 1)) * 16) + (c5 & 3) + 4 * (c5 >> 3);
        EGt[(size_t)item * 64 + ti] = __expf(x); DKt[(size_t)item * 64 + ti] = __expf(gl - x); }
    __syncthreads();
#pragma unroll
    for (int i = 0; i < 2; ++i) { const int p = tid + 512 * i, e = p >> 4, c8 = (p & 15) * 8;
        const float be = bts[e], bg = be * egs[e];
        const u32x4 kr = *(const u32x4*)(KN + (row0 + e) * 2048 + hk * 128 + c8);
        *(LAS u32x4*)(Ks + e * 136 + c8) = kr;
        const u32x4 qr = *(const u32x4*)(QN + (row0 + e) * 2048 + hk * 128 + c8);
        *(LAS u32x4*)(Qs + e * 136 + c8) = qr;
        const u32x4 vr = *(const u32x4*)(V + (row0 + e) * 4096 + hv * 128 + c8);
        const unsigned kw[4] = {kr.x, kr.y, kr.z, kr.w}, vw[4] = {vr.x, vr.y, vr.z, vr.w};
#pragma unroll
        for (int j = 0; j < 4; ++j) {
            kT[(c8 + 2 * j) * 72 + e] = (bf16_t)(kw[j] & 0xffffu); kT[(c8 + 2 * j + 1) * 72 + e] = (bf16_t)(kw[j] >> 16);
            kbgT[(c8 + 2 * j) * 72 + e] = f2bf(bflo(kw[j]) * bg); kbgT[(c8 + 2 * j + 1) * 72 + e] = f2bf(bfhi(kw[j]) * bg);
            vbT[(c8 + 2 * j) * 72 + e] = f2bf(bflo(vw[j]) * be); vbT[(c8 + 2 * j + 1) * 72 + e] = f2bf(bfhi(vw[j]) * be); } }
    __syncthreads();
    if (wave < 3) { const int ct = wave == 0 ? 0 : 1, et = wave == 2 ? 1 : 0;
        f32x16 acc;
#pragma unroll
        for (int r = 0; r < 16; ++r) acc[r] = 0.f;
#pragma unroll
        for (int st = 0; st < 8; ++st) acc = MFMA32(*(const LAS bf16x8*)(Ks + (32 * ct + r32) * 136 + 16 * st + 8 * hi), *(const LAS bf16x8*)(Ks + (32 * et + r32) * 136 + 16 * st + 8 * hi), acc);
        const int e = 32 * et + r32; const float ge = gcs[e];
#pragma unroll
        for (int r = 0; r < 16; ++r) { const int c = 32 * ct + crow(r, hi); Am[c * 68 + e] = (e < c) ? bts[c] * acc[r] * __expf(gcs[c] - ge) : 0.f; }
    } else if (wave < 6) { const int w3 = wave - 3, et = w3 == 2 ? 1 : 0, ct = w3 == 0 ? 0 : 1;
        f32x16 acc;
#pragma unroll
        for (int r = 0; r < 16; ++r) acc[r] = 0.f;
#pragma unroll
        for (int st = 0; st < 8; ++st) acc = MFMA32(*(const LAS bf16x8*)(Ks + (32 * et + r32) * 136 + 16 * st + 8 * hi), *(const LAS bf16x8*)(Qs + (32 * ct + r32) * 136 + 16 * st + 8 * hi), acc);
        const int c = 32 * ct + r32; const float gcc = gcs[c];
#pragma unroll
        for (int r = 0; r < 16; ++r) { const int e = 32 * et + crow(r, hi); acc[r] = (e <= c) ? acc[r] * __expf(gcc - gcs[e]) : 0.f; }
#pragma unroll
        for (int s = 0; s < 2; ++s) *(u32x4*)(Aimg + ((((size_t)item * 4 + ct * 2 + et) * 2 + s) * 512 + lane * 8)) =
            __builtin_bit_cast(u32x4, pack8(acc[8 * s], acc[8 * s + 1], acc[8 * s + 2], acc[8 * s + 3], acc[8 * s + 4], acc[8 * s + 5], acc[8 * s + 6], acc[8 * s + 7]));
    } else if ((hv & 1) == 0) { const int t2 = tid - 384;
#pragma unroll
        for (int i = 0; i < 8; ++i) { const int p = t2 + 128 * i, ln = p & 63, s = (p >> 6) & 1, tl = p >> 7, lr = ln & 31, lh = ln >> 5;
            const int ct = tl >> 2, kt = tl & 3;
            const LAS bf16_t* src = Qs + (32 * ct + lr) * 136 + 32 * kt + 16 * s + 4 * lh;
            const u32x2 lo = *(const LAS u32x2*)src, hh = *(const LAS u32x2*)(src + 8);
            *(u32x4*)(Qimg + ((((size_t)itemk * 8 + tl) * 2 + s) * 512 + ln * 8)) = (u32x4){lo.x, lo.y, hh.x, hh.y}; }
#pragma unroll
        for (int i = 0; i < 8; ++i) { const int p = t2 + 128 * i, ln = p & 63, s = (p >> 6) & 1, tl = p >> 7, lr = ln & 31, lh = ln >> 5;
            const int kt = tl >> 1, ct = tl & 1;
            const LAS bf16_t* src = kT + (32 * kt + lr) * 72 + 32 * ct + 16 * s + 4 * lh;
            const u32x2 lo = *(const LAS u32x2*)src, hh = *(const LAS u32x2*)(src + 8);
            *(u32x4*)(KTimg + ((((size_t)itemk * 8 + tl) * 2 + s) * 512 + ln * 8)) = (u32x4){lo.x, lo.y, hh.x, hh.y}; }
    }
    __syncthreads();
    if (wave == 0) {
        float T[64]; int zoff; asm volatile("v_mov_b32 %0, 0" : "=v"(zoff));
        const LAS float* Amz = Am + zoff;
#pragma unroll
        for (int i = 0; i < 64; ++i) { float acc = (i == lane) ? 1.f : 0.f;
#pragma unroll
            for (int q = 0; q < (i + 3) / 4; ++q) { const f32x4 a4 = *(const LAS f32x4*)(Amz + i * 68 + 4 * q);
                if (4 * q + 0 < i) acc -= a4.x * T[4 * q + 0];
                if (4 * q + 1 < i) acc -= a4.y * T[4 * q + 1];
                if (4 * q + 2 < i) acc -= a4.z * T[4 * q + 2];
                if (4 * q + 3 < i) acc -= a4.w * T[4 * q + 3]; }
            T[i] = acc; Tb[i * 72 + lane] = f2bf(acc); }
    }
    __syncthreads();
    { const int ct = wave >> 2, vt = wave & 3;
        f32x16 acc;
#pragma unroll
        for (int r = 0; r < 16; ++r) acc[r] = 0.f;
        for (int es = 0; es < 2 * (ct + 1); ++es) acc = MFMA32(*(const LAS bf16x8*)(Tb + (32 * ct + r32) * 72 + 16 * es + 8 * hi), *(const LAS bf16x8*)(vbT + (32 * vt + r32) * 72 + 16 * es + 8 * hi), acc);
        bf16_t* dst = Uimg + (((size_t)item * 4 + vt) * 2 + ct) * 1024 + lane * 16;
#pragma unroll
        for (int s = 0; s < 2; ++s) *(u32x4*)(dst + 8 * s) = __builtin_bit_cast(u32x4, pack8(acc[8 * s], acc[8 * s + 1], acc[8 * s + 2], acc[8 * s + 3], acc[8 * s + 4], acc[8 * s + 5], acc[8 * s + 6], acc[8 * s + 7])); }
    { const int kt = wave >> 1, ct = wave & 1;
        f32x16 acc;
#pragma unroll
        for (int r = 0; r < 16; ++r) acc[r] = 0.f;
        for (int es = 0; es < 2 * (ct + 1); ++es) acc = MFMA32(*(const LAS bf16x8*)(kbgT + (32 * kt + r32) * 72 + 16 * es + 8 * hi), *(const LAS bf16x8*)(Tb + (32 * ct + r32) * 72 + 16 * es + 8 * hi), acc);
#pragma unroll
        for (int s = 0; s < 2; ++s) *(u32x4*)(Wimg + ((((size_t)item * 8 + ct * 4 + kt) * 2 + s) * 512 + lane * 8)) =
            __builtin_bit_cast(u32x4, pack8(-acc[8 * s], -acc[8 * s + 1], -acc[8 * s + 2], -acc[8 * s + 3], -acc[8 * s + 4], -acc[8 * s + 5], -acc[8 * s + 6], -acc[8 * s + 7])); }
    __syncthreads();
}

DI f32x16 ld_img16(const bf16_t* p) { const u32x4 a = *(const u32x4*)p, b = *(const u32x4*)(p + 8); f32x16 v;
    v[0] = bflo(a.x); v[1] = bfhi(a.x); v[2] = bflo(a.y); v[3] = bfhi(a.y); v[4] = bflo(a.z); v[5] = bfhi(a.z); v[6] = bflo(a.w); v[7] = bfhi(a.w);
    v[8] = bflo(b.x); v[9] = bfhi(b.x); v[10] = bflo(b.y); v[11] = bfhi(b.y); v[12] = bflo(b.z); v[13] = bfhi(b.z); v[14] = bflo(b.w); v[15] = bfhi(b.w); return v; }
#define PACKS(x, s) pack8((x)[8 * (s)], (x)[8 * (s) + 1], (x)[8 * (s) + 2], (x)[8 * (s) + 3], (x)[8 * (s) + 4], (x)[8 * (s) + 5], (x)[8 * (s) + 6], (x)[8 * (s) + 7])
#define LDF(p) (((const bf16x8*)(p))[lane])
#define DNB_FENCE asm volatile("" ::: "memory")
#define LD_WQ(F, kt) do { F[0] = LDF(Wp + ((0 * 4 + (kt)) * 2 + 0) * 512); F[1] = LDF(Wp + ((0 * 4 + (kt)) * 2 + 1) * 512); F[2] = LDF(Wp + ((1 * 4 + (kt)) * 2 + 0) * 512); F[3] = LDF(Wp + ((1 * 4 + (kt)) * 2 + 1) * 512); \
                          F[4] = LDF(Qp + ((0 * 4 + (kt)) * 2 + 0) * 512); F[5] = LDF(Qp + ((0 * 4 + (kt)) * 2 + 1) * 512); F[6] = LDF(Qp + ((1 * 4 + (kt)) * 2 + 0) * 512); F[7] = LDF(Qp + ((1 * 4 + (kt)) * 2 + 1) * 512); } while (0)
#define CMP_WQ(F, kt) do { const bf16x8 sb0 = PACKS(S[kt], 0), sb1 = PACKS(S[kt], 1); \
        vn[0] = MFMA32(F[0], sb0, vn[0]); vn[1] = MFMA32(F[2], sb0, vn[1]); o[0] = MFMA32(F[4], sb0, o[0]); o[1] = MFMA32(F[6], sb0, o[1]); \
        vn[0] = MFMA32(F[1], sb1, vn[0]); vn[1] = MFMA32(F[3], sb1, vn[1]); o[0] = MFMA32(F[5], sb1, o[0]); o[1] = MFMA32(F[7], sb1, o[1]); } while (0)
#define LD_KT(F, kt0) do { _Pragma("unroll") for (int q_ = 0; q_ < 8; ++q_) F[q_] = LDF(Kp + ((kt0) * 4 + q_) * 512); } while (0)
#define CMP_KT(F, kt0) do { _Pragma("unroll") for (int k_ = 0; k_ < 2; ++k_) { _Pragma("unroll") for (int r_ = 0; r_ < 16; ++r_) S[(kt0) + k_][r_] *= egl; \
        S[(kt0) + k_] = MFMA32(F[4 * k_ + 0], d00, S[(kt0) + k_]); S[(kt0) + k_] = MFMA32(F[4 * k_ + 1], d01, S[(kt0) + k_]); \
        S[(kt0) + k_] = MFMA32(F[4 * k_ + 2], d10, S[(kt0) + k_]); S[(kt0) + k_] = MFMA32(F[4 * k_ + 3], d11, S[(kt0) + k_]); } } while (0)
#define DNB_SETPTR(nn) do { const size_t item_ = ((size_t)b * 32 + (nn)) * 32 + hv, itemk_ = ((size_t)b * 32 + (nn)) * 16 + hk; \
        Wp = Wimg + item_ * 8192; Qp = Qimg + itemk_ * 8192; Kp = KTimg + itemk_ * 8192; Ap = Aimg + item_ * 4096; \
        Up = Uimg + (item_ * 4 + vs) * 2048; Ep = EG + item_ * 64; Dp = DK + item_ * 64; row0 = (size_t)b * SEQ + (nn) * 64; } while (0)
#define LD_U() do { u0 = ((const u32x4*)Up)[2 * lane]; u1 = ((const u32x4*)Up)[2 * lane + 1]; u2 = ((const u32x4*)Up)[128 + 2 * lane]; u3 = ((const u32x4*)Up)[128 + 2 * lane + 1]; } while (0)
#define DNB_CHUNK(F, nn) do { \
        { const unsigned uu0[8] = {u0.x, u0.y, u0.z, u0.w, u1.x, u1.y, u1.z, u1.w}, uu1[8] = {u2.x, u2.y, u2.z, u2.w, u3.x, u3.y, u3.z, u3.w}; \
          _Pragma("unroll") for (int q_ = 0; q_ < 8; ++q_) { vn[0][2 * q_] = bflo(uu0[q_]); vn[0][2 * q_ + 1] = bfhi(uu0[q_]); vn[1][2 * q_] = bflo(uu1[q_]); vn[1][2 * q_ + 1] = bfhi(uu1[q_]); } } \
        _Pragma("unroll") for (int ct = 0; ct < 2; ++ct) _Pragma("unroll") for (int r = 0; r < 16; ++r) o[ct][r] = 0.f; \
        CMP_WQ(F, 0); DNB_FENCE; LD_WQ(F, 1); DNB_FENCE; \
        CMP_WQ(F, 1); DNB_FENCE; LD_WQ(F, 2); DNB_FENCE; \
        CMP_WQ(F, 2); DNB_FENCE; LD_WQ(F, 3); DNB_FENCE; \
        CMP_WQ(F, 3); DNB_FENCE; \
        _Pragma("unroll") for (int q_ = 0; q_ < 2; ++q_) { F[q_] = LDF(Ap + ((0 * 2 + 0) * 2 + q_) * 512); F[2 + q_] = LDF(Ap + ((1 * 2 + 0) * 2 + q_) * 512); F[4 + q_] = LDF(Ap + ((1 * 2 + 1) * 2 + q_) * 512); } \
        float egl; \
        { f32x4 eg[2][4]; _Pragma("unroll") for (int ct = 0; ct < 2; ++ct) _Pragma("unroll") for (int q_ = 0; q_ < 4; ++q_) eg[ct][q_] = ((const f32x4*)Ep)[ct * 8 + hi * 4 + q_]; \
          DNB_FENCE; \
          _Pragma("unroll") for (int ct = 0; ct < 2; ++ct) _Pragma("unroll") for (int r = 0; r < 16; ++r) o[ct][r] *= eg[ct][r >> 2][r & 3]; \
          egl = __shfl(eg[1][3][3], 63); } \
        { const bf16x8 v00 = PACKS(vn[0], 0), v01 = PACKS(vn[0], 1), v10 = PACKS(vn[1], 0), v11 = PACKS(vn[1], 1); \
          o[0] = MFMA32(F[0], v00, o[0]); o[1] = MFMA32(F[2], v00, o[1]); o[0] = MFMA32(F[1], v01, o[0]); o[1] = MFMA32(F[3], v01, o[1]); o[1] = MFMA32(F[4], v10, o[1]); o[1] = MFMA32(F[5], v11, o[1]); } \
        DNB_FENCE; LD_KT(F, 0); \
        { f32x4 dk[2][4]; _Pragma("unroll") for (int ct = 0; ct < 2; ++ct) _Pragma("unroll") for (int q_ = 0; q_ < 4; ++q_) dk[ct][q_] = ((const f32x4*)Dp)[ct * 8 + hi * 4 + q_]; \
          DNB_FENCE; \
          { bf16_t* op_ = OG + (row0 + 4 * hi) * 4096 + hv * 128 + 32 * vs + r32; \
            _Pragma("unroll") for (int ct = 0; ct < 2; ++ct) _Pragma("unroll") for (int g_ = 0; g_ < 4; ++g_) { \
              _Pragma("unroll") for (int i_ = 0; i_ < 4; ++i_) { *op_ = f2bf(o[ct][4 * g_ + i_]); op_ += 4096; asm volatile("" : "+v"(op_)); } \
              op_ += 4 * 4096; asm volatile("" : "+v"(op_)); } } \
          _Pragma("unroll") for (int ct = 0; ct < 2; ++ct) _Pragma("unroll") for (int r = 0; r < 16; ++r) vn[ct][r] *= dk[ct][r >> 2][r & 3]; } \
        { const bf16x8 d00 = PACKS(vn[0], 0), d01 = PACKS(vn[0], 1), d10 = PACKS(vn[1], 0), d11 = PACKS(vn[1], 1); \
          CMP_KT(F, 0); DNB_FENCE; LD_KT(F, 2); DNB_FENCE; CMP_KT(F, 2); DNB_FENCE; } \
        if ((nn) + 1 < 32) { DNB_SETPTR((nn) + 1); LD_WQ(F, 0); LD_U(); } DNB_FENCE; \
    } while (0)
DI void dnb_wave(const bf16_t* Wimg, const bf16_t* Uimg, const bf16_t* Aimg, const bf16_t* Qimg, const bf16_t* KTimg, const float* EG, const float* DK, bf16_t* OG, int bhv, int vs, int lane) {
    const int b = bhv >> 5, hv = bhv & 31, hk = hv >> 1, r32 = lane & 31, hi = lane >> 5;
    f32x16 S[4], vn[2], o[2];
#pragma unroll
    for (int kt = 0; kt < 4; ++kt)
#pragma unroll
        for (int r = 0; r < 16; ++r) S[kt][r] = 0.f;
    const bf16_t *Wp, *Qp, *Kp, *Ap, *Up; const float *Ep, *Dp; size_t row0;
    bf16x8 F[8]; u32x4 u0, u1, u2, u3;
    DNB_SETPTR(0); LD_WQ(F, 0); LD_U();
    for (int n = 0; n < 32; ++n) { DNB_CHUNK(F, n); }
}

DI void dnc_phase(bf16_t* OG, const bf16_t* Z, const float* norm_g, int wave, int lane) {
    const int gw = blockIdx.x * NWAVES + wave, ngw = gridDim.x * NWAVES;
    const int sub = lane >> 4, c8 = (lane & 15) * 8;
    float g[8];
    { const f32x4 a = *(const f32x4*)(norm_g + c8), c = *(const f32x4*)(norm_g + c8 + 4); g[0] = a.x; g[1] = a.y; g[2] = a.z; g[3] = a.w; g[4] = c.x; g[5] = c.y; g[6] = c.z; g[7] = c.w; }
    for (int it = gw; it < M * 32 / 16; it += ngw) {
        u32x4 ro[4], rz[4];
#pragma unroll
        for (int k = 0; k < 4; ++k) { const size_t off = ((size_t)it * 16 + k * 4 + sub) * 128 + c8; ro[k] = *(const u32x4*)(OG + off); rz[k] = *(const u32x4*)(Z + off); }
#pragma unroll
        for (int k = 0; k < 4; ++k) { const size_t off = ((size_t)it * 16 + k * 4 + sub) * 128 + c8;
            float o[8], z[8]; unpack8(ro[k], o); unpack8(rz[k], z);
            float ss = 0.f;
#pragma unroll
            for (int i = 0; i < 8; ++i) ss += o[i] * o[i];
            const float sc = rsqrtf(sum16(ss) * (1.f / 128.f) + RMS_EPS);
#pragma unroll
            for (int i = 0; i < 8; ++i) o[i] = o[i] * sc * g[i] * pg8::silu_f(z[i]);
            u32x4 w; w.x = pk2(o[0], o[1]); w.y = pk2(o[2], o[3]); w.z = pk2(o[4], o[5]); w.w = pk2(o[6], o[7]);
            *(u32x4*)(OG + off) = w; }
    }
}

#define XB_TMO      128
#define XB_XCNT(j)  (256  + 64 * (j))
#define XB_XSUB(j)  (1280 + 64 * (j))
#define XB_XGEN(j)  (2304 + 64 * (j))
#define XB_TOP      3328
#define XB_TOPGEN   3392
#define XCD_BAR_WORDS 3456
#define XB_SPIN_CAP (1u << 18)

__device__ __forceinline__ unsigned xb_ld(unsigned* p)              { return __hip_atomic_load(p, __ATOMIC_RELAXED, __HIP_MEMORY_SCOPE_AGENT); }
__device__ __forceinline__ unsigned xb_add(unsigned* p, unsigned v) { return __hip_atomic_fetch_add(p, v, __ATOMIC_RELAXED, __HIP_MEMORY_SCOPE_AGENT); }
__device__ __forceinline__ unsigned xb_xcc_id() { return (unsigned)__builtin_amdgcn_s_getreg((3 << 11) | 20) & 0xFu; }
#define XB_SPIN(cond, bar) do { unsigned _sp = 0; while (cond) { __builtin_amdgcn_s_sleep(1); \
    if ((++_sp & 255u) == 0u) { if (xb_ld(&(bar)[XB_TMO])) break; if (_sp > XB_SPIN_CAP) { atomicAdd(&(bar)[XB_TMO], 1u); break; } } } } while (0)

struct XcdBarrier {
    unsigned* bar; unsigned x;
    volatile LAS unsigned* st;
};

__device__ __forceinline__ XcdBarrier xcd_barrier_post(unsigned* bar, volatile LAS unsigned* st) {
    XcdBarrier b; b.bar = bar; b.x = xb_xcc_id(); b.st = st;
    if (threadIdx.x == 0) (void)xb_add(&bar[XB_XCNT(b.x)], 1u);
    return b;
}
__device__ __forceinline__ void xcd_barrier_complete(unsigned* bar, unsigned x, unsigned& nloc, unsigned& nx) {
    const unsigned G = gridDim.x * gridDim.y * gridDim.z;
    unsigned sum, cnt, mine, sp = 0u;
    for (;;) {
        sum = 0u; cnt = 0u; mine = 0u;
#pragma unroll
        for (unsigned j = 0; j < 16; ++j) { const unsigned c = xb_ld(&bar[XB_XCNT(j)]); sum += c; cnt += (c > 0u) ? 1u : 0u; mine = (j == x) ? c : mine; }
        if (sum == G) break;
        __builtin_amdgcn_s_sleep(1);
        if ((++sp & 255u) == 0u) { if (xb_ld(&bar[XB_TMO])) break; if (sp > XB_SPIN_CAP) { atomicAdd(&bar[XB_TMO], 1u); break; } }
    }
    nloc = mine > 0u ? mine : 1u; nx = cnt > 0u ? cnt : 1u;
}

__device__ __forceinline__ void xcd_barrier(const XcdBarrier& b) {
    asm volatile("s_waitcnt vmcnt(0)" ::: "memory");
    __syncthreads();
    if (threadIdx.x == 0) {
        unsigned* bar = b.bar;
        __builtin_amdgcn_s_waitcnt(0);
        unsigned nloc = b.st[0], nx = b.st[1];
        if (nloc == 0u) { xcd_barrier_complete(bar, b.x, nloc, nx); b.st[0] = nloc; b.st[1] = nx; }
        const unsigned old = xb_add(&bar[XB_XSUB(b.x)], 1u);
        const unsigned gen = old / nloc;
        if (old + 1u == (gen + 1u) * nloc) {
            __builtin_amdgcn_fence(__ATOMIC_RELEASE, "agent");
            asm volatile("s_waitcnt vmcnt(0)" ::: "memory");
            const unsigned og = xb_add(&bar[XB_TOP], 1u);
            const unsigned tg = og / nx;
            if (og + 1u == (tg + 1u) * nx) xb_add(&bar[XB_TOPGEN], 1u);
            else XB_SPIN(xb_ld(&bar[XB_TOPGEN]) == tg, bar);
            __builtin_amdgcn_fence(__ATOMIC_ACQUIRE, "agent");
            xb_add(&bar[XB_XGEN(b.x)], 1u);
            asm volatile("s_waitcnt vmcnt(0)" ::: "memory");
        } else {
            XB_SPIN(xb_ld(&bar[XB_XGEN(b.x)]) == gen, bar);
            __builtin_amdgcn_fence(__ATOMIC_ACQUIRE, "agent");
            asm volatile("s_waitcnt vmcnt(0)" ::: "memory");
        }
    }
    __syncthreads();
}

constexpr int N_PHASES = 25;
DI void gemm_swiglu(LAS unsigned char* lds, const bf16_t* A, const bf16_t* Wt, bf16_t* H) {
    pg8::Gemm g{A, Wt, M, 2 * DFF, D}; pg8::StaticOrder S; S.init(M, 2 * DFF, (int)gridDim.x, (int)blockIdx.x);
    pg8::EpiSwiGLU E{H, DFF};
    pg8::gemm_phase<pg8::EpiSwiGLU, pg8::StaticOrder, true, true>(lds, g, S, E);
}
DI void gemm_resid(LAS unsigned char* lds, const bf16_t* A, const bf16_t* Wt, int K, const float* resid, float* out, float scale) {
    pg8::Gemm g{A, Wt, M, D, K}; pg8::StaticOrder S; S.init(M, D, (int)gridDim.x, (int)blockIdx.x);
    pg8::EpiResid E{resid, out, D, ALPHA, scale};
    pg8::gemm_phase<pg8::EpiResid, pg8::StaticOrder, true, true>(lds, g, S, E);
}
__global__ void __launch_bounds__(NTHREADS, 2) fwd_kernel(Args args) {
    extern __shared__ __attribute__((aligned(16))) unsigned char lds_raw[];
    LAS unsigned char* lds = (LAS unsigned char*)lds_raw;
    cg::grid_group grid = cg::this_grid();
    const int tid = threadIdx.x, lane = tid & 63, wave = __builtin_amdgcn_readfirstlane(tid >> 6);
    const Args* const ap = &args;
    const int lo = args.ph_lo, hi = args.ph_hi;
    { volatile LAS unsigned* st = (volatile LAS unsigned*)(lds + LDS_BYTES - 64); if (tid < 16) st[tid] = 0u; }
    __syncthreads();
    const XcdBarrier xbar = xcd_barrier_post((unsigned*)(args.ws + WS_BAR), (volatile LAS unsigned*)(lds + LDS_BYTES - 64));
#define PHASE(k) if (lo <= (k) && (k) < hi && ((k) == lo || (((k) == lo + 1) ? (grid.sync(), true) : (xcd_barrier(xbar), true))))
#define ARGS_RELOAD() unsigned char* const ws = ap->ws
#define WSP(T, off) ((T*)(ws + (off)))
    PHASE(0) { ARGS_RELOAD(); p0_prologue(*ap, lds, wave, lane); }
    PHASE(1) { ARGS_RELOAD(); gemm_swiglu(lds, WSP(bf16_t, WS_XB), WSP(bf16_t, WS_WGU1_0), WSP(bf16_t, WS_BIG)); }
    PHASE(2) { ARGS_RELOAD(); gemm_resid(lds, WSP(bf16_t, WS_BIG), WSP(bf16_t, WS_WD1_0), DFF, ap->in[0], ap->out, 0.5f); }
    PHASE(3) { ARGS_RELOAD(); ln_phase(ap->out, WSP(bf16_t, WS_XB), ap->in[7] + 0 * D, ap->in[8] + 0 * D, wave, lane); }
    PHASE(4) { ARGS_RELOAD(); pg8::Gemm g{WSP(bf16_t, WS_XB), WSP(bf16_t, WS_WABIN), M, AB_IN, D}; pg8::StaticOrder S; S.init(M, AB_IN, (int)gridDim.x, (int)blockIdx.x);
        pg8::EpiPlain E{WSP(bf16_t, WS_BIG), AB_IN};
        pg8::gemm_phase<pg8::EpiPlain, pg8::StaticOrder, true, true>(lds, g, S, E); }
    PHASE(5) { ARGS_RELOAD();
        for (int it = blockIdx.x; it < 256; it += gridDim.x)
            rope_item(WSP(bf16_t, WS_BIG), WSP(bf16_t, WS_QR), WSP(bf16_t, WS_KR), WSP(bf16_t, WS_VT), WSP(float, WS_KMEAN), it, (LAS float*)lds, tid);
        for (int it = blockIdx.x; it < 512; it += gridDim.x)
            gmlp_item(WSP(bf16_t, WS_BIG), ap->in[10], ap->in[11], ap->in[12], ap->in[13], WSP(bf16_t, WS_CAT), it, lds, wave, lane);
    }
    PHASE(6) { ARGS_RELOAD();
        for (int wg = blockIdx.x; wg < 256; wg += gridDim.x) { const int bh = wg >> 3, sub = wg & 7;
            moba_wave(WSP(bf16_t, WS_QR), WSP(bf16_t, WS_KR), WSP(bf16_t, WS_VT), WSP(float, WS_KMEAN), WSP(bf16_t, WS_CAT), bh, wave * 8 + sub, lane); }
    }
    PHASE(7) { ARGS_RELOAD(); gemm_resid(lds, WSP(bf16_t, WS_CAT), WSP(bf16_t, WS_WABOUT), D, ap->out, ap->out, 1.0f); }
    PHASE(8) { ARGS_RELOAD(); ln_phase(ap->out, WSP(bf16_t, WS_XB), ap->in[7] + 1 * D, ap->in[8] + 1 * D, wave, lane); }
    PHASE(9) { ARGS_RELOAD(); gemm_swiglu(lds, WSP(bf16_t, WS_XB), WSP(bf16_t, WS_WGU2_0), WSP(bf16_t, WS_BIG)); }
    PHASE(10) { ARGS_RELOAD(); gemm_resid(lds, WSP(bf16_t, WS_BIG), WSP(bf16_t, WS_WD2_0), DFF, ap->out, ap->out, 0.5f); }
    PHASE(11) { ARGS_RELOAD(); ln_phase(ap->out, WSP(bf16_t, WS_XB), ap->in[7] + 2 * D, ap->in[8] + 2 * D, wave, lane); }
    PHASE(12) { ARGS_RELOAD(); gemm_swiglu(lds, WSP(bf16_t, WS_XB), WSP(bf16_t, WS_WGU1_1), WSP(bf16_t, WS_BIG)); }
    PHASE(13) { ARGS_RELOAD(); gemm_resid(lds, WSP(bf16_t, WS_BIG), WSP(bf16_t, WS_WD1_1), DFF, ap->out, ap->out, 0.5f); }
    PHASE(14) { ARGS_RELOAD(); ln_phase(ap->out, WSP(bf16_t, WS_XB), ap->in[7] + 3 * D, ap->in[8] + 3 * D, wave, lane); }
    PHASE(15) { ARGS_RELOAD(); pg8::Gemm g{WSP(bf16_t, WS_XB), WSP(bf16_t, WS_WDNIN), M, DN_IN_PAD, D}; pg8::StaticOrder S; S.init(M, DN_IN_PAD, (int)gridDim.x, (int)blockIdx.x);
        pg8::EpiDnIn E{WSP(bf16_t, WS_BIG), WSP(float, WS_BA)};
        pg8::gemm_phase<pg8::EpiDnIn, pg8::StaticOrder, true, true>(lds, g, S, E); }
    PHASE(16) { ARGS_RELOAD(); dnp_phase(WSP(bf16_t, WS_BIG), WSP(bf16_t, WS_BIG) + (size_t)M * 4096, WSP(float, WS_BA), ap->in[16], ap->in[17], ap->in[18],
                          WSP(bf16_t, WS_QN), WSP(bf16_t, WS_KN), WSP(bf16_t, WS_V), WSP(float, WS_G), WSP(float, WS_BETA), wave, lane); }
    PHASE(17) { ARGS_RELOAD();
        for (int it = blockIdx.x; it < 4096; it += gridDim.x)
            dna_item(WSP(bf16_t, WS_QN), WSP(bf16_t, WS_KN), WSP(bf16_t, WS_V), WSP(float, WS_G), WSP(float, WS_BETA),
                     WSP(bf16_t, WS_WIMG), WSP(bf16_t, WS_UIMG), WSP(bf16_t, WS_AIMG), WSP(bf16_t, WS_QIMG), WSP(bf16_t, WS_KTIMG), WSP(float, WS_GC), WSP(float, WS_GC + MiB), it, lds, tid);
    }
    PHASE(18) { ARGS_RELOAD();
        if (wave < 4) for (int it = blockIdx.x; it < 128; it += gridDim.x)
            dnb_wave(WSP(bf16_t, WS_WIMG), WSP(bf16_t, WS_UIMG), WSP(bf16_t, WS_AIMG), WSP(bf16_t, WS_QIMG), WSP(bf16_t, WS_KTIMG), WSP(float, WS_GC), WSP(float, WS_GC + MiB), WSP(bf16_t, WS_OG), it, wave, lane);
    }
    PHASE(19) { ARGS_RELOAD(); dnc_phase(WSP(bf16_t, WS_OG), WSP(bf16_t, WS_BIG) + (size_t)2 * M * 4096, ap->in[19], wave, lane); }
    PHASE(20) { ARGS_RELOAD(); gemm_resid(lds, WSP(bf16_t, WS_OG), WSP(bf16_t, WS_WDNOUT), 4096, ap->out, ap->out, 1.0f); }
    PHASE(21) { ARGS_RELOAD(); ln_phase(ap->out, WSP(bf16_t, WS_XB), ap->in[7] + 4 * D, ap->in[8] + 4 * D, wave, lane); }
    PHASE(22) { ARGS_RELOAD(); gemm_swiglu(lds, WSP(bf16_t, WS_XB), WSP(bf16_t, WS_WGU2_1), WSP(bf16_t, WS_BIG)); }
    PHASE(23) { ARGS_RELOAD(); gemm_resid(lds, WSP(bf16_t, WS_BIG), WSP(bf16_t, WS_WD2_1), DFF, ap->out, ap->out, 0.5f); }
    PHASE(24) { ARGS_RELOAD(); ln_phase(ap->out, WSP(bf16_t, WS_XB), ap->in[7] + 5 * D, ap->in[8] + 5 * D, wave, lane); }
}

extern "C" void kernel_launch(void* const* d_in, const int* in_sizes, int n_in, void* d_out, int out_size, void* d_ws, size_t ws_size, hipStream_t stream) {
    static int grid = 0;
    if (grid == 0) {
        if (n_in != 21 || out_size != M * D || ws_size < WS_END) { fprintf(stderr, "kernel_launch: unexpected shapes (n_in %d out %d ws %zu)\n", n_in, out_size, ws_size); grid = -1; return; }
        int dev = 0, cus = 0, per_cu = 0;
        (void)hipGetDevice(&dev); (void)hipDeviceGetAttribute(&cus, hipDeviceAttributeMultiprocessorCount, dev);
        (void)hipFuncSetAttribute((const void*)fwd_kernel, hipFuncAttributeMaxDynamicSharedMemorySize, LDS_BYTES);
        (void)hipOccupancyMaxActiveBlocksPerMultiprocessor(&per_cu, (const void*)fwd_kernel, NTHREADS, LDS_BYTES);
        if (per_cu < 1) { fprintf(stderr, "kernel_launch: occupancy query says %d blocks/CU\n", per_cu); per_cu = 1; }
        (void)hipGetLastError();
        grid = cus;
    }
    if (grid < 0) return;
    Args a{};
    for (int i = 0; i < 21; ++i) a.in[i] = (const float*)d_in[i];
    a.out = (float*)d_out; a.ws = (unsigned char*)d_ws; a.ph_lo = 0; a.ph_hi = N_PHASES;
    (void)hipMemsetAsync((char*)d_ws + WS_BAR, 0, BAR_BYTES, stream);
    void* kargs[] = {&a};
    hipError_t e = hipLaunchCooperativeKernel((const void*)fwd_kernel, dim3(grid), dim3(NTHREADS), kargs, LDS_BYTES, stream);
    if (e != hipSuccess) fprintf(stderr, "kernel_launch: cooperative launch failed: %s (grid %d)\n", hipGetErrorString(e), grid);
}
```

```cpp
#include <hip/hip_runtime.h>
#include <hip/hip_cooperative_groups.h>
#include <cstdio>
#include <cstdint>
namespace cg = cooperative_groups;
namespace pg8 {
#define PG8_LAS __attribute__((address_space(3)))
typedef unsigned short bf16_t;
typedef short bf16x8 __attribute__((ext_vector_type(8)));
typedef float f32x4 __attribute__((ext_vector_type(4)));
typedef unsigned u32x4 __attribute__((ext_vector_type(4)));
constexpr int BM = 256, BK = 64, HALF = 128, HTB = HALF * BK * 2  , STAGE_BYTES = 8 * HTB, NXCD = 8, WGM = 8;

__host__ __device__ __forceinline__ int lds_byte(int r, int c) { const int st = (r >> 4) * 2 + (c >> 5), rr = r & 15, cc = c & 31, ob = rr * 64 + cc * 2; return st * 1024 + (ob ^ (((ob >> 9) & 1) << 5)); }
__host__ __device__ __forceinline__ void stage_rc(int b, int& R, int& C) { const int st = b / 1024, sb = b % 1024, swz = sb ^ (((sb >> 9) & 1) << 5); R = (st >> 1) * 16 + swz / 64; C = (st & 1) * 32 + (swz % 64) / 2; }
__host__ __device__ __forceinline__ int perm32(int rho) { const int n = rho >> 4, i = rho & 15; return 8 * (i >> 2) + 4 * n + (i & 3); }

struct Unit { int pm, pn; };
struct Gemm { const bf16_t* A; const bf16_t* Bt; int M, N, K; };

struct StaticOrder {
    int nM, nN, nwg, G, c;
    __host__ __device__ void init(int M, int N, int G_, int c_) { nM = M / BM; nN = N / BM; nwg = nM * nN; G = G_; c = c_; }
    __host__ __device__ bool next(int i, Unit& u) const {
        const long L = (long)i * G + c; if (L >= nwg) return false;
        int wgid = (int)L; { const int q = nwg / NXCD, r = nwg % NXCD, xcd = wgid % NXCD, off = wgid / NXCD; wgid = (xcd < r ? xcd * (q + 1) : r * (q + 1) + (xcd - r) * q) + off; }
        const int nig = WGM * nN, gid = wgid / nig, fm = gid * WGM, gsz = (nM - fm) < WGM ? (nM - fm) : WGM;
        u.pm = fm + ((wgid % nig) % gsz); u.pn = (wgid % nig) / gsz; return true;
    }
    __device__ __forceinline__ void a_ready(const Unit&) const {}
    __device__ __forceinline__ void done(const Unit&) const {}
};

__device__ __forceinline__ unsigned cvt_pk_bf16(float lo, float hi) { unsigned r; asm volatile("v_cvt_pk_bf16_f32 %0, %1, %2" : "=v"(r) : "v"(lo), "v"(hi)); return r; }
typedef float f32x2 __attribute__((ext_vector_type(2)));
typedef __bf16 bf16x2_t __attribute__((ext_vector_type(2)));
__device__ __forceinline__ unsigned pk2(float lo, float hi) { f32x2 v = {lo, hi}; bf16x2_t b = __builtin_convertvector(v, bf16x2_t); return __builtin_bit_cast(unsigned, b); }
__device__ __forceinline__ float silu_f(float g) { return g * __builtin_amdgcn_rcpf(1.0f + __expf(-g)); }

struct EpiPlain {
    static constexpr bool PERM = true, AFTER_DRAIN = false;
    bf16_t* O; int ldc;
    __device__ __forceinline__ void operator()(const f32x4 (&acc)[2][2][4][2], const Unit& u, int wr, int wc, int fr, int fq) const {
        const int row0 = u.pm * BM + wr * 64 + fr, col0 = u.pn * BM + wc * 32 + 8 * fq;
#pragma unroll
        for (int ai = 0; ai < 2; ++ai)
#pragma unroll
            for (int m = 0; m < 4; ++m) { bf16_t* rowp = O + (size_t)(row0 + ai * HALF + m * 16) * ldc + col0;
#pragma unroll
                for (int bj = 0; bj < 2; ++bj) { const f32x4 v0 = acc[ai][bj][m][0], v1 = acc[ai][bj][m][1];
                    u32x4 w; w.x = pk2(v0[0], v0[1]); w.y = pk2(v0[2], v0[3]); w.z = pk2(v1[0], v1[1]); w.w = pk2(v1[2], v1[3]);
                    *(u32x4*)(rowp + bj * HALF) = w; } }
    }
};
struct EpiDnIn {
    static constexpr bool PERM = true, AFTER_DRAIN = false;
    bf16_t* O; float* BA;
    __device__ __forceinline__ void operator()(const f32x4 (&acc)[2][2][4][2], const Unit& u, int wr, int wc, int fr, int fq) const {
        const int row0 = u.pm * BM + wr * 64 + fr;
        if (u.pn < 48) {
            bf16_t* base = O + (size_t)(u.pn >> 4) * ((size_t)8192 * 4096);
            const int col0 = (u.pn & 15) * BM + wc * 32 + 8 * fq;
#pragma unroll
            for (int ai = 0; ai < 2; ++ai)
#pragma unroll
                for (int m = 0; m < 4; ++m) { bf16_t* rowp = base + (size_t)(row0 + ai * HALF + m * 16) * 4096 + col0;
#pragma unroll
                    for (int bj = 0; bj < 2; ++bj) { const f32x4 v0 = acc[ai][bj][m][0], v1 = acc[ai][bj][m][1];
                        u32x4 w; w.x = pk2(v0[0], v0[1]); w.y = pk2(v0[2], v0[3]); w.z = pk2(v1[0], v1[1]); w.w = pk2(v1[2], v1[3]);
                        *(u32x4*)(rowp + bj * HALF) = w; } }
        } else if (wc < 2) {
            const int col0 = wc * 32 + 8 * fq;
#pragma unroll
            for (int ai = 0; ai < 2; ++ai)
#pragma unroll
                for (int m = 0; m < 4; ++m) { float* rowp = BA + (size_t)(row0 + ai * HALF + m * 16) * 64 + col0;
                    *(f32x4*)(rowp) = acc[ai][0][m][0]; *(f32x4*)(rowp + 4) = acc[ai][0][m][1]; }
        }
    }
};
struct EpiSwiGLU {
    static constexpr bool PERM = true, AFTER_DRAIN = false;
    bf16_t* O; int ldc;
    __device__ __forceinline__ void operator()(const f32x4 (&acc)[2][2][4][2], const Unit& u, int wr, int wc, int fr, int fq) const {
        const int row0 = u.pm * BM + wr * 64 + fr, col0 = u.pn * HALF + wc * 32 + 8 * fq;
#pragma unroll
        for (int ai = 0; ai < 2; ++ai)
#pragma unroll
            for (int m = 0; m < 4; ++m) { bf16_t* rowp = O + (size_t)(row0 + ai * HALF + m * 16) * ldc + col0;
                const f32x4 g0 = acc[ai][0][m][0], g1 = acc[ai][0][m][1], u0 = acc[ai][1][m][0], u1 = acc[ai][1][m][1];
                u32x4 w;
                w.x = pk2(silu_f(g0[0]) * u0[0], silu_f(g0[1]) * u0[1]); w.y = pk2(silu_f(g0[2]) * u0[2], silu_f(g0[3]) * u0[3]);
                w.z = pk2(silu_f(g1[0]) * u1[0], silu_f(g1[1]) * u1[1]); w.w = pk2(silu_f(g1[2]) * u1[2], silu_f(g1[3]) * u1[3]);
                *(u32x4*)(rowp) = w; }
    }
};
struct EpiResid {
    static constexpr bool PERM = false, AFTER_DRAIN = false;
    const float* resid; float* out; int ldc; float alpha, scale;
    __device__ __forceinline__ void operator()(const f32x4 (&acc)[2][2][4][2], const Unit& u, int wr, int wc, int fr, int fq) const {
        const int col0 = u.pn * BM + wc * 32 + 4 * fq;
#pragma unroll
        for (int ai = 0; ai < 2; ++ai)
#pragma unroll
            for (int m = 0; m < 4; ++m) { const size_t off = (size_t)(u.pm * BM + ai * HALF + wr * 64 + m * 16 + fr) * ldc + col0;
                f32x4 rv[2][2];
#pragma unroll
                for (int bj = 0; bj < 2; ++bj)
#pragma unroll
                    for (int n = 0; n < 2; ++n) rv[bj][n] = *(const f32x4*)(resid + off + bj * HALF + n * 16);
#pragma unroll
                for (int bj = 0; bj < 2; ++bj)
#pragma unroll
                    for (int n = 0; n < 2; ++n) *(f32x4*)(out + off + bj * HALF + n * 16) = rv[bj][n] * alpha + acc[ai][bj][m][n] * scale;
                asm volatile("" ::: "memory"); }
    }
};
template <class Epi, class Sched, bool ALIGN_EPI = false, bool SP2 = false>
__device__ __forceinline__ void gemm_phase(PG8_LAS unsigned char* lds, const Gemm g, const Sched& S, const Epi& E) {
    const int tid = threadIdx.x, wid = __builtin_amdgcn_readfirstlane(tid >> 6), lane = tid & 63, wr = wid >> 2, wc = wid & 3, fr = lane & 15, fq = lane >> 4;
    const int K = g.K, nt = K / BK;
    unsigned voffA[2], voffB[2];
#pragma unroll
    for (int i = 0; i < 2; ++i) { int R, C; stage_rc(tid * 16 + i * 8192, R, C); const int Rb = Epi::PERM ? ((R & ~31) + perm32(R & 31)) : R;
        voffA[i] = (unsigned)(R * K + C) * 2u; voffB[i] = (unsigned)(Rb * K + C) * 2u; }
    const size_t kstep = (size_t)(BK * 2);
    const size_t hstep = (size_t)HALF * K * 2;
    const size_t tstep = 2 * hstep;
    const unsigned ldsw = (unsigned)wid * 1024u;
    const int aoff = lds_byte(wr * 64 + fr, fq * 8), boff = lds_byte(wc * 32 + fr, fq * 8);
#define PG8_SA(b, h) (((b) * 2 + (h)) * HTB)
#define PG8_SB(b, h) ((4 + (b) * 2 + (h)) * HTB)
#define PG8_STAGE(bufoff, gbase, voff) do { _Pragma("unroll") for (int _i = 0; _i < 2; ++_i) \
        __builtin_amdgcn_global_load_lds((const unsigned*)((const char*)(gbase) + (voff)[_i]), (PG8_LAS unsigned*)(lds + (bufoff) + ldsw + _i * 8192), 16, 0, 0); } while (0)
#define PG8_LDA(dst, b, h) do { _Pragma("unroll") for (int m = 0; m < 4; ++m) _Pragma("unroll") for (int k = 0; k < 2; ++k) dst[m][k] = *(const PG8_LAS bf16x8*)(lds + PG8_SA(b, h) + aoff + m * 2048 + k * 1024); } while (0)
#define PG8_LDB(dst, b, h) do { _Pragma("unroll") for (int n = 0; n < 2; ++n) _Pragma("unroll") for (int k = 0; k < 2; ++k) dst[n][k] = *(const PG8_LAS bf16x8*)(lds + PG8_SB(b, h) + boff + n * 2048 + k * 1024); } while (0)
#define PG8_MMA(ai, bj, At, Bt) do { __builtin_amdgcn_s_setprio(1); _Pragma("unroll") for (int m = 0; m < 4; ++m) _Pragma("unroll") for (int n = 0; n < 2; ++n) _Pragma("unroll") for (int k = 0; k < 2; ++k) \
        acc[ai][bj][m][n] = __builtin_amdgcn_mfma_f32_16x16x32_bf16(Bt[n][k], At[m][k], acc[ai][bj][m][n], 0, 0, 0); __builtin_amdgcn_s_setprio(0); } while (0)
#define PG8_WAIT_V(n) asm volatile("s_waitcnt vmcnt(" #n ")" ::: "memory")
#define PG8_WAIT_L(n) asm volatile("s_waitcnt lgkmcnt(" #n ")" ::: "memory")
#define PG8_BAR __builtin_amdgcn_s_barrier()
#define PG8_SCHED __builtin_amdgcn_sched_barrier(0)
    Unit cur, nxt; int ui = 0;
    if (!S.next(0, cur)) return;
    f32x4 acc[2][2][4][2];
#pragma unroll
    for (int a = 0; a < 2; ++a)
#pragma unroll
        for (int b = 0; b < 2; ++b)
#pragma unroll
            for (int m = 0; m < 4; ++m)
#pragma unroll
                for (int n = 0; n < 2; ++n) acc[a][b][m][n] = (f32x4){0.f, 0.f, 0.f, 0.f};
    bf16x8 At[4][2], B0[2][2], B1[2][2];
    const char* cA = (const char*)g.A + (size_t)cur.pm * tstep; const char* cB = (const char*)g.Bt + (size_t)cur.pn * tstep;
    S.a_ready(cur);
    if constexpr (SP2) {
        PG8_STAGE(PG8_SB(0, 0), cB, voffB); PG8_STAGE(PG8_SB(0, 1), cB + hstep, voffB); PG8_STAGE(PG8_SA(0, 0), cA, voffA); PG8_STAGE(PG8_SA(0, 1), cA + hstep, voffA);
        if (wr == 1) PG8_BAR;
        PG8_WAIT_V(2); PG8_BAR;
        PG8_STAGE(PG8_SB(1, 0), cB + kstep, voffB); PG8_STAGE(PG8_SA(1, 0), cA + kstep, voffA); PG8_STAGE(PG8_SB(1, 1), cB + hstep + kstep, voffB);
        PG8_WAIT_V(6); PG8_BAR;
    } else {
        PG8_STAGE(PG8_SB(0, 0), cB, voffB); PG8_STAGE(PG8_SA(0, 0), cA, voffA); PG8_STAGE(PG8_SB(0, 1), cB + hstep, voffB); PG8_STAGE(PG8_SA(0, 1), cA + hstep, voffA);
        if (wr == 1) PG8_BAR;
        PG8_WAIT_V(4); PG8_BAR;
        PG8_STAGE(PG8_SB(1, 0), cB + kstep, voffB); PG8_STAGE(PG8_SA(1, 0), cA + kstep, voffA); PG8_STAGE(PG8_SB(1, 1), cB + hstep + kstep, voffB);
        PG8_WAIT_V(6); PG8_BAR;
    }
    for (;;) {
        const bool has_next = S.next(ui + 1, nxt);
        const char* nA = has_next ? (const char*)g.A + (size_t)nxt.pm * tstep : cA; const char* nB = has_next ? (const char*)g.Bt + (size_t)nxt.pn * tstep : cB;
        for (int t = 0; t < nt; t += 2) {
            const bool last = (t == nt - 2);
            const char* a1 = cA + (size_t)(t + 1) * kstep;
            const char* a2 = last ? nA : cA + (size_t)(t + 2) * kstep; const char* b2 = last ? nB : cB + (size_t)(t + 2) * kstep;
            const char* a3 = a2 + kstep; const char* b3 = b2 + kstep;
            if (last && has_next) S.a_ready(nxt);
            if constexpr (SP2) {
            PG8_LDB(B0, 0, 0); PG8_LDB(B1, 0, 1); PG8_SCHED; PG8_LDA(At, 0, 0); PG8_STAGE(PG8_SA(1, 1), a1 + hstep, voffA);
            PG8_WAIT_V(8); PG8_WAIT_L(0); PG8_BAR; PG8_MMA(0, 0, At, B0); PG8_MMA(0, 1, At, B1); PG8_BAR; PG8_SCHED;
            PG8_LDA(At, 0, 1); PG8_STAGE(PG8_SB(0, 0), b2, voffB); PG8_STAGE(PG8_SB(0, 1), b2 + hstep, voffB); PG8_STAGE(PG8_SA(0, 0), a2, voffA);
            PG8_WAIT_V(8); PG8_WAIT_L(0); PG8_BAR; PG8_MMA(1, 0, At, B0); PG8_MMA(1, 1, At, B1); PG8_BAR; PG8_SCHED;
            PG8_LDB(B0, 1, 0); PG8_LDB(B1, 1, 1); PG8_SCHED; PG8_LDA(At, 1, 0); PG8_STAGE(PG8_SA(0, 1), a2 + hstep, voffA);
            PG8_WAIT_V(8); PG8_WAIT_L(0); PG8_BAR; PG8_MMA(0, 0, At, B0); PG8_MMA(0, 1, At, B1); PG8_BAR; PG8_SCHED;
            PG8_LDA(At, 1, 1); PG8_STAGE(PG8_SB(1, 0), b3, voffB); PG8_STAGE(PG8_SB(1, 1), b3 + hstep, voffB); PG8_STAGE(PG8_SA(1, 0), a3, voffA);
            PG8_WAIT_V(8); PG8_WAIT_L(0); PG8_BAR; PG8_MMA(1, 0, At, B0); PG8_MMA(1, 1, At, B1); PG8_BAR; PG8_SCHED;
            } else {
            PG8_LDB(B0, 0, 0); PG8_SCHED; PG8_LDA(At, 0, 0); PG8_STAGE(PG8_SA(1, 1), a1 + hstep, voffA);
            PG8_WAIT_L(8); PG8_BAR; PG8_WAIT_L(0); PG8_MMA(0, 0, At, B0); PG8_BAR; PG8_SCHED;
            PG8_LDB(B1, 0, 1); PG8_STAGE(PG8_SB(0, 0), b2, voffB);
            PG8_BAR; PG8_WAIT_L(0); PG8_MMA(0, 1, At, B1); PG8_BAR;
            PG8_LDA(At, 0, 1); PG8_STAGE(PG8_SA(0, 0), a2, voffA);
            PG8_BAR; PG8_WAIT_L(0); PG8_MMA(1, 0, At, B0); PG8_BAR; PG8_SCHED;
            PG8_STAGE(PG8_SB(0, 1), b2 + hstep, voffB);
            PG8_WAIT_V(6); PG8_BAR; PG8_MMA(1, 1, At, B1); PG8_BAR;
            PG8_LDB(B0, 1, 0); PG8_SCHED; PG8_LDA(At, 1, 0); PG8_STAGE(PG8_SA(0, 1), a2 + hstep, voffA);
            PG8_WAIT_L(8); PG8_BAR; PG8_WAIT_L(0); PG8_MMA(0, 0, At, B0); PG8_BAR; PG8_SCHED;
            PG8_LDB(B1, 1, 1); PG8_STAGE(PG8_SB(1, 0), b3, voffB);
            PG8_BAR; PG8_WAIT_L(0); PG8_MMA(0, 1, At, B1); PG8_BAR;
            PG8_LDA(At, 1, 1); PG8_STAGE(PG8_SA(1, 0), a3, voffA);
            PG8_BAR; PG8_WAIT_L(0); PG8_MMA(1, 0, At, B0); PG8_BAR; PG8_SCHED;
            PG8_STAGE(PG8_SB(1, 1), b3 + hstep, voffB);
            PG8_WAIT_V(6); PG8_BAR; PG8_MMA(1, 1, At, B1); PG8_BAR;
            }
        }
        if constexpr (ALIGN_EPI) { if (wr == 0) PG8_BAR; }
        if constexpr (!Epi::AFTER_DRAIN) { E(acc, cur, wr, wc, fr, fq); S.done(cur); }
        if (!has_next) break;
#pragma unroll
        for (int a = 0; a < 2; ++a)
#pragma unroll
            for (int b = 0; b < 2; ++b)
#pragma unroll
                for (int m = 0; m < 4; ++m)
#pragma unroll
                    for (int n = 0; n < 2; ++n) acc[a][b][m][n] = (f32x4){0.f, 0.f, 0.f, 0.f};
        cur = nxt; cA = nA; cB = nB; ++ui;
        if constexpr (ALIGN_EPI) { if (wr == 1) PG8_BAR; }
    }
    PG8_WAIT_V(0);
    if constexpr (!ALIGN_EPI) { if (wr == 0) PG8_BAR; }
    PG8_BAR;
    if constexpr (Epi::AFTER_DRAIN) { E.fused(acc, cur, wr, wc, fr, fq, lds, wid, lane); S.done(cur); }
#undef PG8_SA
#undef PG8_SB
#undef PG8_STAGE
#undef PG8_LDA
#undef PG8_LDB
#undef PG8_MMA
#undef PG8_WAIT_V
#undef PG8_WAIT_L
#undef PG8_BAR
#undef PG8_SCHED
}
}
#define LAS __attribute__((address_space(3)))
#define DI __device__ __forceinline__
typedef unsigned short bf16_t;
typedef short bf16x8 __attribute__((ext_vector_type(8)));
typedef float f32x4 __attribute__((ext_vector_type(4)));
typedef float f32x16 __attribute__((ext_vector_type(16)));
typedef unsigned u32x4 __attribute__((ext_vector_type(4)));
typedef unsigned u32x2 __attribute__((ext_vector_type(2)));
using pg8::pk2;

constexpr int NWAVES = 8, NTHREADS = 512;
constexpr int D = 2048, BATCH = 4, SEQ = 2048, M = BATCH * SEQ, DFF = 5632;
constexpr int AB_IN = 5120, DN_IN = 12352, DN_IN_PAD = 12544;
constexpr float ALPHA = 1.41421356237f;
constexpr float LN_EPS = 1e-5f, RMS_EPS = 1e-6f;
constexpr size_t MiB = (size_t)1 << 20;
constexpr size_t WS_L0 = 0;
constexpr size_t WS_WGU1_0 = 0, WS_WD1_0 = 44 * MiB, WS_WGU2_0 = 66 * MiB, WS_WD2_0 = 110 * MiB, WS_WABIN = 132 * MiB, WS_WABOUT = 152 * MiB;
constexpr size_t WS_WGU1_1 = 160 * MiB, WS_WD1_1 = 204 * MiB, WS_WGU2_1 = 226 * MiB, WS_WD2_1 = 270 * MiB, WS_WDNIN = 292 * MiB, WS_WDNOUT = 341 * MiB;
constexpr size_t WS_XB = 357 * MiB;
constexpr size_t WS_BIG = 389 * MiB;
constexpr size_t WS_BA = WS_BIG + 192 * MiB;
constexpr size_t WS_DNX = 585 * MiB;
constexpr size_t WS_QR = WS_DNX, WS_KR = WS_DNX + 16 * MiB, WS_VT = WS_DNX + 32 * MiB, WS_CAT = WS_DNX + 48 * MiB, WS_KMEAN = WS_DNX + 80 * MiB;
constexpr size_t WS_QN = WS_DNX, WS_KN = WS_DNX + 32 * MiB, WS_V = WS_DNX + 64 * MiB, WS_G = WS_DNX + 128 * MiB, WS_BETA = WS_DNX + 129 * MiB;
constexpr size_t WS_OG = WS_L0;
constexpr size_t WS_WIMG = WS_BIG, WS_UIMG = WS_BIG + 64 * MiB;
constexpr size_t WS_AIMG = WS_L0 + 64 * MiB, WS_QIMG = WS_L0 + 96 * MiB, WS_KTIMG = WS_L0 + 128 * MiB;
constexpr size_t WS_GC = 715 * MiB;
constexpr size_t WS_BAR = 717 * MiB, BAR_BYTES = 16384;
constexpr size_t WS_END = 718 * MiB;
constexpr int LDS_BYTES = 147456;

DI float bflo(unsigned u) { return __uint_as_float(u << 16); }
DI float bfhi(unsigned u) { return __uint_as_float(u & 0xffff0000u); }
DI float bf2f(bf16_t h) { return __uint_as_float((unsigned)h << 16); }
DI bf16_t f2bf(float f) { return (bf16_t)(pk2(f, 0.f) & 0xffffu); }
DI float wave_sum(float v) {
#pragma unroll
    for (int o = 1; o < 64; o <<= 1) v += __shfl_xor(v, o);
    return v;
}
DI float gelu_tanh(float x) { const float t = 1.5957691216f * (x + 0.044715f * x * x * x); return x * __builtin_amdgcn_rcpf(1.0f + __expf(-t)); }
DI int crow(int r, int h) { return (r & 3) + 8 * (r >> 2) + 4 * h; }
#define MFMA32(a, b, c) __builtin_amdgcn_mfma_f32_32x32x16_bf16((a), (b), (c), 0, 0, 0)
DI bf16x8 pack8(float a0, float a1, float a2, float a3, float a4, float a5, float a6, float a7) {
    u32x4 p; p.x = pk2(a0, a1); p.y = pk2(a2, a3); p.z = pk2(a4, a5); p.w = pk2(a6, a7); return __builtin_bit_cast(bf16x8, p);
}

DI void tr_tile(const float* __restrict__ W, int K, int N, bf16_t* __restrict__ WT, int k0, int n0, int drow0, LAS float* scr, int lane) {
#pragma unroll 4
    for (int i = 0; i < 16; ++i) { const int kk = 4 * i + (lane >> 4), c4 = (lane & 15) * 4;
        const f32x4 v = *(const f32x4*)(W + (size_t)(k0 + kk) * N + n0 + c4);
        LAS float* s = scr + kk * 65 + c4; s[0] = v.x; s[1] = v.y; s[2] = v.z; s[3] = v.w; }
    asm volatile("s_waitcnt lgkmcnt(0)" ::: "memory");
    const int c = lane & 7;
#pragma unroll
    for (int j = 0; j < 8; ++j) { const int n = (lane >> 3) + 8 * j; const LAS float* s = scr + (8 * c) * 65 + n;
        u32x4 o; o.x = pk2(s[0], s[65]); o.y = pk2(s[2 * 65], s[3 * 65]); o.z = pk2(s[4 * 65], s[5 * 65]); o.w = pk2(s[6 * 65], s[7 * 65]);
        *(u32x4*)(WT + (size_t)(drow0 + n) * K + k0 + 8 * c) = o; }
    asm volatile("s_waitcnt lgkmcnt(0)" ::: "memory");
}
DI void tr_matrix(const float* W, int K, int N, bf16_t* WT, int mode, LAS float* scr, int gw, int ngw, int lane) {
    const int nb = N / 64, items = (K / 64) * nb;
    for (int it = gw; it < items; it += ngw) {
        const int kb = it / nb, n0 = (it % nb) * 64;
        const int drow0 = mode == 0 ? n0 : ((n0 >> 7) * 256 + (n0 & 127) + (mode == 2 ? 128 : 0));
        tr_tile(W, K, N, WT, kb * 64, n0, drow0, scr, lane);
    }
}

struct Args { const float* in[21]; float* out; unsigned char* ws; int ph_lo, ph_hi; };

DI void p0_prologue(const Args& a, LAS unsigned char* lds, int wave, int lane) {
    LAS float* scr = (LAS float*)(lds + wave * 17408);
    const int gw = blockIdx.x * NWAVES + wave, ngw = gridDim.x * NWAVES;
    unsigned char* ws = a.ws;
    const size_t WGU = (size_t)D * DFF;
    for (int l = 0; l < 2; ++l) {
        bf16_t* gu1 = (bf16_t*)(ws + (l ? WS_WGU1_1 : WS_WGU1_0)); bf16_t* d1 = (bf16_t*)(ws + (l ? WS_WD1_1 : WS_WD1_0));
        bf16_t* gu2 = (bf16_t*)(ws + (l ? WS_WGU2_1 : WS_WGU2_0)); bf16_t* d2 = (bf16_t*)(ws + (l ? WS_WD2_1 : WS_WD2_0));
        tr_matrix(a.in[1] + l * WGU, D, DFF, gu1, 1, scr, gw, ngw, lane);
        tr_matrix(a.in[2] + l * WGU, D, DFF, gu1, 2, scr, gw, ngw, lane);
        tr_matrix(a.in[3] + l * WGU, DFF, D, d1, 0, scr, gw, ngw, lane);
        tr_matrix(a.in[4] + l * WGU, D, DFF, gu2, 1, scr, gw, ngw, lane);
        tr_matrix(a.in[5] + l * WGU, D, DFF, gu2, 2, scr, gw, ngw, lane);
        tr_matrix(a.in[6] + l * WGU, DFF, D, d2, 0, scr, gw, ngw, lane);
    }
    tr_matrix(a.in[9], D, AB_IN, (bf16_t*)(ws + WS_WABIN), 0, scr, gw, ngw, lane);
    tr_matrix(a.in[14], D, D, (bf16_t*)(ws + WS_WABOUT), 0, scr, gw, ngw, lane);
    tr_matrix(a.in[15], D, DN_IN, (bf16_t*)(ws + WS_WDNIN), 0, scr, gw, ngw, lane);
    tr_matrix(a.in[20], 4096, D, (bf16_t*)(ws + WS_WDNOUT), 0, scr, gw, ngw, lane);
    { u32x4* p = (u32x4*)((bf16_t*)(ws + WS_WDNIN) + (size_t)DN_IN * D); const int n16 = (DN_IN_PAD - DN_IN) * D / 8;
      for (int i = blockIdx.x * NTHREADS + threadIdx.x; i < n16; i += gridDim.x * NTHREADS) p[i] = (u32x4){0u, 0u, 0u, 0u}; }
    { const f32x4* x4 = (const f32x4*)a.in[0]; u32x2* xb = (u32x2*)(ws + WS_XB); const int n4 = M * D / 4;
      for (int i = blockIdx.x * NTHREADS + threadIdx.x; i < n4; i += gridDim.x * NTHREADS) { const f32x4 v = x4[i]; xb[i] = (u32x2){pk2(v.x, v.y), pk2(v.z, v.w)}; } }
}

DI void ln_phase(float* Y, bf16_t* XB, const float* g, const float* b, int wave, int lane) {
    const int gw = blockIdx.x * NWAVES + wave, ngw = gridDim.x * NWAVES;
    for (int m = gw; m < M; m += ngw) {
        f32x4* yr = (f32x4*)(Y + (size_t)m * D) + lane;
        f32x4 v[8]; float s = 0.f;
#pragma unroll
        for (int j = 0; j < 8; ++j) { v[j] = yr[64 * j]; s += (v[j].x + v[j].y) + (v[j].z + v[j].w); }
        const float mean = wave_sum(s) * (1.f / D); float s2 = 0.f;
#pragma unroll
        for (int j = 0; j < 8; ++j) { v[j] = v[j] - mean; s2 += (v[j].x * v[j].x + v[j].y * v[j].y) + (v[j].z * v[j].z + v[j].w * v[j].w); }
        const float rstd = rsqrtf(wave_sum(s2) * (1.f / D) + LN_EPS);
        u32x2* o8 = (u32x2*)(XB + (size_t)m * D) + lane;
#pragma unroll
        for (int j = 0; j < 8; ++j) { const f32x4 gg = ((const f32x4*)g)[lane + 64 * j], bb = ((const f32x4*)b)[lane + 64 * j];
            const f32x4 o = v[j] * rstd * gg + bb; yr[64 * j] = o; o8[64 * j] = (u32x2){pk2(o.x, o.y), pk2(o.z, o.w)}; }
    }
}

DI void rope_item(const bf16_t* HC, bf16_t* Qr, bf16_t* Kr, bf16_t* Vt, float* kmean, int item, LAS float* red, int tid) {
    const int h = item & 7, blk = (item >> 3) & 7, b = item >> 6, bh = b * 8 + h;
    const int i = tid & 63, rg = tid >> 6;
    const float inv = expf((-9.210340371976184f * (float)i) * 0.015625f);
    float ks0 = 0.f, ks1 = 0.f;
    for (int rr = 0; rr < 32; ++rr) {
        const int pos = blk * 256 + rr * 8 + rg; const size_t row = (size_t)b * SEQ + pos;
        float sn, cs; sincosf((float)pos * inv, &sn, &cs);
        const bf16_t* hp = HC + row * AB_IN + h * 128 + i;
        const float q1 = bf2f(hp[0]), q2 = bf2f(hp[64]), k1 = bf2f(hp[1024]), k2 = bf2f(hp[1024 + 64]);
        const bf16_t v1 = hp[2048], v2 = hp[2048 + 64];
        const float qa = (q1 * cs - q2 * sn) * 0.08838834764831845f, qb = (q2 * cs + q1 * sn) * 0.08838834764831845f;
        const float ka = k1 * cs - k2 * sn, kb = k2 * cs + k1 * sn;
        const size_t o = ((size_t)bh * SEQ + pos) * 128 + i;
        Qr[o] = f2bf(qa); Qr[o + 64] = f2bf(qb); Kr[o] = f2bf(ka); Kr[o + 64] = f2bf(kb);
        ks0 += ka; ks1 += kb;
        Vt[((size_t)bh * 128 + i) * SEQ + pos] = v1; Vt[((size_t)bh * 128 + i + 64) * SEQ + pos] = v2;
    }
    red[rg * 128 + i] = ks0; red[rg * 128 + 64 + i] = ks1;
    __syncthreads();
    if (tid < 128) { float s = 0.f;
#pragma unroll
        for (int g = 0; g < 8; ++g) s += red[g * 128 + tid];
        kmean[((size_t)bh * 8 + blk) * 128 + tid] = s * (1.f / 256.f); }
    __syncthreads();
}

DI void gmlp_item(const bf16_t* HC, const float* lng, const float* lnb, const float* w_s, const float* b_s, bf16_t* CAT, int item, LAS unsigned char* lds, int wave, int lane) {
    const int g = item & 7, c = (item >> 3) & 15, b = item >> 7;
    const size_t row0 = (size_t)b * SEQ + c * 128;
    LAS bf16_t* vnT = (LAS bf16_t*)lds;
    { const float g0 = lng[g * 128 + 2 * lane], g1 = lng[g * 128 + 2 * lane + 1], b0 = lnb[g * 128 + 2 * lane], b1 = lnb[g * 128 + 2 * lane + 1];
      for (int ss = 0; ss < 16; ++ss) { const int s = wave * 16 + ss;
        const unsigned raw = *(const unsigned*)(HC + (row0 + s) * AB_IN + 4096 + g * 128 + 2 * lane);
        const float v0 = gelu_tanh(bflo(raw)), v1 = gelu_tanh(bfhi(raw));
        const float mu = wave_sum(v0 + v1) * (1.f / 128.f); const float d0 = v0 - mu, d1 = v1 - mu;
        const float rstd = rsqrtf(wave_sum(d0 * d0 + d1 * d1) * (1.f / 128.f) + LN_EPS);
        vnT[(2 * lane) * 136 + s] = f2bf(d0 * rstd * g0 + b0); vnT[(2 * lane + 1) * 136 + s] = f2bf(d1 * rstd * g1 + b1); } }
    __syncthreads();
    const int tt = wave >> 1, dh = wave & 1, r32 = lane & 31, hi = lane >> 5;
    f32x16 acc[2];
#pragma unroll
    for (int j = 0; j < 2; ++j)
#pragma unroll
        for (int r = 0; r < 16; ++r) acc[j][r] = 0.f;
    const int t = 32 * tt + r32; const float* wrow = w_s + ((size_t)g * 128 + t) * 128;
    for (int st = 0; st < 2 * (tt + 1); ++st) { const int s0 = 16 * st + 8 * hi;
        const f32x4 w0 = *(const f32x4*)(wrow + s0), w1 = *(const f32x4*)(wrow + s0 + 4);
        const bf16x8 a = pack8(s0 + 0 <= t ? w0.x : 0.f, s0 + 1 <= t ? w0.y : 0.f, s0 + 2 <= t ? w0.z : 0.f, s0 + 3 <= t ? w0.w : 0.f,
                               s0 + 4 <= t ? w1.x : 0.f, s0 + 5 <= t ? w1.y : 0.f, s0 + 6 <= t ? w1.z : 0.f, s0 + 7 <= t ? w1.w : 0.f);
#pragma unroll
        for (int j = 0; j < 2; ++j) { const bf16x8 bv = *(const LAS bf16x8*)(vnT + (32 * (2 * dh + j) + r32) * 136 + s0); acc[j] = MFMA32(a, bv, acc[j]); } }
#pragma unroll
    for (int j = 0; j < 2; ++j) { const int d = 32 * (2 * dh + j) + r32;
#pragma unroll
        for (int r = 0; r < 16; ++r) { const int tq = 32 * tt + crow(r, hi); const size_t row = row0 + tq;
            const float uval = gelu_tanh(bf2f(HC[row * AB_IN + 3072 + g * 128 + d]));
            CAT[row * D + 1024 + g * 128 + d] = f2bf(uval * (acc[j][r] + b_s[g * 128 + tq])); } }
    __syncthreads();
}

DI void moba_wave(const bf16_t* Qr, const bf16_t* Kr, const bf16_t* Vt, const float* kmean, bf16_t* CAT, int bh, int qt, int lane) {
    const int qi = lane & 31, hi = lane >> 5, q0 = qt * 32, own = q0 >> 8, pos = q0 + qi, b = bh >> 3, h = bh & 7;
    bf16x8 qf[8];
    { const bf16_t* qp = Qr + ((size_t)bh * SEQ + pos) * 128 + 8 * hi;
#pragma unroll
      for (int st = 0; st < 8; ++st) qf[st] = *(const bf16x8*)(qp + 16 * st); }
    unsigned selmask = 0u;
    if (own > 0) {
        f32x16 ga;
#pragma unroll
        for (int r = 0; r < 16; ++r) ga[r] = 0.f;
#pragma unroll
        for (int st = 0; st < 8; ++st) { bf16x8 a = (bf16x8){0, 0, 0, 0, 0, 0, 0, 0};
            if (qi < 8) { const float* kp = kmean + ((size_t)bh * 8 + qi) * 128 + 16 * st + 8 * hi; const f32x4 k0 = *(const f32x4*)kp, k1 = *(const f32x4*)(kp + 4);
                a = pack8(k0.x, k0.y, k0.z, k0.w, k1.x, k1.y, k1.z, k1.w); }
            ga = MFMA32(a, qf[st], ga); }
        float g[8];
#pragma unroll
        for (int r = 0; r < 4; ++r) { const float mine = ga[r], other = __shfl_xor(mine, 32); g[r] = hi ? other : mine; g[4 + r] = hi ? mine : other; }
        const int nsel = own < 3 ? own : 3;
#pragma unroll
        for (int j = 0; j < 8; ++j) { int rank = 0;
#pragma unroll
            for (int i2 = 0; i2 < 8; ++i2) if (i2 != j) rank += (i2 < own && (g[i2] > g[j] || (g[i2] == g[j] && i2 < j))) ? 1 : 0;
            if (j < own && rank < nsel) selmask |= 1u << j; }
    }
    f32x16 o[4];
#pragma unroll
    for (int dt = 0; dt < 4; ++dt)
#pragma unroll
        for (int r = 0; r < 16; ++r) o[dt][r] = 0.f;
    float mrun = -INFINITY, lrun = 0.f;
    for (int j = 0; j <= own; ++j) {
        const bool act = (j == own) || ((selmask >> j) & 1u);
        if (__ballot(act) == 0ull) continue;
        const int nkt = (j == own) ? ((q0 & 255) >> 5) + 1 : 8;
        for (int kt = 0; kt < nkt; ++kt) {
            const int key0 = j * 256 + kt * 32;
            f32x16 s;
#pragma unroll
            for (int r = 0; r < 16; ++r) s[r] = 0.f;
            const bf16_t* kp = Kr + ((size_t)bh * SEQ + key0 + qi) * 128 + 8 * hi;
#pragma unroll
            for (int st = 0; st < 8; ++st) s = MFMA32(*(const bf16x8*)(kp + 16 * st), qf[st], s);
            float mt = -INFINITY;
#pragma unroll
            for (int r = 0; r < 16; ++r) { const int key = key0 + crow(r, hi); const bool ok = act && (j < own || key <= pos); s[r] = ok ? s[r] : -INFINITY; mt = fmaxf(mt, s[r]); }
            mt = fmaxf(mt, __shfl_xor(mt, 32));
            const float mnew = fmaxf(mrun, mt), muse = (mnew == -INFINITY) ? 0.f : mnew;
            const float alpha = __expf(mrun - muse);
            float ls = 0.f;
#pragma unroll
            for (int r = 0; r < 16; ++r) { s[r] = __expf(s[r] - muse); ls += s[r]; }
            lrun = lrun * alpha + ls; mrun = mnew;
#pragma unroll
            for (int dt = 0; dt < 4; ++dt)
#pragma unroll
                for (int r = 0; r < 16; ++r) o[dt][r] *= alpha;
#pragma unroll
            for (int sp = 0; sp < 2; ++sp) {
                const bf16x8 pb = pack8(s[8 * sp], s[8 * sp + 1], s[8 * sp + 2], s[8 * sp + 3], s[8 * sp + 4], s[8 * sp + 5], s[8 * sp + 6], s[8 * sp + 7]);
#pragma unroll
                for (int dt = 0; dt < 4; ++dt) { const bf16_t* vp = Vt + ((size_t)bh * 128 + 32 * dt + qi) * SEQ + key0 + 16 * sp + 4 * hi;
                    const u32x2 lo = *(const u32x2*)vp, hh = *(const u32x2*)(vp + 8);
                    const bf16x8 a = __builtin_bit_cast(bf16x8, (u32x4){lo.x, lo.y, hh.x, hh.y});
                    o[dt] = MFMA32(a, pb, o[dt]); }
            }
        }
    }
    const float ltot = lrun + __shfl_xor(lrun, 32), inv = 1.0f / ltot;
    bf16_t* op = CAT + ((size_t)b * SEQ + pos) * D + h * 128;
#pragma unroll
    for (int dt = 0; dt < 4; ++dt)
#pragma unroll
        for (int g4 = 0; g4 < 4; ++g4) { const int d = 32 * dt + 8 * g4 + 4 * hi;
            *(u32x2*)(op + d) = (u32x2){pk2(o[dt][4 * g4] * inv, o[dt][4 * g4 + 1] * inv), pk2(o[dt][4 * g4 + 2] * inv, o[dt][4 * g4 + 3] * inv)}; }
}

DI float sum16(float v) {
    v += __shfl_xor(v, 1); v += __shfl_xor(v, 2); v += __shfl_xor(v, 4); v += __shfl_xor(v, 8); return v;
}
DI void unpack8(const u32x4 r, float (&x)[8]) { x[0] = bflo(r.x); x[1] = bfhi(r.x); x[2] = bflo(r.y); x[3] = bfhi(r.y); x[4] = bflo(r.z); x[5] = bfhi(r.z); x[6] = bflo(r.w); x[7] = bfhi(r.w); }
DI void dnp_phase(const bf16_t* QKraw, const bf16_t* Vraw, const float* BA, const float* conv_w, const float* a_log, const float* dt_bias,
                  bf16_t* QN, bf16_t* KN, bf16_t* V, float* G, float* BETA, int wave, int lane) {
    const int gw = blockIdx.x * NWAVES + wave, ngw = gridDim.x * NWAVES;
    const int rs = lane >> 4, c8 = (lane & 15) * 8;
    for (int it = gw; it < BATCH * 64 * 32; it += ngw) {
        const int rc = it & 31, hs = (it >> 5) & 63, b = it >> 11;
        const int ch = hs * 128 + c8;
        float w[4][8];
#pragma unroll
        for (int j = 0; j < 4; ++j) { const f32x4 a = *(const f32x4*)(conv_w + j * 8192 + ch), c = *(const f32x4*)(conv_w + j * 8192 + ch + 4);
            w[j][0] = a.x; w[j][1] = a.y; w[j][2] = a.z; w[j][3] = a.w; w[j][4] = c.x; w[j][5] = c.y; w[j][6] = c.z; w[j][7] = c.w; }
        const bf16_t* src = hs < 32 ? QKraw + ch : Vraw + (ch - 4096);
        const int t0 = rc * 64 + rs * 16;
        u32x4 raw[19];
#pragma unroll
        for (int j = 0; j < 19; ++j) { const int t = t0 - 3 + j; raw[j] = (u32x4){0u, 0u, 0u, 0u}; if (t >= 0) raw[j] = *(const u32x4*)(src + ((size_t)b * SEQ + t) * 4096); }
        float xa[8], xb[8], xc[8], xd[8];
        unpack8(raw[0], xa); unpack8(raw[1], xb); unpack8(raw[2], xc);
#pragma unroll
        for (int tt = 0; tt < 16; ++tt) { const size_t row = (size_t)b * SEQ + t0 + tt;
            unpack8(raw[tt + 3], xd);
            float y[8]; float ss = 0.f;
#pragma unroll
            for (int i = 0; i < 8; ++i) { y[i] = pg8::silu_f(xa[i] * w[0][i] + xb[i] * w[1][i] + xc[i] * w[2][i] + xd[i] * w[3][i]); ss += y[i] * y[i]; xa[i] = xb[i]; xb[i] = xc[i]; xc[i] = xd[i]; }
            float sc = 1.0f;
            if (hs < 32) { sc = rsqrtf(sum16(ss) + RMS_EPS) * (hs < 16 ? 0.08838834764831845f : 1.0f); }
            u32x4 o; o.x = pk2(y[0] * sc, y[1] * sc); o.y = pk2(y[2] * sc, y[3] * sc); o.z = pk2(y[4] * sc, y[5] * sc); o.w = pk2(y[6] * sc, y[7] * sc);
            bf16_t* dst = hs < 16 ? QN + row * 2048 + ch : (hs < 32 ? KN + row * 2048 + (ch - 2048) : V + row * 4096 + (ch - 4096));
            *(u32x4*)dst = o; }
    }
    for (int i = blockIdx.x * NTHREADS + threadIdx.x; i < M * 32; i += gridDim.x * NTHREADS) { const int row = i >> 5, h = i & 31;
        const float bb = BA[(size_t)row * 64 + h], aa = BA[(size_t)row * 64 + 32 + h];
        BETA[i] = 1.0f / (1.0f + expf(-bb));
        const float x = aa + dt_bias[h]; const float sp = x > 20.f ? x : log1pf(expf(x));
        G[i] = -expf(a_log[h]) * sp; }
}

#define PACKS(x, s) pack8((x)[8 * (s)], (x)[8 * (s) + 1], (x)[8 * (s) + 2], (x)[8 * (s) + 3], (x)[8 * (s) + 4], (x)[8 * (s) + 5], (x)[8 * (s) + 6], (x)[8 * (s) + 7])
constexpr int DW_STRIDE = 18432;
constexpr int DW_A00 = 0, DW_A11 = 4608, DW_A10 = 9216, DW_TT0 = 11776, DW_T11 = 14336, DW_GC = 16896, DW_BT = 17152;
constexpr int DW_TB = 0, DW_X = 9216, DW_X2 = 13824;
#define LDSW() asm volatile("s_waitcnt lgkmcnt(0)" ::: "memory")
DI void dna_wave(const bf16_t* QN, const bf16_t* KN, const bf16_t* V, const float* G, const float* BETA,
                 bf16_t* Wimg, bf16_t* Uimg, bf16_t* Aimg, bf16_t* Qimg, bf16_t* KTimg, float* EGt, float* DKt, int item, LAS unsigned char* wl, int lane) {
    asm volatile("" : "+v"(lane));
    const int hv = item & 31, n = (item >> 5) & 31, b = item >> 10, hk = hv >> 1, r32 = lane & 31, hi = lane >> 5;
    int itemv = item; asm volatile("" : "+v"(itemv));
    const size_t row0 = (size_t)(itemv >> 10) * SEQ + ((itemv >> 5) & 31) * 64;
    const int itemk = ((itemv >> 10) * 32 + ((itemv >> 5) & 31)) * 16 + ((itemv & 31) >> 1);
    LAS float* A00 = (LAS float*)(wl + DW_A00); LAS float* A11 = (LAS float*)(wl + DW_A11);
    LAS bf16_t* A10b = (LAS bf16_t*)(wl + DW_A10); LAS bf16_t* TT0 = (LAS bf16_t*)(wl + DW_TT0); LAS bf16_t* T11 = (LAS bf16_t*)(wl + DW_T11);
    LAS float* gcs = (LAS float*)(wl + DW_GC); LAS float* bts = (LAS float*)(wl + DW_BT);
    float gx = G[(row0 + lane) * 32 + hv];
#pragma unroll
    for (int o = 1; o < 64; o <<= 1) { const float t = __shfl_up(gx, o); if (lane >= o) gx += t; }
    const float mybeta = BETA[(row0 + lane) * 32 + hv], myeg = __expf(gx);
    gcs[lane] = gx; bts[lane] = mybeta;
    { const float gl = __shfl(gx, 63); const int c5 = lane & 31, ti = (((lane >> 5) * 2 + ((c5 >> 2) & 1)) * 16) + (c5 & 3) + 4 * (c5 >> 3);
      EGt[(size_t)itemv * 64 + ti] = myeg; DKt[(size_t)itemv * 64 + ti] = __expf(gl - gx); }
    bf16x8 kf[2][8], qf[2][8];
    { const bf16_t* kp = KN + (row0 + r32) * 2048 + hk * 128 + 8 * hi; const bf16_t* qp = QN + (row0 + r32) * 2048 + hk * 128 + 8 * hi;
#pragma unroll
      for (int t2 = 0; t2 < 2; ++t2)
#pragma unroll
          for (int st = 0; st < 8; ++st) { kf[t2][st] = *(const bf16x8*)(kp + (size_t)t2 * 32 * 2048 + 16 * st); qf[t2][st] = *(const bf16x8*)(qp + (size_t)t2 * 32 * 2048 + 16 * st); } }
    LDSW();
#pragma unroll
    for (int tl = 0; tl < 3; ++tl) { const int ct = tl == 0 ? 0 : 1, et = tl == 1 ? 1 : 0;
        f32x16 acc;
#pragma unroll
        for (int r = 0; r < 16; ++r) acc[r] = 0.f;
#pragma unroll
        for (int st = 0; st < 8; ++st) acc = MFMA32(kf[ct][st], kf[et][st], acc);
        const int e = 32 * et + r32; const float ge = gcs[e];
#pragma unroll
        for (int r = 0; r < 16; ++r) { const int cl = crow(r, hi), c = 32 * ct + cl; const float val = (e < c) ? bts[c] * acc[r] * __expf(gcs[c] - ge) : 0.f;
            if (tl == 0) A00[cl * 36 + r32] = val; else if (tl == 1) A11[cl * 36 + r32] = val; else A10b[cl * 40 + r32] = f2bf(val); } }
#pragma unroll
    for (int tl = 0; tl < 3; ++tl) { const int et = tl == 2 ? 1 : 0, ct = tl == 0 ? 0 : 1;
        f32x16 acc;
#pragma unroll
        for (int r = 0; r < 16; ++r) acc[r] = 0.f;
#pragma unroll
        for (int st = 0; st < 8; ++st) acc = MFMA32(kf[et][st], qf[ct][st], acc);
        const int c = 32 * ct + r32; const float gcc = gcs[c];
#pragma unroll
        for (int r = 0; r < 16; ++r) { const int e = 32 * et + crow(r, hi); acc[r] = (e <= c) ? acc[r] * __expf(gcc - gcs[e]) : 0.f; }
#pragma unroll
        for (int s = 0; s < 2; ++s) *(u32x4*)(Aimg + ((((size_t)itemv * 4 + ct * 2 + et) * 2 + s) * 512 + lane * 8)) = __builtin_bit_cast(u32x4, PACKS(acc, s)); }
    if ((hv & 1) == 0) {
#pragma unroll 1
        for (int ct = 0; ct < 2; ++ct)
#pragma unroll
            for (int kt = 0; kt < 4; ++kt)
#pragma unroll
                for (int s = 0; s < 2; ++s) { const bf16_t* sp = QN + (row0 + 32 * ct + r32) * 2048 + hk * 128 + 32 * kt + 16 * s + 4 * hi;
                    const u32x2 lo = *(const u32x2*)sp, hh = *(const u32x2*)(sp + 8);
                    *(u32x4*)(Qimg + ((((size_t)itemk * 8 + ct * 4 + kt) * 2 + s) * 512 + lane * 8)) = (u32x4){lo.x, lo.y, hh.x, hh.y}; } }
    LDSW();
    float T[32];
    { const LAS float* Ab = hi ? A11 : A00;
#pragma unroll
      for (int i = 0; i < 32; ++i) { float acc = (i == r32) ? 1.f : 0.f;
#pragma unroll
          for (int q = 0; q < (i + 3) / 4; ++q) { const f32x4 a4 = *(const LAS f32x4*)(Ab + i * 36 + 4 * q);
              if (4 * q + 0 < i) acc -= a4.x * T[4 * q + 0];
              if (4 * q + 1 < i) acc -= a4.y * T[4 * q + 1];
              if (4 * q + 2 < i) acc -= a4.z * T[4 * q + 2];
              if (4 * q + 3 < i) acc -= a4.w * T[4 * q + 3]; }
          T[i] = acc; } }
    if (hi) {
#pragma unroll
        for (int i = 0; i < 32; ++i) T11[i * 40 + r32] = f2bf(T[i]);
    } else {
#pragma unroll
        for (int q = 0; q < 4; ++q) *(LAS u32x4*)(TT0 + r32 * 40 + 8 * q) = __builtin_bit_cast(u32x4, pack8(T[8 * q], T[8 * q + 1], T[8 * q + 2], T[8 * q + 3], T[8 * q + 4], T[8 * q + 5], T[8 * q + 6], T[8 * q + 7]));
    }
    LDSW();
    f32x16 Xa, Ya;
#pragma unroll
    for (int r = 0; r < 16; ++r) { Xa[r] = 0.f; Ya[r] = 0.f; }
#pragma unroll
    for (int s = 0; s < 2; ++s) Xa = MFMA32(*(const LAS bf16x8*)(A10b + r32 * 40 + 16 * s + 8 * hi), *(const LAS bf16x8*)(TT0 + r32 * 40 + 16 * s + 8 * hi), Xa);
#pragma unroll
    for (int s = 0; s < 2; ++s) { const LAS bf16_t* tp = T11 + r32 * 40 + 16 * s + 4 * hi; const u32x2 lo = *(const LAS u32x2*)tp, hh = *(const LAS u32x2*)(tp + 8);
        Ya = MFMA32(__builtin_bit_cast(bf16x8, (u32x4){lo.x, lo.y, hh.x, hh.y}), PACKS(Xa, s), Ya); }
    LDSW();
    LAS bf16_t* Tb = (LAS bf16_t*)(wl + DW_TB); LAS bf16_t* X = (LAS bf16_t*)(wl + DW_X); LAS bf16_t* X2 = (LAS bf16_t*)(wl + DW_X2);
    if (hi) {
#pragma unroll
        for (int i = 0; i < 32; ++i) Tb[(32 + i) * 72 + 32 + r32] = f2bf(T[i]);
    } else {
#pragma unroll
        for (int i = 0; i < 32; ++i) Tb[i * 72 + r32] = f2bf(T[i]);
    }
#pragma unroll
    for (int r = 0; r < 16; ++r) Tb[(32 + crow(r, hi)) * 72 + r32] = f2bf(-Ya[r]);
    LDSW();
    const float be = mybeta, bg = mybeta * myeg;
#pragma unroll 1
    for (int vt = 0; vt < 4; ++vt) {
        { const bf16_t* vp = V + (row0 + lane) * 4096 + hv * 128 + 32 * vt;
#pragma unroll
          for (int q = 0; q < 4; ++q) { const u32x4 rv = *(const u32x4*)(vp + 8 * q); float x[8]; unpack8(rv, x);
#pragma unroll
              for (int i = 0; i < 8; ++i) X[(8 * q + i) * 72 + lane] = f2bf(x[i] * be); } }
        LDSW();
#pragma unroll
        for (int ct = 0; ct < 2; ++ct) { f32x16 acc;
#pragma unroll
            for (int r = 0; r < 16; ++r) acc[r] = 0.f;
#pragma unroll
            for (int es = 0; es < 4; ++es) if (es < 2 * (ct + 1)) acc = MFMA32(*(const LAS bf16x8*)(Tb + (32 * ct + r32) * 72 + 16 * es + 8 * hi), *(const LAS bf16x8*)(X + r32 * 72 + 16 * es + 8 * hi), acc);
            bf16_t* dst = Uimg + (((size_t)itemv * 4 + vt) * 2 + ct) * 1024 + lane * 16;
#pragma unroll
            for (int s = 0; s < 2; ++s) *(u32x4*)(dst + 8 * s) = __builtin_bit_cast(u32x4, PACKS(acc, s)); }
        LDSW();
    }
#pragma unroll 1
    for (int kt = 0; kt < 4; ++kt) {
        { const bf16_t* kp = KN + (row0 + lane) * 2048 + hk * 128 + 32 * kt;
#pragma unroll
          for (int q = 0; q < 4; ++q) { const u32x4 rv = *(const u32x4*)(kp + 8 * q); float x[8]; unpack8(rv, x); const unsigned rw[4] = {rv.x, rv.y, rv.z, rv.w};
#pragma unroll
              for (int i = 0; i < 8; ++i) { X[(8 * q + i) * 72 + lane] = f2bf(x[i] * bg); X2[(8 * q + i) * 72 + lane] = (bf16_t)((i & 1) ? (rw[i >> 1] >> 16) : (rw[i >> 1] & 0xffffu)); } } }
        LDSW();
#pragma unroll
        for (int ct = 0; ct < 2; ++ct) { f32x16 acc;
#pragma unroll
            for (int r = 0; r < 16; ++r) acc[r] = 0.f;
#pragma unroll
            for (int es = 0; es < 4; ++es) if (es < 2 * (ct + 1)) acc = MFMA32(*(const LAS bf16x8*)(X + r32 * 72 + 16 * es + 8 * hi), *(const LAS bf16x8*)(Tb + (32 * ct + r32) * 72 + 16 * es + 8 * hi), acc);
#pragma unroll
            for (int r = 0; r < 16; ++r) acc[r] = -acc[r];
#pragma unroll
            for (int s = 0; s < 2; ++s) *(u32x4*)(Wimg + ((((size_t)itemv * 8 + ct * 4 + kt) * 2 + s) * 512 + lane * 8)) = __builtin_bit_cast(u32x4, PACKS(acc, s)); }
        if ((hv & 1) == 0) {
#pragma unroll
            for (int ct = 0; ct < 2; ++ct)
#pragma unroll
                for (int s = 0; s < 2; ++s) { const LAS bf16_t* sp = X2 + r32 * 72 + 32 * ct + 16 * s + 4 * hi; const u32x2 lo = *(const LAS u32x2*)sp, hh = *(const LAS u32x2*)(sp + 8);
                    *(u32x4*)(KTimg + ((((size_t)itemk * 8 + kt * 2 + ct) * 2 + s) * 512 + lane * 8)) = (u32x4){lo.x, lo.y, hh.x, hh.y}; } }
        LDSW();
    }
}

DI f32x16 ld_img16(const bf16_t* p) { const u32x4 a = *(const u32x4*)p, b = *(const u32x4*)(p + 8); f32x16 v;
    v[0] = bflo(a.x); v[1] = bfhi(a.x); v[2] = bflo(a.y); v[3] = bfhi(a.y); v[4] = bflo(a.z); v[5] = bfhi(a.z); v[6] = bflo(a.w); v[7] = bfhi(a.w);
    v[8] = bflo(b.x); v[9] = bfhi(b.x); v[10] = bflo(b.y); v[11] = bfhi(b.y); v[12] = bflo(b.z); v[13] = bfhi(b.z); v[14] = bflo(b.w); v[15] = bfhi(b.w); return v; }
#define LDF(p) (((const bf16x8*)(p))[lane])
#define DNB_FENCE asm volatile("" ::: "memory")
#define LD_WQ(F, kt) do { F[0] = LDF(Wp + ((0 * 4 + (kt)) * 2 + 0) * 512); F[1] = LDF(Wp + ((0 * 4 + (kt)) * 2 + 1) * 512); F[2] = LDF(Wp + ((1 * 4 + (kt)) * 2 + 0) * 512); F[3] = LDF(Wp + ((1 * 4 + (kt)) * 2 + 1) * 512); \
                          F[4] = LDF(Qp + ((0 * 4 + (kt)) * 2 + 0) * 512); F[5] = LDF(Qp + ((0 * 4 + (kt)) * 2 + 1) * 512); F[6] = LDF(Qp + ((1 * 4 + (kt)) * 2 + 0) * 512); F[7] = LDF(Qp + ((1 * 4 + (kt)) * 2 + 1) * 512); } while (0)
#define CMP_WQ(F, kt) do { const bf16x8 sb0 = PACKS(S[kt], 0), sb1 = PACKS(S[kt], 1); \
        vn[0] = MFMA32(F[0], sb0, vn[0]); vn[1] = MFMA32(F[2], sb0, vn[1]); o[0] = MFMA32(F[4], sb0, o[0]); o[1] = MFMA32(F[6], sb0, o[1]); \
        vn[0] = MFMA32(F[1], sb1, vn[0]); vn[1] = MFMA32(F[3], sb1, vn[1]); o[0] = MFMA32(F[5], sb1, o[0]); o[1] = MFMA32(F[7], sb1, o[1]); } while (0)
#define LD_KT(F, kt0) do { _Pragma("unroll") for (int q_ = 0; q_ < 8; ++q_) F[q_] = LDF(Kp + ((kt0) * 4 + q_) * 512); } while (0)
#define CMP_KT(F, kt0) do { _Pragma("unroll") for (int k_ = 0; k_ < 2; ++k_) { _Pragma("unroll") for (int r_ = 0; r_ < 16; ++r_) S[(kt0) + k_][r_] *= egl; \
        S[(kt0) + k_] = MFMA32(F[4 * k_ + 0], d00, S[(kt0) + k_]); S[(kt0) + k_] = MFMA32(F[4 * k_ + 1], d01, S[(kt0) + k_]); \
        S[(kt0) + k_] = MFMA32(F[4 * k_ + 2], d10, S[(kt0) + k_]); S[(kt0) + k_] = MFMA32(F[4 * k_ + 3], d11, S[(kt0) + k_]); } } while (0)
#define DNB_SETPTR(nn) do { const size_t item_ = ((size_t)b * 32 + (nn)) * 32 + hv, itemk_ = ((size_t)b * 32 + (nn)) * 16 + hk; \
        Wp = Wimg + item_ * 8192; Qp = Qimg + itemk_ * 8192; Kp = KTimg + itemk_ * 8192; Ap = Aimg + item_ * 4096; \
        Up = Uimg + (item_ * 4 + vs) * 2048; Ep = EG + item_ * 64; Dp = DK + item_ * 64; row0 = (size_t)b * SEQ + (nn) * 64; } while (0)
#define LD_U() do { u0 = ((const u32x4*)Up)[2 * lane]; u1 = ((const u32x4*)Up)[2 * lane + 1]; u2 = ((const u32x4*)Up)[128 + 2 * lane]; u3 = ((const u32x4*)Up)[128 + 2 * lane + 1]; } while (0)
#define DNB_CHUNK(F, nn) do { \
        { const unsigned uu0[8] = {u0.x, u0.y, u0.z, u0.w, u1.x, u1.y, u1.z, u1.w}, uu1[8] = {u2.x, u2.y, u2.z, u2.w, u3.x, u3.y, u3.z, u3.w}; \
          _Pragma("unroll") for (int q_ = 0; q_ < 8; ++q_) { vn[0][2 * q_] = bflo(uu0[q_]); vn[0][2 * q_ + 1] = bfhi(uu0[q_]); vn[1][2 * q_] = bflo(uu1[q_]); vn[1][2 * q_ + 1] = bfhi(uu1[q_]); } } \
        _Pragma("unroll") for (int ct = 0; ct < 2; ++ct) _Pragma("unroll") for (int r = 0; r < 16; ++r) o[ct][r] = 0.f; \
        CMP_WQ(F, 0); DNB_FENCE; LD_WQ(F, 1); DNB_FENCE; \
        CMP_WQ(F, 1); DNB_FENCE; LD_WQ(F, 2); DNB_FENCE; \
        CMP_WQ(F, 2); DNB_FENCE; LD_WQ(F, 3); DNB_FENCE; \
        CMP_WQ(F, 3); DNB_FENCE; \
        _Pragma("unroll") for (int q_ = 0; q_ < 2; ++q_) { F[q_] = LDF(Ap + ((0 * 2 + 0) * 2 + q_) * 512); F[2 + q_] = LDF(Ap + ((1 * 2 + 0) * 2 + q_) * 512); F[4 + q_] = LDF(Ap + ((1 * 2 + 1) * 2 + q_) * 512); } \
        float egl; \
        { f32x4 eg[2][4]; _Pragma("unroll") for (int ct = 0; ct < 2; ++ct) _Pragma("unroll") for (int q_ = 0; q_ < 4; ++q_) eg[ct][q_] = ((const f32x4*)Ep)[ct * 8 + hi * 4 + q_]; \
          DNB_FENCE; \
          _Pragma("unroll") for (int ct = 0; ct < 2; ++ct) _Pragma("unroll") for (int r = 0; r < 16; ++r) o[ct][r] *= eg[ct][r >> 2][r & 3]; \
          egl = __shfl(eg[1][3][3], 63); } \
        { const bf16x8 v00 = PACKS(vn[0], 0), v01 = PACKS(vn[0], 1), v10 = PACKS(vn[1], 0), v11 = PACKS(vn[1], 1); \
          o[0] = MFMA32(F[0], v00, o[0]); o[1] = MFMA32(F[2], v00, o[1]); o[0] = MFMA32(F[1], v01, o[0]); o[1] = MFMA32(F[3], v01, o[1]); o[1] = MFMA32(F[4], v10, o[1]); o[1] = MFMA32(F[5], v11, o[1]); } \
        DNB_FENCE; LD_KT(F, 0); \
        { f32x4 dk[2][4]; _Pragma("unroll") for (int ct = 0; ct < 2; ++ct) _Pragma("unroll") for (int q_ = 0; q_ < 4; ++q_) dk[ct][q_] = ((const f32x4*)Dp)[ct * 8 + hi * 4 + q_]; \
          DNB_FENCE; \
          { bf16_t* op_ = OG + (row0 + 4 * hi) * 4096 + hv * 128 + 32 * vs + r32; \
            _Pragma("unroll") for (int ct = 0; ct < 2; ++ct) _Pragma("unroll") for (int g_ = 0; g_ < 4; ++g_) { \
              _Pragma("unroll") for (int i_ = 0; i_ < 4; ++i_) { *op_ = f2bf(o[ct][4 * g_ + i_]); op_ += 4096; asm volatile("" : "+v"(op_)); } \
              op_ += 4 * 4096; asm volatile("" : "+v"(op_)); } } \
          _Pragma("unroll") for (int ct = 0; ct < 2; ++ct) _Pragma("unroll") for (int r = 0; r < 16; ++r) vn[ct][r] *= dk[ct][r >> 2][r & 3]; } \
        { const bf16x8 d00 = PACKS(vn[0], 0), d01 = PACKS(vn[0], 1), d10 = PACKS(vn[1], 0), d11 = PACKS(vn[1], 1); \
          CMP_KT(F, 0); DNB_FENCE; LD_KT(F, 2); DNB_FENCE; CMP_KT(F, 2); DNB_FENCE; } \
        if ((nn) + 1 < 32) { DNB_SETPTR((nn) + 1); LD_WQ(F, 0); LD_U(); } DNB_FENCE; \
    } while (0)
DI void dnb_wave(const bf16_t* Wimg, const bf16_t* Uimg, const bf16_t* Aimg, const bf16_t* Qimg, const bf16_t* KTimg, const float* EG, const float* DK, bf16_t* OG, int bhv, int vs, int lane) {
    const int b = bhv >> 5, hv = bhv & 31, hk = hv >> 1, r32 = lane & 31, hi = lane >> 5;
    f32x16 S[4], vn[2], o[2];
#pragma unroll
    for (int kt = 0; kt < 4; ++kt)
#pragma unroll
        for (int r = 0; r < 16; ++r) S[kt][r] = 0.f;
    const bf16_t *Wp, *Qp, *Kp, *Ap, *Up; const float *Ep, *Dp; size_t row0;
    bf16x8 F[8]; u32x4 u0, u1, u2, u3;
    DNB_SETPTR(0); LD_WQ(F, 0); LD_U();
    for (int n = 0; n < 32; ++n) { DNB_CHUNK(F, n); }
}

DI void dnc_phase(bf16_t* OG, const bf16_t* Z, const float* norm_g, int wave, int lane) {
    const int gw = blockIdx.x * NWAVES + wave, ngw = gridDim.x * NWAVES;
    const int sub = lane >> 4, c8 = (lane & 15) * 8;
    float g[8];
    { const f32x4 a = *(const f32x4*)(norm_g + c8), c = *(const f32x4*)(norm_g + c8 + 4); g[0] = a.x; g[1] = a.y; g[2] = a.z; g[3] = a.w; g[4] = c.x; g[5] = c.y; g[6] = c.z; g[7] = c.w; }
    for (int it = gw; it < M * 32 / 16; it += ngw) {
        u32x4 ro[4], rz[4];
#pragma unroll
        for (int k = 0; k < 4; ++k) { const size_t off = ((size_t)it * 16 + k * 4 + sub) * 128 + c8; ro[k] = *(const u32x4*)(OG + off); rz[k] = *(const u32x4*)(Z + off); }
#pragma unroll
        for (int k = 0; k < 4; ++k) { const size_t off = ((size_t)it * 16 + k * 4 + sub) * 128 + c8;
            float o[8], z[8]; unpack8(ro[k], o); unpack8(rz[k], z);
            float ss = 0.f;
#pragma unroll
            for (int i = 0; i < 8; ++i) ss += o[i] * o[i];
            const float sc = rsqrtf(sum16(ss) * (1.f / 128.f) + RMS_EPS);
#pragma unroll
            for (int i = 0; i < 8; ++i) o[i] = o[i] * sc * g[i] * pg8::silu_f(z[i]);
            u32x4 w; w.x = pk2(o[0], o[1]); w.y = pk2(o[2], o[3]); w.z = pk2(o[4], o[5]); w.w = pk2(o[6], o[7]);
            *(u32x4*)(OG + off) = w; }
    }
}

#define XB_TMO      128
#define XB_XCNT(j)  (256  + 64 * (j))
#define XB_XSUB(j)  (1280 + 64 * (j))
#define XB_XGEN(j)  (2304 + 64 * (j))
#define XB_TOP      3328
#define XB_TOPGEN   3392
#define XCD_BAR_WORDS 3456
#define XB_SPIN_CAP (1u << 18)

__device__ __forceinline__ unsigned xb_ld(unsigned* p)              { return __hip_atomic_load(p, __ATOMIC_RELAXED, __HIP_MEMORY_SCOPE_AGENT); }
__device__ __forceinline__ unsigned xb_add(unsigned* p, unsigned v) { return __hip_atomic_fetch_add(p, v, __ATOMIC_RELAXED, __HIP_MEMORY_SCOPE_AGENT); }
__device__ __forceinline__ unsigned xb_xcc_id() { return (unsigned)__builtin_amdgcn_s_getreg((3 << 11) | 20) & 0xFu; }
#define XB_SPIN(cond, bar) do { unsigned _sp = 0; while (cond) { __builtin_amdgcn_s_sleep(1); \
    if ((++_sp & 255u) == 0u) { if (xb_ld(&(bar)[XB_TMO])) break; if (_sp > XB_SPIN_CAP) { atomicAdd(&(bar)[XB_TMO], 1u); break; } } } } while (0)

struct XcdBarrier {
    unsigned* bar; unsigned x;
    volatile LAS unsigned* st;
};

__device__ __forceinline__ XcdBarrier xcd_barrier_post(unsigned* bar, volatile LAS unsigned* st) {
    XcdBarrier b; b.bar = bar; b.x = xb_xcc_id(); b.st = st;
    if (threadIdx.x == 0) (void)xb_add(&bar[XB_XCNT(b.x)], 1u);
    return b;
}
__device__ __forceinline__ void xcd_barrier_complete(unsigned* bar, unsigned x, unsigned& nloc, unsigned& nx) {
    const unsigned G = gridDim.x * gridDim.y * gridDim.z;
    unsigned sum, cnt, mine, sp = 0u;
    for (;;) {
        sum = 0u; cnt = 0u; mine = 0u;
#pragma unroll
        for (unsigned j = 0; j < 16; ++j) { const unsigned c = xb_ld(&bar[XB_XCNT(j)]); sum += c; cnt += (c > 0u) ? 1u : 0u; mine = (j == x) ? c : mine; }
        if (sum == G) break;
        __builtin_amdgcn_s_sleep(1);
        if ((++sp & 255u) == 0u) { if (xb_ld(&bar[XB_TMO])) break; if (sp > XB_SPIN_CAP) { atomicAdd(&bar[XB_TMO], 1u); break; } }
    }
    nloc = mine > 0u ? mine : 1u; nx = cnt > 0u ? cnt : 1u;
}

__device__ __forceinline__ void xcd_barrier(const XcdBarrier& b) {
    asm volatile("s_waitcnt vmcnt(0)" ::: "memory");
    __syncthreads();
    if (threadIdx.x == 0) {
        unsigned* bar = b.bar;
        __builtin_amdgcn_s_waitcnt(0);
        unsigned nloc = b.st[0], nx = b.st[1];
        if (nloc == 0u) { xcd_barrier_complete(bar, b.x, nloc, nx); b.st[0] = nloc; b.st[1] = nx; }
        const unsigned old = xb_add(&bar[XB_XSUB(b.x)], 1u);
        const unsigned gen = old / nloc;
        if (old + 1u == (gen + 1u) * nloc) {
            __builtin_amdgcn_fence(__ATOMIC_RELEASE, "agent");
            asm volatile("s_waitcnt vmcnt(0)" ::: "memory");
            const unsigned og = xb_add(&bar[XB_TOP], 1u);
            const unsigned tg = og / nx;
            if (og + 1u == (tg + 1u) * nx) xb_add(&bar[XB_TOPGEN], 1u);
            else XB_SPIN(xb_ld(&bar[XB_TOPGEN]) == tg, bar);
            __builtin_amdgcn_fence(__ATOMIC_ACQUIRE, "agent");
            xb_add(&bar[XB_XGEN(b.x)], 1u);
            asm volatile("s_waitcnt vmcnt(0)" ::: "memory");
        } else {
            XB_SPIN(xb_ld(&bar[XB_XGEN(b.x)]) == gen, bar);
            __builtin_amdgcn_fence(__ATOMIC_ACQUIRE, "agent");
            asm volatile("s_waitcnt vmcnt(0)" ::: "memory");
        }
    }
    __syncthreads();
}

constexpr int N_PHASES = 25;
DI void gemm_swiglu(LAS unsigned char* lds, const bf16_t* A, const bf16_t* Wt, bf16_t* H) {
    pg8::Gemm g{A, Wt, M, 2 * DFF, D}; pg8::StaticOrder S; S.init(M, 2 * DFF, (int)gridDim.x, (int)blockIdx.x);
    pg8::EpiSwiGLU E{H, DFF};
    pg8::gemm_phase<pg8::EpiSwiGLU, pg8::StaticOrder, true, true>(lds, g, S, E);
}
DI void gemm_resid(LAS unsigned char* lds, const bf16_t* A, const bf16_t* Wt, int K, const float* resid, float* out, float scale) {
    pg8::Gemm g{A, Wt, M, D, K}; pg8::StaticOrder S; S.init(M, D, (int)gridDim.x, (int)blockIdx.x);
    pg8::EpiResid E{resid, out, D, ALPHA, scale};
    pg8::gemm_phase<pg8::EpiResid, pg8::StaticOrder, true, true>(lds, g, S, E);
}
__global__ void __launch_bounds__(NTHREADS, 2) fwd_kernel(Args args) {
    extern __shared__ __attribute__((aligned(16))) unsigned char lds_raw[];
    LAS unsigned char* lds = (LAS unsigned char*)lds_raw;
    cg::grid_group grid = cg::this_grid();
    const int tid = threadIdx.x, lane = tid & 63, wave = __builtin_amdgcn_readfirstlane(tid >> 6);
    typedef const Args __attribute__((address_space(4)))* KArgP;
    KArgP ap = (KArgP)__builtin_amdgcn_kernarg_segment_ptr();
    const int lo = args.ph_lo, hi = args.ph_hi;
    { volatile LAS unsigned* st = (volatile LAS unsigned*)(lds + LDS_BYTES - 16); if (tid < 2) st[tid] = 0u; }
    __syncthreads();
    const XcdBarrier xbar = xcd_barrier_post((unsigned*)(args.ws + WS_BAR), (volatile LAS unsigned*)(lds + LDS_BYTES - 16));
#define PHASE(k) if (lo <= (k) && (k) < hi && ((k) == lo || (((k) == lo + 1) ? (grid.sync(), true) : (xcd_barrier(xbar), true))))
#define ARGS_RELOAD() asm volatile("" : "+s"(ap)); unsigned char* const ws = ap->ws
#define WSP(T, off) ((T*)(ws + (off)))
    PHASE(0) { ARGS_RELOAD(); p0_prologue(args, lds, wave, lane); }
    PHASE(1) { ARGS_RELOAD(); gemm_swiglu(lds, WSP(bf16_t, WS_XB), WSP(bf16_t, WS_WGU1_0), WSP(bf16_t, WS_BIG)); }
    PHASE(2) { ARGS_RELOAD(); gemm_resid(lds, WSP(bf16_t, WS_BIG), WSP(bf16_t, WS_WD1_0), DFF, ap->in[0], ap->out, 0.5f); }
    PHASE(3) { ARGS_RELOAD(); ln_phase(ap->out, WSP(bf16_t, WS_XB), ap->in[7] + 0 * D, ap->in[8] + 0 * D, wave, lane); }
    PHASE(4) { ARGS_RELOAD(); pg8::Gemm g{WSP(bf16_t, WS_XB), WSP(bf16_t, WS_WABIN), M, AB_IN, D}; pg8::StaticOrder S; S.init(M, AB_IN, (int)gridDim.x, (int)blockIdx.x);
        pg8::EpiPlain E{WSP(bf16_t, WS_BIG), AB_IN};
        pg8::gemm_phase<pg8::EpiPlain, pg8::StaticOrder, true, true>(lds, g, S, E); }
    PHASE(5) { ARGS_RELOAD();
        for (int it = blockIdx.x; it < 256; it += gridDim.x)
            rope_item(WSP(bf16_t, WS_BIG), WSP(bf16_t, WS_QR), WSP(bf16_t, WS_KR), WSP(bf16_t, WS_VT), WSP(float, WS_KMEAN), it, (LAS float*)lds, tid);
        for (int it = blockIdx.x; it < 512; it += gridDim.x)
            gmlp_item(WSP(bf16_t, WS_BIG), ap->in[10], ap->in[11], ap->in[12], ap->in[13], WSP(bf16_t, WS_CAT), it, lds, wave, lane);
    }
    PHASE(6) { ARGS_RELOAD();
        for (int wg = blockIdx.x; wg < 256; wg += gridDim.x) { const int bh = wg >> 3, sub = wg & 7;
            moba_wave(WSP(bf16_t, WS_QR), WSP(bf16_t, WS_KR), WSP(bf16_t, WS_VT), WSP(float, WS_KMEAN), WSP(bf16_t, WS_CAT), bh, wave * 8 + sub, lane); }
    }
    PHASE(7) { ARGS_RELOAD(); gemm_resid(lds, WSP(bf16_t, WS_CAT), WSP(bf16_t, WS_WABOUT), D, ap->out, ap->out, 1.0f); }
    PHASE(8) { ARGS_RELOAD(); ln_phase(ap->out, WSP(bf16_t, WS_XB), ap->in[7] + 1 * D, ap->in[8] + 1 * D, wave, lane); }
    PHASE(9) { ARGS_RELOAD(); gemm_swiglu(lds, WSP(bf16_t, WS_XB), WSP(bf16_t, WS_WGU2_0), WSP(bf16_t, WS_BIG)); }
    PHASE(10) { ARGS_RELOAD(); gemm_resid(lds, WSP(bf16_t, WS_BIG), WSP(bf16_t, WS_WD2_0), DFF, ap->out, ap->out, 0.5f); }
    PHASE(11) { ARGS_RELOAD(); ln_phase(ap->out, WSP(bf16_t, WS_XB), ap->in[7] + 2 * D, ap->in[8] + 2 * D, wave, lane); }
    PHASE(12) { ARGS_RELOAD(); gemm_swiglu(lds, WSP(bf16_t, WS_XB), WSP(bf16_t, WS_WGU1_1), WSP(bf16_t, WS_BIG)); }
    PHASE(13) { ARGS_RELOAD(); gemm_resid(lds, WSP(bf16_t, WS_BIG), WSP(bf16_t, WS_WD1_1), DFF, ap->out, ap->out, 0.5f); }
    PHASE(14) { ARGS_RELOAD(); ln_phase(ap->out, WSP(bf16_t, WS_XB), ap->in[7] + 3 * D, ap->in[8] + 3 * D, wave, lane); }
    PHASE(15) { ARGS_RELOAD(); pg8::Gemm g{WSP(bf16_t, WS_XB), WSP(bf16_t, WS_WDNIN), M, DN_IN_PAD, D}; pg8::StaticOrder S; S.init(M, DN_IN_PAD, (int)gridDim.x, (int)blockIdx.x);
        pg8::EpiDnIn E{WSP(bf16_t, WS_BIG), WSP(float, WS_BA)};
        pg8::gemm_phase<pg8::EpiDnIn, pg8::StaticOrder, true, true>(lds, g, S, E); }
    PHASE(16) { ARGS_RELOAD(); dnp_phase(WSP(bf16_t, WS_BIG), WSP(bf16_t, WS_BIG) + (size_t)M * 4096, WSP(float, WS_BA), ap->in[16], ap->in[17], ap->in[18],
                          WSP(bf16_t, WS_QN), WSP(bf16_t, WS_KN), WSP(bf16_t, WS_V), WSP(float, WS_G), WSP(float, WS_BETA), wave, lane); }
    PHASE(17) { ARGS_RELOAD();
        for (int it = blockIdx.x * NWAVES + wave; it < 4096; it += gridDim.x * NWAVES)
            dna_wave(WSP(bf16_t, WS_QN), WSP(bf16_t, WS_KN), WSP(bf16_t, WS_V), WSP(float, WS_G), WSP(float, WS_BETA),
                     WSP(bf16_t, WS_WIMG), WSP(bf16_t, WS_UIMG), WSP(bf16_t, WS_AIMG), WSP(bf16_t, WS_QIMG), WSP(bf16_t, WS_KTIMG), WSP(float, WS_GC), WSP(float, WS_GC + MiB), it, lds + wave * DW_STRIDE, lane);
    }
    PHASE(18) { ARGS_RELOAD();
        if (wave < 4) for (int it = blockIdx.x; it < 128; it += gridDim.x)
            dnb_wave(WSP(bf16_t, WS_WIMG), WSP(bf16_t, WS_UIMG), WSP(bf16_t, WS_AIMG), WSP(bf16_t, WS_QIMG), WSP(bf16_t, WS_KTIMG), WSP(float, WS_GC), WSP(float, WS_GC + MiB), WSP(bf16_t, WS_OG), it, wave, lane);
    }
    PHASE(19) { ARGS_RELOAD(); dnc_phase(WSP(bf16_t, WS_OG), WSP(bf16_t, WS_BIG) + (size_t)2 * M * 4096, ap->in[19], wave, lane); }
    PHASE(20) { ARGS_RELOAD(); gemm_resid(lds, WSP(bf16_t, WS_OG), WSP(bf16_t, WS_WDNOUT), 4096, ap->out, ap->out, 1.0f); }
    PHASE(21) { ARGS_RELOAD(); ln_phase(ap->out, WSP(bf16_t, WS_XB), ap->in[7] + 4 * D, ap->in[8] + 4 * D, wave, lane); }
    PHASE(22) { ARGS_RELOAD(); gemm_swiglu(lds, WSP(bf16_t, WS_XB), WSP(bf16_t, WS_WGU2_1), WSP(bf16_t, WS_BIG)); }
    PHASE(23) { ARGS_RELOAD(); gemm_resid(lds, WSP(bf16_t, WS_BIG), WSP(bf16_t, WS_WD2_1), DFF, ap->out, ap->out, 0.5f); }
    PHASE(24) { ARGS_RELOAD(); ln_phase(ap->out, WSP(bf16_t, WS_XB), ap->in[7] + 5 * D, ap->in[8] + 5 * D, wave, lane); }
}

extern "C" void kernel_launch(void* const* d_in, const int* in_sizes, int n_in, void* d_out, int out_size, void* d_ws, size_t ws_size, hipStream_t stream) {
    static int grid = 0;
    if (grid == 0) {
        if (n_in != 21 || out_size != M * D || ws_size < WS_END) { fprintf(stderr, "kernel_launch: unexpected shapes (n_in %d out %d ws %zu)\n", n_in, out_size, ws_size); grid = -1; return; }
        int dev = 0, cus = 0, per_cu = 0;
        (void)hipGetDevice(&dev); (void)hipDeviceGetAttribute(&cus, hipDeviceAttributeMultiprocessorCount, dev);
        (void)hipFuncSetAttribute((const void*)fwd_kernel, hipFuncAttributeMaxDynamicSharedMemorySize, LDS_BYTES);
        (void)hipOccupancyMaxActiveBlocksPerMultiprocessor(&per_cu, (const void*)fwd_kernel, NTHREADS, LDS_BYTES);
        if (per_cu < 1) { fprintf(stderr, "kernel_launch: occupancy query says %d blocks/CU\n", per_cu); per_cu = 1; }
        (void)hipGetLastError();
        grid = cus;
    }
    if (grid < 0) return;
    Args a{};
    for (int i = 0; i < 21; ++i) a.in[i] = (const float*)d_in[i];
    a.out = (float*)d_out; a.ws = (unsigned char*)d_ws; a.ph_lo = 0; a.ph_hi = N_PHASES;
    (void)hipMemsetAsync((char*)d_ws + WS_BAR, 0, BAR_BYTES, stream);
    void* kargs[] = {&a};
    hipError_t e = hipLaunchCooperativeKernel((const void*)fwd_kernel, dim3(grid), dim3(NTHREADS), kargs, LDS_BYTES, stream);
    if (e != hipSuccess) fprintf(stderr, "kernel_launch: cooperative launch failed: %s (grid %d)\n", hipGetErrorString(e), grid);
}
```

```cpp
#include <hip/hip_runtime.h>
#include <hip/hip_cooperative_groups.h>
#include <cstdio>
#include <cstdint>
namespace cg = cooperative_groups;
namespace pg8 {
#define PG8_LAS __attribute__((address_space(3)))
typedef unsigned short bf16_t;
typedef short bf16x8 __attribute__((ext_vector_type(8)));
typedef float f32x4 __attribute__((ext_vector_type(4)));
typedef unsigned u32x4 __attribute__((ext_vector_type(4)));
constexpr int BM = 256, BK = 64, HALF = 128, HTB = HALF * BK * 2  , STAGE_BYTES = 8 * HTB, NXCD = 8, WGM = 8;

__host__ __device__ __forceinline__ int lds_byte(int r, int c) { const int st = (r >> 4) * 2 + (c >> 5), rr = r & 15, cc = c & 31, ob = rr * 64 + cc * 2; return st * 1024 + (ob ^ (((ob >> 9) & 1) << 5)); }
__host__ __device__ __forceinline__ void stage_rc(int b, int& R, int& C) { const int st = b / 1024, sb = b % 1024, swz = sb ^ (((sb >> 9) & 1) << 5); R = (st >> 1) * 16 + swz / 64; C = (st & 1) * 32 + (swz % 64) / 2; }
__host__ __device__ __forceinline__ int perm32(int rho) { const int n = rho >> 4, i = rho & 15; return 8 * (i >> 2) + 4 * n + (i & 3); }

struct Unit { int pm, pn; };
struct Gemm { const bf16_t* A; const bf16_t* Bt; int M, N, K; };

struct StaticOrder {
    int nM, nN, nwg, G, c;
    __host__ __device__ void init(int M, int N, int G_, int c_) { nM = M / BM; nN = N / BM; nwg = nM * nN; G = G_; c = c_; }
    __host__ __device__ bool next(int i, Unit& u) const {
        const long L = (long)i * G + c; if (L >= nwg) return false;
        int wgid = (int)L; { const int q = nwg / NXCD, r = nwg % NXCD, xcd = wgid % NXCD, off = wgid / NXCD; wgid = (xcd < r ? xcd * (q + 1) : r * (q + 1) + (xcd - r) * q) + off; }
        const int nig = WGM * nN, gid = wgid / nig, fm = gid * WGM, gsz = (nM - fm) < WGM ? (nM - fm) : WGM;
        u.pm = fm + ((wgid % nig) % gsz); u.pn = (wgid % nig) / gsz; return true;
    }
    __device__ __forceinline__ void a_ready(const Unit&) const {}
    __device__ __forceinline__ void done(const Unit&) const {}
};

__device__ __forceinline__ unsigned cvt_pk_bf16(float lo, float hi) { unsigned r; asm volatile("v_cvt_pk_bf16_f32 %0, %1, %2" : "=v"(r) : "v"(lo), "v"(hi)); return r; }
typedef float f32x2 __attribute__((ext_vector_type(2)));
typedef __bf16 bf16x2_t __attribute__((ext_vector_type(2)));
__device__ __forceinline__ unsigned pk2(float lo, float hi) { f32x2 v = {lo, hi}; bf16x2_t b = __builtin_convertvector(v, bf16x2_t); return __builtin_bit_cast(unsigned, b); }
__device__ __forceinline__ float silu_f(float g) { return g * __builtin_amdgcn_rcpf(1.0f + __expf(-g)); }

struct EpiPlain {
    static constexpr bool PERM = true, AFTER_DRAIN = false;
    bf16_t* O; int ldc;
    __device__ __forceinline__ void operator()(const f32x4 (&acc)[2][2][4][2], const Unit& u, int wr, int wc, int fr, int fq) const {
        const int row0 = u.pm * BM + wr * 64 + fr, col0 = u.pn * BM + wc * 32 + 8 * fq;
#pragma unroll
        for (int ai = 0; ai < 2; ++ai)
#pragma unroll
            for (int m = 0; m < 4; ++m) { bf16_t* rowp = O + (size_t)(row0 + ai * HALF + m * 16) * ldc + col0;
#pragma unroll
                for (int bj = 0; bj < 2; ++bj) { const f32x4 v0 = acc[ai][bj][m][0], v1 = acc[ai][bj][m][1];
                    u32x4 w; w.x = pk2(v0[0], v0[1]); w.y = pk2(v0[2], v0[3]); w.z = pk2(v1[0], v1[1]); w.w = pk2(v1[2], v1[3]);
                    *(u32x4*)(rowp + bj * HALF) = w; } }
    }
};
struct EpiDnIn {
    static constexpr bool PERM = true, AFTER_DRAIN = false;
    bf16_t* O; float* BA;
    __device__ __forceinline__ void operator()(const f32x4 (&acc)[2][2][4][2], const Unit& u, int wr, int wc, int fr, int fq) const {
        const int row0 = u.pm * BM + wr * 64 + fr;
        if (u.pn < 48) {
            bf16_t* base = O + (size_t)(u.pn >> 4) * ((size_t)8192 * 4096);
            const int col0 = (u.pn & 15) * BM + wc * 32 + 8 * fq;
#pragma unroll
            for (int ai = 0; ai < 2; ++ai)
#pragma unroll
                for (int m = 0; m < 4; ++m) { bf16_t* rowp = base + (size_t)(row0 + ai * HALF + m * 16) * 4096 + col0;
#pragma unroll
                    for (int bj = 0; bj < 2; ++bj) { const f32x4 v0 = acc[ai][bj][m][0], v1 = acc[ai][bj][m][1];
                        u32x4 w; w.x = pk2(v0[0], v0[1]); w.y = pk2(v0[2], v0[3]); w.z = pk2(v1[0], v1[1]); w.w = pk2(v1[2], v1[3]);
                        *(u32x4*)(rowp + bj * HALF) = w; } }
        } else if (wc < 2) {
            const int col0 = wc * 32 + 8 * fq;
#pragma unroll
            for (int ai = 0; ai < 2; ++ai)
#pragma unroll
                for (int m = 0; m < 4; ++m) { float* rowp = BA + (size_t)(row0 + ai * HALF + m * 16) * 64 + col0;
                    *(f32x4*)(rowp) = acc[ai][0][m][0]; *(f32x4*)(rowp + 4) = acc[ai][0][m][1]; }
        }
    }
};
struct EpiSwiGLU {
    static constexpr bool PERM = true, AFTER_DRAIN = false;
    bf16_t* O; int ldc;
    __device__ __forceinline__ void operator()(const f32x4 (&acc)[2][2][4][2], const Unit& u, int wr, int wc, int fr, int fq) const {
        const int row0 = u.pm * BM + wr * 64 + fr, col0 = u.pn * HALF + wc * 32 + 8 * fq;
#pragma unroll
        for (int ai = 0; ai < 2; ++ai)
#pragma unroll
            for (int m = 0; m < 4; ++m) { bf16_t* rowp = O + (size_t)(row0 + ai * HALF + m * 16) * ldc + col0;
                const f32x4 g0 = acc[ai][0][m][0], g1 = acc[ai][0][m][1], u0 = acc[ai][1][m][0], u1 = acc[ai][1][m][1];
                u32x4 w;
                w.x = pk2(silu_f(g0[0]) * u0[0], silu_f(g0[1]) * u0[1]); w.y = pk2(silu_f(g0[2]) * u0[2], silu_f(g0[3]) * u0[3]);
                w.z = pk2(silu_f(g1[0]) * u1[0], silu_f(g1[1]) * u1[1]); w.w = pk2(silu_f(g1[2]) * u1[2], silu_f(g1[3]) * u1[3]);
                *(u32x4*)(rowp) = w; }
    }
};
struct EpiResid {
    static constexpr bool PERM = false, AFTER_DRAIN = false;
    const float* resid; float* out; int ldc; float alpha, scale;
    __device__ __forceinline__ void operator()(const f32x4 (&acc)[2][2][4][2], const Unit& u, int wr, int wc, int fr, int fq) const {
        const int col0 = u.pn * BM + wc * 32 + 4 * fq;
#pragma unroll
        for (int ai = 0; ai < 2; ++ai)
#pragma unroll
            for (int m = 0; m < 4; ++m) { const size_t off = (size_t)(u.pm * BM + ai * HALF + wr * 64 + m * 16 + fr) * ldc + col0;
                f32x4 rv[2][2];
#pragma unroll
                for (int bj = 0; bj < 2; ++bj)
#pragma unroll
                    for (int n = 0; n < 2; ++n) rv[bj][n] = *(const f32x4*)(resid + off + bj * HALF + n * 16);
#pragma unroll
                for (int bj = 0; bj < 2; ++bj)
#pragma unroll
                    for (int n = 0; n < 2; ++n) *(f32x4*)(out + off + bj * HALF + n * 16) = rv[bj][n] * alpha + acc[ai][bj][m][n] * scale;
                asm volatile("" ::: "memory"); }
    }
};
template <class Epi, class Sched, bool ALIGN_EPI = false, bool SP2 = false>
__device__ __forceinline__ void gemm_phase(PG8_LAS unsigned char* lds, const Gemm g, const Sched& S, const Epi& E) {
    const int tid = threadIdx.x, wid = __builtin_amdgcn_readfirstlane(tid >> 6), lane = tid & 63, wr = wid >> 2, wc = wid & 3, fr = lane & 15, fq = lane >> 4;
    const int K = g.K, nt = K / BK;
    unsigned voffA[2], voffB[2];
#pragma unroll
    for (int i = 0; i < 2; ++i) { int R, C; stage_rc(tid * 16 + i * 8192, R, C); const int Rb = Epi::PERM ? ((R & ~31) + perm32(R & 31)) : R;
        voffA[i] = (unsigned)(R * K + C) * 2u; voffB[i] = (unsigned)(Rb * K + C) * 2u; }
    const size_t kstep = (size_t)(BK * 2);
    const size_t hstep = (size_t)HALF * K * 2;
    const size_t tstep = 2 * hstep;
    const unsigned ldsw = (unsigned)wid * 1024u;
    const int aoff = lds_byte(wr * 64 + fr, fq * 8), boff = lds_byte(wc * 32 + fr, fq * 8);
#define PG8_SA(b, h) (((b) * 2 + (h)) * HTB)
#define PG8_SB(b, h) ((4 + (b) * 2 + (h)) * HTB)
#define PG8_STAGE(bufoff, gbase, voff) do { _Pragma("unroll") for (int _i = 0; _i < 2; ++_i) \
        __builtin_amdgcn_global_load_lds((const unsigned*)((const char*)(gbase) + (voff)[_i]), (PG8_LAS unsigned*)(lds + (bufoff) + ldsw + _i * 8192), 16, 0, 0); } while (0)
#define PG8_LDA(dst, b, h) do { _Pragma("unroll") for (int m = 0; m < 4; ++m) _Pragma("unroll") for (int k = 0; k < 2; ++k) dst[m][k] = *(const PG8_LAS bf16x8*)(lds + PG8_SA(b, h) + aoff + m * 2048 + k * 1024); } while (0)
#define PG8_LDB(dst, b, h) do { _Pragma("unroll") for (int n = 0; n < 2; ++n) _Pragma("unroll") for (int k = 0; k < 2; ++k) dst[n][k] = *(const PG8_LAS bf16x8*)(lds + PG8_SB(b, h) + boff + n * 2048 + k * 1024); } while (0)
#define PG8_MMA(ai, bj, At, Bt) do { __builtin_amdgcn_s_setprio(1); _Pragma("unroll") for (int m = 0; m < 4; ++m) _Pragma("unroll") for (int n = 0; n < 2; ++n) _Pragma("unroll") for (int k = 0; k < 2; ++k) \
        acc[ai][bj][m][n] = __builtin_amdgcn_mfma_f32_16x16x32_bf16(Bt[n][k], At[m][k], acc[ai][bj][m][n], 0, 0, 0); __builtin_amdgcn_s_setprio(0); } while (0)
#define PG8_WAIT_V(n) asm volatile("s_waitcnt vmcnt(" #n ")" ::: "memory")
#define PG8_WAIT_L(n) asm volatile("s_waitcnt lgkmcnt(" #n ")" ::: "memory")
#define PG8_BAR __builtin_amdgcn_s_barrier()
#define PG8_SCHED __builtin_amdgcn_sched_barrier(0)
    Unit cur, nxt; int ui = 0;
    if (!S.next(0, cur)) return;
    f32x4 acc[2][2][4][2];
#pragma unroll
    for (int a = 0; a < 2; ++a)
#pragma unroll
        for (int b = 0; b < 2; ++b)
#pragma unroll
            for (int m = 0; m < 4; ++m)
#pragma unroll
                for (int n = 0; n < 2; ++n) acc[a][b][m][n] = (f32x4){0.f, 0.f, 0.f, 0.f};
    bf16x8 At[4][2], B0[2][2], B1[2][2];
    const char* cA = (const char*)g.A + (size_t)cur.pm * tstep; const char* cB = (const char*)g.Bt + (size_t)cur.pn * tstep;
    S.a_ready(cur);
    if constexpr (SP2) {
        PG8_STAGE(PG8_SB(0, 0), cB, voffB); PG8_STAGE(PG8_SB(0, 1), cB + hstep, voffB); PG8_STAGE(PG8_SA(0, 0), cA, voffA); PG8_STAGE(PG8_SA(0, 1), cA + hstep, voffA);
        if (wr == 1) PG8_BAR;
        PG8_WAIT_V(2); PG8_BAR;
        PG8_STAGE(PG8_SB(1, 0), cB + kstep, voffB); PG8_STAGE(PG8_SA(1, 0), cA + kstep, voffA); PG8_STAGE(PG8_SB(1, 1), cB + hstep + kstep, voffB);
        PG8_WAIT_V(6); PG8_BAR;
    } else {
        PG8_STAGE(PG8_SB(0, 0), cB, voffB); PG8_STAGE(PG8_SA(0, 0), cA, voffA); PG8_STAGE(PG8_SB(0, 1), cB + hstep, voffB); PG8_STAGE(PG8_SA(0, 1), cA + hstep, voffA);
        if (wr == 1) PG8_BAR;
        PG8_WAIT_V(4); PG8_BAR;
        PG8_STAGE(PG8_SB(1, 0), cB + kstep, voffB); PG8_STAGE(PG8_SA(1, 0), cA + kstep, voffA); PG8_STAGE(PG8_SB(1, 1), cB + hstep + kstep, voffB);
        PG8_WAIT_V(6); PG8_BAR;
    }
    for (;;) {
        const bool has_next = S.next(ui + 1, nxt);
        const char* nA = has_next ? (const char*)g.A + (size_t)nxt.pm * tstep : cA; const char* nB = has_next ? (const char*)g.Bt + (size_t)nxt.pn * tstep : cB;
        for (int t = 0; t < nt; t += 2) {
            const bool last = (t == nt - 2);
            const char* a1 = cA + (size_t)(t + 1) * kstep;
            const char* a2 = last ? nA : cA + (size_t)(t + 2) * kstep; const char* b2 = last ? nB : cB + (size_t)(t + 2) * kstep;
            const char* a3 = a2 + kstep; const char* b3 = b2 + kstep;
            if (last && has_next) S.a_ready(nxt);
            if constexpr (SP2) {
            PG8_LDB(B0, 0, 0); PG8_LDB(B1, 0, 1); PG8_SCHED; PG8_LDA(At, 0, 0); PG8_STAGE(PG8_SA(1, 1), a1 + hstep, voffA);
            PG8_WAIT_V(8); PG8_WAIT_L(0); PG8_BAR; PG8_MMA(0, 0, At, B0); PG8_MMA(0, 1, At, B1); PG8_BAR; PG8_SCHED;
            PG8_LDA(At, 0, 1); PG8_STAGE(PG8_SB(0, 0), b2, voffB); PG8_STAGE(PG8_SB(0, 1), b2 + hstep, voffB); PG8_STAGE(PG8_SA(0, 0), a2, voffA);
            PG8_WAIT_V(8); PG8_WAIT_L(0); PG8_BAR; PG8_MMA(1, 0, At, B0); PG8_MMA(1, 1, At, B1); PG8_BAR; PG8_SCHED;
            PG8_LDB(B0, 1, 0); PG8_LDB(B1, 1, 1); PG8_SCHED; PG8_LDA(At, 1, 0); PG8_STAGE(PG8_SA(0, 1), a2 + hstep, voffA);
            PG8_WAIT_V(8); PG8_WAIT_L(0); PG8_BAR; PG8_MMA(0, 0, At, B0); PG8_MMA(0, 1, At, B1); PG8_BAR; PG8_SCHED;
            PG8_LDA(At, 1, 1); PG8_STAGE(PG8_SB(1, 0), b3, voffB); PG8_STAGE(PG8_SB(1, 1), b3 + hstep, voffB); PG8_STAGE(PG8_SA(1, 0), a3, voffA);
            PG8_WAIT_V(8); PG8_WAIT_L(0); PG8_BAR; PG8_MMA(1, 0, At, B0); PG8_MMA(1, 1, At, B1); PG8_BAR; PG8_SCHED;
            } else {
            PG8_LDB(B0, 0, 0); PG8_SCHED; PG8_LDA(At, 0, 0); PG8_STAGE(PG8_SA(1, 1), a1 + hstep, voffA);
            PG8_WAIT_L(8); PG8_BAR; PG8_WAIT_L(0); PG8_MMA(0, 0, At, B0); PG8_BAR; PG8_SCHED;
            PG8_LDB(B1, 0, 1); PG8_STAGE(PG8_SB(0, 0), b2, voffB);
            PG8_BAR; PG8_WAIT_L(0); PG8_MMA(0, 1, At, B1); PG8_BAR;
            PG8_LDA(At, 0, 1); PG8_STAGE(PG8_SA(0, 0), a2, voffA);
            PG8_BAR; PG8_WAIT_L(0); PG8_MMA(1, 0, At, B0); PG8_BAR; PG8_SCHED;
            PG8_STAGE(PG8_SB(0, 1), b2 + hstep, voffB);
            PG8_WAIT_V(6); PG8_BAR; PG8_MMA(1, 1, At, B1); PG8_BAR;
            PG8_LDB(B0, 1, 0); PG8_SCHED; PG8_LDA(At, 1, 0); PG8_STAGE(PG8_SA(0, 1), a2 + hstep, voffA);
            PG8_WAIT_L(8); PG8_BAR; PG8_WAIT_L(0); PG8_MMA(0, 0, At, B0); PG8_BAR; PG8_SCHED;
            PG8_LDB(B1, 1, 1); PG8_STAGE(PG8_SB(1, 0), b3, voffB);
            PG8_BAR; PG8_WAIT_L(0); PG8_MMA(0, 1, At, B1); PG8_BAR;
            PG8_LDA(At, 1, 1); PG8_STAGE(PG8_SA(1, 0), a3, voffA);
            PG8_BAR; PG8_WAIT_L(0); PG8_MMA(1, 0, At, B0); PG8_BAR; PG8_SCHED;
            PG8_STAGE(PG8_SB(1, 1), b3 + hstep, voffB);
            PG8_WAIT_V(6); PG8_BAR; PG8_MMA(1, 1, At, B1); PG8_BAR;
            }
        }
        if constexpr (ALIGN_EPI) { if (wr == 0) PG8_BAR; }
        if constexpr (!Epi::AFTER_DRAIN) { E(acc, cur, wr, wc, fr, fq); S.done(cur); }
        if (!has_next) break;
#pragma unroll
        for (int a = 0; a < 2; ++a)
#pragma unroll
            for (int b = 0; b < 2; ++b)
#pragma unroll
                for (int m = 0; m < 4; ++m)
#pragma unroll
                    for (int n = 0; n < 2; ++n) acc[a][b][m][n] = (f32x4){0.f, 0.f, 0.f, 0.f};
        cur = nxt; cA = nA; cB = nB; ++ui;
        if constexpr (ALIGN_EPI) { if (wr == 1) PG8_BAR; }
    }
    PG8_WAIT_V(0);
    if constexpr (!ALIGN_EPI) { if (wr == 0) PG8_BAR; }
    PG8_BAR;
    if constexpr (Epi::AFTER_DRAIN) { E.fused(acc, cur, wr, wc, fr, fq, lds, wid, lane); S.done(cur); }
#undef PG8_SA
#undef PG8_SB
#undef PG8_STAGE
#undef PG8_LDA
#undef PG8_LDB
#undef PG8_MMA
#undef PG8_WAIT_V
#undef PG8_WAIT_L
#undef PG8_BAR
#undef PG8_SCHED
}
}
#define LAS __attribute__((address_space(3)))
#define DI __device__ __forceinline__
typedef unsigned short bf16_t;
typedef short bf16x8 __attribute__((ext_vector_type(8)));
typedef float f32x4 __attribute__((ext_vector_type(4)));
typedef float f32x16 __attribute__((ext_vector_type(16)));
typedef unsigned u32x4 __attribute__((ext_vector_type(4)));
typedef unsigned u32x2 __attribute__((ext_vector_type(2)));
using pg8::pk2;

constexpr int NWAVES = 8, NTHREADS = 512;
constexpr int D = 2048, BATCH = 4, SEQ = 2048, M = BATCH * SEQ, DFF = 5632;
constexpr int AB_IN = 5120, DN_IN = 12352, DN_IN_PAD = 12544;
constexpr float ALPHA = 1.41421356237f;
constexpr float LN_EPS = 1e-5f, RMS_EPS = 1e-6f;
constexpr size_t MiB = (size_t)1 << 20;
constexpr size_t WS_L0 = 0;
constexpr size_t WS_WGU1_0 = 0, WS_WD1_0 = 44 * MiB, WS_WGU2_0 = 66 * MiB, WS_WD2_0 = 110 * MiB, WS_WABIN = 132 * MiB, WS_WABOUT = 152 * MiB;
constexpr size_t WS_WGU1_1 = 160 * MiB, WS_WD1_1 = 204 * MiB, WS_WGU2_1 = 226 * MiB, WS_WD2_1 = 270 * MiB, WS_WDNIN = 292 * MiB, WS_WDNOUT = 341 * MiB;
constexpr size_t WS_XB = 357 * MiB;
constexpr size_t WS_BIG = 389 * MiB;
constexpr size_t WS_BA = WS_BIG + 192 * MiB;
constexpr size_t WS_DNX = 585 * MiB;
constexpr size_t WS_QR = WS_DNX, WS_KR = WS_DNX + 16 * MiB, WS_VT = WS_DNX + 32 * MiB, WS_CAT = WS_DNX + 48 * MiB, WS_KMEAN = WS_DNX + 80 * MiB;
constexpr size_t WS_QN = WS_DNX, WS_KN = WS_DNX + 32 * MiB, WS_V = WS_DNX + 64 * MiB, WS_G = WS_DNX + 128 * MiB, WS_BETA = WS_DNX + 129 * MiB;
constexpr size_t WS_OG = WS_L0;
constexpr size_t WS_WIMG = WS_BIG, WS_UIMG = WS_BIG + 64 * MiB;
constexpr size_t WS_AIMG = WS_L0 + 64 * MiB, WS_QIMG = WS_L0 + 96 * MiB, WS_KTIMG = WS_L0 + 128 * MiB;
constexpr size_t WS_GC = 715 * MiB;
constexpr size_t WS_BAR = 717 * MiB, BAR_BYTES = 16384;
constexpr size_t WS_END = 718 * MiB;
constexpr int LDS_BYTES = 147456;

DI float bflo(unsigned u) { return __uint_as_float(u << 16); }
DI float bfhi(unsigned u) { return __uint_as_float(u & 0xffff0000u); }
DI float bf2f(bf16_t h) { return __uint_as_float((unsigned)h << 16); }
DI bf16_t f2bf(float f) { return (bf16_t)(pk2(f, 0.f) & 0xffffu); }
DI float wave_sum(float v) {
#pragma unroll
    for (int o = 1; o < 64; o <<= 1) v += __shfl_xor(v, o);
    return v;
}
DI float gelu_tanh(float x) { const float t = 1.5957691216f * (x + 0.044715f * x * x * x); return x * __builtin_amdgcn_rcpf(1.0f + __expf(-t)); }
DI int crow(int r, int h) { return (r & 3) + 8 * (r >> 2) + 4 * h; }
#define MFMA32(a, b, c) __builtin_amdgcn_mfma_f32_32x32x16_bf16((a), (b), (c), 0, 0, 0)
DI bf16x8 pack8(float a0, float a1, float a2, float a3, float a4, float a5, float a6, float a7) {
    u32x4 p; p.x = pk2(a0, a1); p.y = pk2(a2, a3); p.z = pk2(a4, a5); p.w = pk2(a6, a7); return __builtin_bit_cast(bf16x8, p);
}

#define PACKS(x, s) pack8((x)[8 * (s)], (x)[8 * (s) + 1], (x)[8 * (s) + 2], (x)[8 * (s) + 3], (x)[8 * (s) + 4], (x)[8 * (s) + 5], (x)[8 * (s) + 6], (x)[8 * (s) + 7])
DI void tr_tile(const float* __restrict__ W, int K, int N, bf16_t* __restrict__ WT, int k0, int n0, int drow0, LAS float* scr, int lane) {
#pragma unroll 4
    for (int i = 0; i < 16; ++i) { const int kk = 4 * i + (lane >> 4), c4 = (lane & 15) * 4;
        const f32x4 v = *(const f32x4*)(W + (size_t)(k0 + kk) * N + n0 + c4);
        LAS float* s = scr + kk * 65 + c4; s[0] = v.x; s[1] = v.y; s[2] = v.z; s[3] = v.w; }
    asm volatile("s_waitcnt lgkmcnt(0)" ::: "memory");
    const int c = lane & 7;
#pragma unroll
    for (int j = 0; j < 8; ++j) { const int n = (lane >> 3) + 8 * j; const LAS float* s = scr + (8 * c) * 65 + n;
        u32x4 o; o.x = pk2(s[0], s[65]); o.y = pk2(s[2 * 65], s[3 * 65]); o.z = pk2(s[4 * 65], s[5 * 65]); o.w = pk2(s[6 * 65], s[7 * 65]);
        *(u32x4*)(WT + (size_t)(drow0 + n) * K + k0 + 8 * c) = o; }
    asm volatile("s_waitcnt lgkmcnt(0)" ::: "memory");
}
DI void tr_matrix(const float* W, int K, int N, bf16_t* WT, int mode, LAS float* scr, int gw, int ngw, int lane) {
    const int nb = N / 64, items = (K / 64) * nb;
    for (int it = gw; it < items; it += ngw) {
        const int kb = it / nb, n0 = (it % nb) * 64;
        const int drow0 = mode == 0 ? n0 : ((n0 >> 7) * 256 + (n0 & 127) + (mode == 2 ? 128 : 0));
        tr_tile(W, K, N, WT, kb * 64, n0, drow0, scr, lane);
    }
}

struct Args { const float* in[21]; float* out; unsigned char* ws; int ph_lo, ph_hi; };

DI void p0_prologue(const Args& a, LAS unsigned char* lds, int wave, int lane) {
    LAS float* scr = (LAS float*)(lds + wave * 17408);
    const int gw = blockIdx.x * NWAVES + wave, ngw = gridDim.x * NWAVES;
    unsigned char* ws = a.ws;
    const size_t WGU = (size_t)D * DFF;
    for (int l = 0; l < 2; ++l) {
        bf16_t* gu1 = (bf16_t*)(ws + (l ? WS_WGU1_1 : WS_WGU1_0)); bf16_t* d1 = (bf16_t*)(ws + (l ? WS_WD1_1 : WS_WD1_0));
        bf16_t* gu2 = (bf16_t*)(ws + (l ? WS_WGU2_1 : WS_WGU2_0)); bf16_t* d2 = (bf16_t*)(ws + (l ? WS_WD2_1 : WS_WD2_0));
        tr_matrix(a.in[1] + l * WGU, D, DFF, gu1, 1, scr, gw, ngw, lane);
        tr_matrix(a.in[2] + l * WGU, D, DFF, gu1, 2, scr, gw, ngw, lane);
        tr_matrix(a.in[3] + l * WGU, DFF, D, d1, 0, scr, gw, ngw, lane);
        tr_matrix(a.in[4] + l * WGU, D, DFF, gu2, 1, scr, gw, ngw, lane);
        tr_matrix(a.in[5] + l * WGU, D, DFF, gu2, 2, scr, gw, ngw, lane);
        tr_matrix(a.in[6] + l * WGU, DFF, D, d2, 0, scr, gw, ngw, lane);
    }
    tr_matrix(a.in[9], D, AB_IN, (bf16_t*)(ws + WS_WABIN), 0, scr, gw, ngw, lane);
    tr_matrix(a.in[14], D, D, (bf16_t*)(ws + WS_WABOUT), 0, scr, gw, ngw, lane);
    tr_matrix(a.in[15], D, DN_IN, (bf16_t*)(ws + WS_WDNIN), 0, scr, gw, ngw, lane);
    tr_matrix(a.in[20], 4096, D, (bf16_t*)(ws + WS_WDNOUT), 0, scr, gw, ngw, lane);
    { u32x4* p = (u32x4*)((bf16_t*)(ws + WS_WDNIN) + (size_t)DN_IN * D); const int n16 = (DN_IN_PAD - DN_IN) * D / 8;
      for (int i = blockIdx.x * NTHREADS + threadIdx.x; i < n16; i += gridDim.x * NTHREADS) p[i] = (u32x4){0u, 0u, 0u, 0u}; }
    { const f32x4* x4 = (const f32x4*)a.in[0]; u32x2* xb = (u32x2*)(ws + WS_XB); const int n4 = M * D / 4;
      for (int i = blockIdx.x * NTHREADS + threadIdx.x; i < n4; i += gridDim.x * NTHREADS) { const f32x4 v = x4[i]; xb[i] = (u32x2){pk2(v.x, v.y), pk2(v.z, v.w)}; } }
}

DI void ln_phase(float* Y, bf16_t* XB, const float* g, const float* b, int wave, int lane) {
    const int gw = blockIdx.x * NWAVES + wave, ngw = gridDim.x * NWAVES;
    for (int m = gw; m < M; m += ngw) {
        f32x4* yr = (f32x4*)(Y + (size_t)m * D) + lane;
        f32x4 v[8]; float s = 0.f;
#pragma unroll
        for (int j = 0; j < 8; ++j) { v[j] = yr[64 * j]; s += (v[j].x + v[j].y) + (v[j].z + v[j].w); }
        const float mean = wave_sum(s) * (1.f / D); float s2 = 0.f;
#pragma unroll
        for (int j = 0; j < 8; ++j) { v[j] = v[j] - mean; s2 += (v[j].x * v[j].x + v[j].y * v[j].y) + (v[j].z * v[j].z + v[j].w * v[j].w); }
        const float rstd = rsqrtf(wave_sum(s2) * (1.f / D) + LN_EPS);
        u32x2* o8 = (u32x2*)(XB + (size_t)m * D) + lane;
#pragma unroll
        for (int j = 0; j < 8; ++j) { const f32x4 gg = ((const f32x4*)g)[lane + 64 * j], bb = ((const f32x4*)b)[lane + 64 * j];
            const f32x4 o = v[j] * rstd * gg + bb; yr[64 * j] = o; o8[64 * j] = (u32x2){pk2(o.x, o.y), pk2(o.z, o.w)}; }
    }
}

DI void rope_item(const bf16_t* HC, bf16_t* Qr, bf16_t* Kr, bf16_t* Vt, float* kmean, int item, LAS float* red, int tid) {
    const int h = item & 7, blk = (item >> 3) & 7, b = item >> 6, bh = b * 8 + h;
    const int i = tid & 63, rg = tid >> 6;
    const float inv = expf((-9.210340371976184f * (float)i) * 0.015625f);
    float ks0 = 0.f, ks1 = 0.f;
    for (int rr = 0; rr < 32; ++rr) {
        const int pos = blk * 256 + rr * 8 + rg; const size_t row = (size_t)b * SEQ + pos;
        float sn, cs; sincosf((float)pos * inv, &sn, &cs);
        const bf16_t* hp = HC + row * AB_IN + h * 128 + i;
        const float q1 = bf2f(hp[0]), q2 = bf2f(hp[64]), k1 = bf2f(hp[1024]), k2 = bf2f(hp[1024 + 64]);
        const bf16_t v1 = hp[2048], v2 = hp[2048 + 64];
        const float qa = (q1 * cs - q2 * sn) * 0.08838834764831845f, qb = (q2 * cs + q1 * sn) * 0.08838834764831845f;
        const float ka = k1 * cs - k2 * sn, kb = k2 * cs + k1 * sn;
        const size_t o = ((size_t)bh * SEQ + pos) * 128 + i;
        Qr[o] = f2bf(qa); Qr[o + 64] = f2bf(qb);
        ks0 += ka; ks1 += kb;
        { const size_t kb0 = (((size_t)bh * 64 + (pos >> 5)) * 8) * 512 + (size_t)(pos & 31) * 8;
          Kr[kb0 + (size_t)(i >> 4) * 512 + ((i >> 3) & 1) * 256 + (i & 7)] = f2bf(ka);
          Kr[kb0 + (size_t)((i + 64) >> 4) * 512 + (((i + 64) >> 3) & 1) * 256 + (i & 7)] = f2bf(kb); }
        { const size_t vb0 = (((size_t)bh * 64 + (pos >> 5)) * 4) * 1024 + (size_t)((pos >> 4) & 1) * 512 + ((pos >> 2) & 1) * 256 + (((pos >> 3) & 1) * 4 + (pos & 3));
          Vt[vb0 + (size_t)(i >> 5) * 1024 + (i & 31) * 8] = v1;
          Vt[vb0 + (size_t)((i + 64) >> 5) * 1024 + (i & 31) * 8] = v2; }
    }
    red[rg * 128 + i] = ks0; red[rg * 128 + 64 + i] = ks1;
    __syncthreads();
    if (tid < 128) { float s = 0.f;
#pragma unroll
        for (int g = 0; g < 8; ++g) s += red[g * 128 + tid];
        kmean[((size_t)bh * 8 + blk) * 128 + tid] = s * (1.f / 256.f); }
    __syncthreads();
}

DI void gmlp_item(const bf16_t* HC, const float* lng, const float* lnb, const float* w_s, const float* b_s, bf16_t* CAT, int item, LAS unsigned char* lds, int wave, int lane) {
    const int g = item & 7, c = (item >> 3) & 15, b = item >> 7;
    const size_t row0 = (size_t)b * SEQ + c * 128;
    LAS bf16_t* vnT = (LAS bf16_t*)lds;
    { const float g0 = lng[g * 128 + 2 * lane], g1 = lng[g * 128 + 2 * lane + 1], b0 = lnb[g * 128 + 2 * lane], b1 = lnb[g * 128 + 2 * lane + 1];
      for (int ss = 0; ss < 16; ++ss) { const int s = wave * 16 + ss;
        const unsigned raw = *(const unsigned*)(HC + (row0 + s) * AB_IN + 4096 + g * 128 + 2 * lane);
        const float v0 = gelu_tanh(bflo(raw)), v1 = gelu_tanh(bfhi(raw));
        const float mu = wave_sum(v0 + v1) * (1.f / 128.f); const float d0 = v0 - mu, d1 = v1 - mu;
        const float rstd = rsqrtf(wave_sum(d0 * d0 + d1 * d1) * (1.f / 128.f) + LN_EPS);
        vnT[(2 * lane) * 136 + s] = f2bf(d0 * rstd * g0 + b0); vnT[(2 * lane + 1) * 136 + s] = f2bf(d1 * rstd * g1 + b1); } }
    __syncthreads();
    const int tt = wave >> 1, dh = wave & 1, r32 = lane & 31, hi = lane >> 5;
    f32x16 acc[2];
#pragma unroll
    for (int j = 0; j < 2; ++j)
#pragma unroll
        for (int r = 0; r < 16; ++r) acc[j][r] = 0.f;
    const int t = 32 * tt + r32; const float* wrow = w_s + ((size_t)g * 128 + t) * 128;
    for (int st = 0; st < 2 * (tt + 1); ++st) { const int s0 = 16 * st + 8 * hi;
        const f32x4 w0 = *(const f32x4*)(wrow + s0), w1 = *(const f32x4*)(wrow + s0 + 4);
        const bf16x8 a = pack8(s0 + 0 <= t ? w0.x : 0.f, s0 + 1 <= t ? w0.y : 0.f, s0 + 2 <= t ? w0.z : 0.f, s0 + 3 <= t ? w0.w : 0.f,
                               s0 + 4 <= t ? w1.x : 0.f, s0 + 5 <= t ? w1.y : 0.f, s0 + 6 <= t ? w1.z : 0.f, s0 + 7 <= t ? w1.w : 0.f);
#pragma unroll
        for (int j = 0; j < 2; ++j) { const bf16x8 bv = *(const LAS bf16x8*)(vnT + (32 * (2 * dh + j) + r32) * 136 + s0); acc[j] = MFMA32(a, bv, acc[j]); } }
#pragma unroll
    for (int j = 0; j < 2; ++j) { const int d = 32 * (2 * dh + j) + r32;
#pragma unroll
        for (int r = 0; r < 16; ++r) { const int tq = 32 * tt + crow(r, hi); const size_t row = row0 + tq;
            const float uval = gelu_tanh(bf2f(HC[row * AB_IN + 3072 + g * 128 + d]));
            CAT[row * D + 1024 + g * 128 + d] = f2bf(uval * (acc[j][r] + b_s[g * 128 + tq])); } }
    __syncthreads();
}

DI void moba_wave(const bf16_t* Qr, const bf16_t* Kr, const bf16_t* Vt, const float* kmean, bf16_t* CAT, int bh, int qt, int lane) {
    const int qi = lane & 31, hi = lane >> 5, q0 = qt * 32, own = q0 >> 8, pos = q0 + qi, b = bh >> 3, h = bh & 7;
    bf16x8 qf[8];
    { const bf16_t* qp = Qr + ((size_t)bh * SEQ + pos) * 128 + 8 * hi;
#pragma unroll
      for (int st = 0; st < 8; ++st) qf[st] = *(const bf16x8*)(qp + 16 * st); }
    unsigned selmask = 0u;
    if (own > 0) {
        f32x16 ga;
#pragma unroll
        for (int r = 0; r < 16; ++r) ga[r] = 0.f;
#pragma unroll
        for (int st = 0; st < 8; ++st) { bf16x8 a = (bf16x8){0, 0, 0, 0, 0, 0, 0, 0};
            if (qi < 8) { const float* kp = kmean + ((size_t)bh * 8 + qi) * 128 + 16 * st + 8 * hi; const f32x4 k0 = *(const f32x4*)kp, k1 = *(const f32x4*)(kp + 4);
                a = pack8(k0.x, k0.y, k0.z, k0.w, k1.x, k1.y, k1.z, k1.w); }
            ga = MFMA32(a, qf[st], ga); }
        float g[8];
#pragma unroll
        for (int r = 0; r < 4; ++r) { const float mine = ga[r], other = __shfl_xor(mine, 32); g[r] = hi ? other : mine; g[4 + r] = hi ? mine : other; }
        const int nsel = own < 3 ? own : 3;
#pragma unroll
        for (int j = 0; j < 8; ++j) { int rank = 0;
#pragma unroll
            for (int i2 = 0; i2 < 8; ++i2) if (i2 != j) rank += (i2 < own && (g[i2] > g[j] || (g[i2] == g[j] && i2 < j))) ? 1 : 0;
            if (j < own && rank < nsel) selmask |= 1u << j; }
    }
    f32x16 o[4];
#pragma unroll
    for (int dt = 0; dt < 4; ++dt)
#pragma unroll
        for (int r = 0; r < 16; ++r) o[dt][r] = 0.f;
    float mrun = -INFINITY, lrun = 0.f;
    unsigned amask = 1u << own;
#pragma unroll
    for (int j = 0; j < 8; ++j) if (j < own && __ballot((selmask >> j) & 1u) != 0ull) amask |= 1u << j;
    const int nkt_own = ((q0 & 255) >> 5) + 1;
    const bf16x8* Kb = (const bf16x8*)Kr + (size_t)bh * 64 * 8 * 64 + lane;
    const bf16x8* Vb = (const bf16x8*)Vt + (size_t)bh * 64 * 8 * 64 + lane;
    int j = __builtin_ctz(amask), kt = 0;
    bf16x8 kfr[8], vfr[8];
    { const int T = j * 8 + kt;
#pragma unroll
      for (int st = 0; st < 8; ++st) { kfr[st] = Kb[(T * 8 + st) * 64]; vfr[st] = Vb[(T * 8 + st) * 64]; } }
    while (j >= 0) {
        const int key0 = j * 256 + kt * 32;
        const bool act = (j == own) || ((selmask >> j) & 1u);
        f32x16 s;
#pragma unroll
        for (int r = 0; r < 16; ++r) s[r] = 0.f;
#pragma unroll
        for (int st = 0; st < 8; ++st) s = MFMA32(kfr[st], qf[st], s);
        int j2 = j, kt2 = kt + 1;
        if (kt2 >= (j == own ? nkt_own : 8)) { kt2 = 0; const unsigned rem = amask & ~((2u << j) - 1u); j2 = rem ? __builtin_ctz(rem) : -1; }
        const int T2 = (j2 < 0 ? j : j2) * 8 + (j2 < 0 ? kt : kt2);
#pragma unroll
        for (int st = 0; st < 8; ++st) kfr[st] = Kb[(T2 * 8 + st) * 64];
        float mt = -INFINITY;
#pragma unroll
        for (int r = 0; r < 16; ++r) { const int key = key0 + crow(r, hi); const bool ok = act && (j < own || key <= pos); s[r] = ok ? s[r] : -INFINITY; mt = fmaxf(mt, s[r]); }
        mt = fmaxf(mt, __shfl_xor(mt, 32));
        const float mnew = fmaxf(mrun, mt), muse = (mnew == -INFINITY) ? 0.f : mnew;
        const float alpha = __expf(mrun - muse);
        float ls = 0.f;
#pragma unroll
        for (int r = 0; r < 16; ++r) { s[r] = __expf(s[r] - muse); ls += s[r]; }
        lrun = lrun * alpha + ls; mrun = mnew;
#pragma unroll
        for (int dt = 0; dt < 4; ++dt)
#pragma unroll
            for (int r = 0; r < 16; ++r) o[dt][r] *= alpha;
        { const bf16x8 pb0 = PACKS(s, 0), pb1 = PACKS(s, 1);
#pragma unroll
          for (int dt = 0; dt < 4; ++dt) { o[dt] = MFMA32(vfr[2 * dt], pb0, o[dt]); o[dt] = MFMA32(vfr[2 * dt + 1], pb1, o[dt]); } }
#pragma unroll
        for (int st = 0; st < 8; ++st) vfr[st] = Vb[(T2 * 8 + st) * 64];
        j = j2; kt = kt2;
    }
    const float ltot = lrun + __shfl_xor(lrun, 32), inv = 1.0f / ltot;
    bf16_t* op = CAT + ((size_t)b * SEQ + pos) * D + h * 128;
#pragma unroll
    for (int dt = 0; dt < 4; ++dt)
#pragma unroll
        for (int g4 = 0; g4 < 4; ++g4) { const int d = 32 * dt + 8 * g4 + 4 * hi;
            *(u32x2*)(op + d) = (u32x2){pk2(o[dt][4 * g4] * inv, o[dt][4 * g4 + 1] * inv), pk2(o[dt][4 * g4 + 2] * inv, o[dt][4 * g4 + 3] * inv)}; }
}

DI float sum16(float v) {
    v += __shfl_xor(v, 1); v += __shfl_xor(v, 2); v += __shfl_xor(v, 4); v += __shfl_xor(v, 8); return v;
}
DI void unpack8(const u32x4 r, float (&x)[8]) { x[0] = bflo(r.x); x[1] = bfhi(r.x); x[2] = bflo(r.y); x[3] = bfhi(r.y); x[4] = bflo(r.z); x[5] = bfhi(r.z); x[6] = bflo(r.w); x[7] = bfhi(r.w); }
DI void dnp_phase(const bf16_t* QKraw, const bf16_t* Vraw, const float* BA, const float* conv_w, const float* a_log, const float* dt_bias,
                  bf16_t* QN, bf16_t* KN, bf16_t* V, float* G, float* BETA, int wave, int lane) {
    const int gw = blockIdx.x * NWAVES + wave, ngw = gridDim.x * NWAVES;
    const int rs = lane >> 4, c8 = (lane & 15) * 8;
    for (int it = gw; it < BATCH * 64 * 32; it += ngw) {
        const int rc = it & 31, hs = (it >> 5) & 63, b = it >> 11;
        const int ch = hs * 128 + c8;
        float w[4][8];
#pragma unroll
        for (int j = 0; j < 4; ++j) { const f32x4 a = *(const f32x4*)(conv_w + j * 8192 + ch), c = *(const f32x4*)(conv_w + j * 8192 + ch + 4);
            w[j][0] = a.x; w[j][1] = a.y; w[j][2] = a.z; w[j][3] = a.w; w[j][4] = c.x; w[j][5] = c.y; w[j][6] = c.z; w[j][7] = c.w; }
        const bf16_t* src = hs < 32 ? QKraw + ch : Vraw + (ch - 4096);
        const int t0 = rc * 64 + rs * 16;
        u32x4 raw[19];
#pragma unroll
        for (int j = 0; j < 19; ++j) { const int t = t0 - 3 + j; raw[j] = (u32x4){0u, 0u, 0u, 0u}; if (t >= 0) raw[j] = *(const u32x4*)(src + ((size_t)b * SEQ + t) * 4096); }
        float xa[8], xb[8], xc[8], xd[8];
        unpack8(raw[0], xa); unpack8(raw[1], xb); unpack8(raw[2], xc);
#pragma unroll
        for (int tt = 0; tt < 16; ++tt) { const size_t row = (size_t)b * SEQ + t0 + tt;
            unpack8(raw[tt + 3], xd);
            float y[8]; float ss = 0.f;
#pragma unroll
            for (int i = 0; i < 8; ++i) { y[i] = pg8::silu_f(xa[i] * w[0][i] + xb[i] * w[1][i] + xc[i] * w[2][i] + xd[i] * w[3][i]); ss += y[i] * y[i]; xa[i] = xb[i]; xb[i] = xc[i]; xc[i] = xd[i]; }
            float sc = 1.0f;
            if (hs < 32) { sc = rsqrtf(sum16(ss) + RMS_EPS) * (hs < 16 ? 0.08838834764831845f : 1.0f); }
            u32x4 o; o.x = pk2(y[0] * sc, y[1] * sc); o.y = pk2(y[2] * sc, y[3] * sc); o.z = pk2(y[4] * sc, y[5] * sc); o.w = pk2(y[6] * sc, y[7] * sc);
            bf16_t* dst = hs < 16 ? QN + row * 2048 + ch : (hs < 32 ? KN + row * 2048 + (ch - 2048) : V + row * 4096 + (ch - 4096));
            *(u32x4*)dst = o; }
    }
    for (int i = blockIdx.x * NTHREADS + threadIdx.x; i < M * 32; i += gridDim.x * NTHREADS) { const int row = i >> 5, h = i & 31;
        const float bb = BA[(size_t)row * 64 + h], aa = BA[(size_t)row * 64 + 32 + h];
        BETA[i] = 1.0f / (1.0f + expf(-bb));
        const float x = aa + dt_bias[h]; const float sp = x > 20.f ? x : log1pf(expf(x));
        G[i] = -expf(a_log[h]) * sp; }
}

constexpr int DW_STRIDE = 18432;
constexpr int DW_A00 = 0, DW_A11 = 4608, DW_A10 = 9216, DW_TT0 = 11776, DW_T11 = 14336, DW_GC = 16896, DW_BT = 17152;
constexpr int DW_TB = 0, DW_X = 9216, DW_X2 = 13824;
#define LDSW() asm volatile("s_waitcnt lgkmcnt(0)" ::: "memory")
DI void dna_wave(const bf16_t* QN, const bf16_t* KN, const bf16_t* V, const float* G, const float* BETA,
                 bf16_t* Wimg, bf16_t* Uimg, bf16_t* Aimg, bf16_t* Qimg, bf16_t* KTimg, float* EGt, float* DKt, int item, LAS unsigned char* wl, int lane) {
    asm volatile("" : "+v"(lane));
    const int hv = item & 31, n = (item >> 5) & 31, b = item >> 10, hk = hv >> 1, r32 = lane & 31, hi = lane >> 5;
    int itemv = item; asm volatile("" : "+v"(itemv));
    const size_t row0 = (size_t)(itemv >> 10) * SEQ + ((itemv >> 5) & 31) * 64;
    const int itemk = ((itemv >> 10) * 32 + ((itemv >> 5) & 31)) * 16 + ((itemv & 31) >> 1);
    LAS float* A00 = (LAS float*)(wl + DW_A00); LAS float* A11 = (LAS float*)(wl + DW_A11);
    LAS bf16_t* A10b = (LAS bf16_t*)(wl + DW_A10); LAS bf16_t* TT0 = (LAS bf16_t*)(wl + DW_TT0); LAS bf16_t* T11 = (LAS bf16_t*)(wl + DW_T11);
    LAS float* gcs = (LAS float*)(wl + DW_GC); LAS float* bts = (LAS float*)(wl + DW_BT);
    float gx = G[(row0 + lane) * 32 + hv];
#pragma unroll
    for (int o = 1; o < 64; o <<= 1) { const float t = __shfl_up(gx, o); if (lane >= o) gx += t; }
    const float mybeta = BETA[(row0 + lane) * 32 + hv], myeg = __expf(gx);
    gcs[lane] = gx; bts[lane] = mybeta;
    { const float gl = __shfl(gx, 63); const int c5 = lane & 31, ti = (((lane >> 5) * 2 + ((c5 >> 2) & 1)) * 16) + (c5 & 3) + 4 * (c5 >> 3);
      EGt[(size_t)itemv * 64 + ti] = myeg; DKt[(size_t)itemv * 64 + ti] = __expf(gl - gx); }
    bf16x8 kf[2][8], qf[2][8];
    { const bf16_t* kp = KN + (row0 + r32) * 2048 + hk * 128 + 8 * hi; const bf16_t* qp = QN + (row0 + r32) * 2048 + hk * 128 + 8 * hi;
#pragma unroll
      for (int t2 = 0; t2 < 2; ++t2)
#pragma unroll
          for (int st = 0; st < 8; ++st) { kf[t2][st] = *(const bf16x8*)(kp + (size_t)t2 * 32 * 2048 + 16 * st); qf[t2][st] = *(const bf16x8*)(qp + (size_t)t2 * 32 * 2048 + 16 * st); } }
    LDSW();
#pragma unroll
    for (int tl = 0; tl < 3; ++tl) { const int ct = tl == 0 ? 0 : 1, et = tl == 1 ? 1 : 0;
        f32x16 acc;
#pragma unroll
        for (int r = 0; r < 16; ++r) acc[r] = 0.f;
#pragma unroll
        for (int st = 0; st < 8; ++st) acc = MFMA32(kf[ct][st], kf[et][st], acc);
        const int e = 32 * et + r32; const float ge = gcs[e];
#pragma unroll
        for (int r = 0; r < 16; ++r) { const int cl = crow(r, hi), c = 32 * ct + cl; const float val = (e < c) ? bts[c] * acc[r] * __expf(gcs[c] - ge) : 0.f;
            if (tl == 0) A00[cl * 36 + r32] = val; else if (tl == 1) A11[cl * 36 + r32] = val; else A10b[cl * 40 + r32] = f2bf(val); } }
#pragma unroll
    for (int tl = 0; tl < 3; ++tl) { const int et = tl == 2 ? 1 : 0, ct = tl == 0 ? 0 : 1;
        f32x16 acc;
#pragma unroll
        for (int r = 0; r < 16; ++r) acc[r] = 0.f;
#pragma unroll
        for (int st = 0; st < 8; ++st) acc = MFMA32(kf[et][st], qf[ct][st], acc);
        const int c = 32 * ct + r32; const float gcc = gcs[c];
#pragma unroll
        for (int r = 0; r < 16; ++r) { const int e = 32 * et + crow(r, hi); acc[r] = (e <= c) ? acc[r] * __expf(gcc - gcs[e]) : 0.f; }
#pragma unroll
        for (int s = 0; s < 2; ++s) *(u32x4*)(Aimg + ((((size_t)itemv * 4 + ct * 2 + et) * 2 + s) * 512 + lane * 8)) = __builtin_bit_cast(u32x4, PACKS(acc, s)); }
    if ((hv & 1) == 0) {
#pragma unroll 1
        for (int ct = 0; ct < 2; ++ct)
#pragma unroll
            for (int kt = 0; kt < 4; ++kt)
#pragma unroll
                for (int s = 0; s < 2; ++s) { const bf16_t* sp = QN + (row0 + 32 * ct + r32) * 2048 + hk * 128 + 32 * kt + 16 * s + 4 * hi;
                    const u32x2 lo = *(const u32x2*)sp, hh = *(const u32x2*)(sp + 8);
                    *(u32x4*)(Qimg + ((((size_t)itemk * 8 + ct * 4 + kt) * 2 + s) * 512 + lane * 8)) = (u32x4){lo.x, lo.y, hh.x, hh.y}; } }
    LDSW();
    float T[32];
    { const LAS float* Ab = hi ? A11 : A00;
#pragma unroll
      for (int i = 0; i < 32; ++i) { float acc = (i == r32) ? 1.f : 0.f;
#pragma unroll
          for (int q = 0; q < (i + 3) / 4; ++q) { const f32x4 a4 = *(const LAS f32x4*)(Ab + i * 36 + 4 * q);
              if (4 * q + 0 < i) acc -= a4.x * T[4 * q + 0];
              if (4 * q + 1 < i) acc -= a4.y * T[4 * q + 1];
              if (4 * q + 2 < i) acc -= a4.z * T[4 * q + 2];
              if (4 * q + 3 < i) acc -= a4.w * T[4 * q + 3]; }
          T[i] = acc; } }
    if (hi) {
#pragma unroll
        for (int i = 0; i < 32; ++i) T11[i * 40 + r32] = f2bf(T[i]);
    } else {
#pragma unroll
        for (int q = 0; q < 4; ++q) *(LAS u32x4*)(TT0 + r32 * 40 + 8 * q) = __builtin_bit_cast(u32x4, pack8(T[8 * q], T[8 * q + 1], T[8 * q + 2], T[8 * q + 3], T[8 * q + 4], T[8 * q + 5], T[8 * q + 6], T[8 * q + 7]));
    }
    LDSW();
    f32x16 Xa, Ya;
#pragma unroll
    for (int r = 0; r < 16; ++r) { Xa[r] = 0.f; Ya[r] = 0.f; }
#pragma unroll
    for (int s = 0; s < 2; ++s) Xa = MFMA32(*(const LAS bf16x8*)(A10b + r32 * 40 + 16 * s + 8 * hi), *(const LAS bf16x8*)(TT0 + r32 * 40 + 16 * s + 8 * hi), Xa);
#pragma unroll
    for (int s = 0; s < 2; ++s) { const LAS bf16_t* tp = T11 + r32 * 40 + 16 * s + 4 * hi; const u32x2 lo = *(const LAS u32x2*)tp, hh = *(const LAS u32x2*)(tp + 8);
        Ya = MFMA32(__builtin_bit_cast(bf16x8, (u32x4){lo.x, lo.y, hh.x, hh.y}), PACKS(Xa, s), Ya); }
    LDSW();
    LAS bf16_t* Tb = (LAS bf16_t*)(wl + DW_TB); LAS bf16_t* X = (LAS bf16_t*)(wl + DW_X); LAS bf16_t* X2 = (LAS bf16_t*)(wl + DW_X2);
    if (hi) {
#pragma unroll
        for (int i = 0; i < 32; ++i) Tb[(32 + i) * 72 + 32 + r32] = f2bf(T[i]);
    } else {
#pragma unroll
        for (int i = 0; i < 32; ++i) Tb[i * 72 + r32] = f2bf(T[i]);
    }
#pragma unroll
    for (int r = 0; r < 16; ++r) Tb[(32 + crow(r, hi)) * 72 + r32] = f2bf(-Ya[r]);
    LDSW();
    const float be = mybeta, bg = mybeta * myeg;
#pragma unroll 1
    for (int vt = 0; vt < 4; ++vt) {
        { const bf16_t* vp = V + (row0 + lane) * 4096 + hv * 128 + 32 * vt;
#pragma unroll
          for (int q = 0; q < 4; ++q) { const u32x4 rv = *(const u32x4*)(vp + 8 * q); float x[8]; unpack8(rv, x);
#pragma unroll
              for (int i = 0; i < 8; ++i) X[(8 * q + i) * 72 + lane] = f2bf(x[i] * be); } }
        LDSW();
#pragma unroll
        for (int ct = 0; ct < 2; ++ct) { f32x16 acc;
#pragma unroll
            for (int r = 0; r < 16; ++r) acc[r] = 0.f;
#pragma unroll
            for (int es = 0; es < 4; ++es) if (es < 2 * (ct + 1)) acc = MFMA32(*(const LAS bf16x8*)(Tb + (32 * ct + r32) * 72 + 16 * es + 8 * hi), *(const LAS bf16x8*)(X + r32 * 72 + 16 * es + 8 * hi), acc);
            bf16_t* dst = Uimg + (((size_t)itemv * 4 + vt) * 2 + ct) * 1024 + lane * 16;
#pragma unroll
            for (int s = 0; s < 2; ++s) *(u32x4*)(dst + 8 * s) = __builtin_bit_cast(u32x4, PACKS(acc, s)); }
        LDSW();
    }
#pragma unroll 1
    for (int kt = 0; kt < 4; ++kt) {
        { const bf16_t* kp = KN + (row0 + lane) * 2048 + hk * 128 + 32 * kt;
#pragma unroll
          for (int q = 0; q < 4; ++q) { const u32x4 rv = *(const u32x4*)(kp + 8 * q); float x[8]; unpack8(rv, x); const unsigned rw[4] = {rv.x, rv.y, rv.z, rv.w};
#pragma unroll
              for (int i = 0; i < 8; ++i) { X[(8 * q + i) * 72 + lane] = f2bf(x[i] * bg); X2[(8 * q + i) * 72 + lane] = (bf16_t)((i & 1) ? (rw[i >> 1] >> 16) : (rw[i >> 1] & 0xffffu)); } } }
        LDSW();
#pragma unroll
        for (int ct = 0; ct < 2; ++ct) { f32x16 acc;
#pragma unroll
            for (int r = 0; r < 16; ++r) acc[r] = 0.f;
#pragma unroll
            for (int es = 0; es < 4; ++es) if (es < 2 * (ct + 1)) acc = MFMA32(*(const LAS bf16x8*)(X + r32 * 72 + 16 * es + 8 * hi), *(const LAS bf16x8*)(Tb + (32 * ct + r32) * 72 + 16 * es + 8 * hi), acc);
#pragma unroll
            for (int r = 0; r < 16; ++r) acc[r] = -acc[r];
#pragma unroll
            for (int s = 0; s < 2; ++s) *(u32x4*)(Wimg + ((((size_t)itemv * 8 + ct * 4 + kt) * 2 + s) * 512 + lane * 8)) = __builtin_bit_cast(u32x4, PACKS(acc, s)); }
        if ((hv & 1) == 0) {
#pragma unroll
            for (int ct = 0; ct < 2; ++ct)
#pragma unroll
                for (int s = 0; s < 2; ++s) { const LAS bf16_t* sp = X2 + r32 * 72 + 32 * ct + 16 * s + 4 * hi; const u32x2 lo = *(const LAS u32x2*)sp, hh = *(const LAS u32x2*)(sp + 8);
                    *(u32x4*)(KTimg + ((((size_t)itemk * 8 + kt * 2 + ct) * 2 + s) * 512 + lane * 8)) = (u32x4){lo.x, lo.y, hh.x, hh.y}; } }
        LDSW();
    }
}

DI f32x16 ld_img16(const bf16_t* p) { const u32x4 a = *(const u32x4*)p, b = *(const u32x4*)(p + 8); f32x16 v;
    v[0] = bflo(a.x); v[1] = bfhi(a.x); v[2] = bflo(a.y); v[3] = bfhi(a.y); v[4] = bflo(a.z); v[5] = bfhi(a.z); v[6] = bflo(a.w); v[7] = bfhi(a.w);
    v[8] = bflo(b.x); v[9] = bfhi(b.x); v[10] = bflo(b.y); v[11] = bfhi(b.y); v[12] = bflo(b.z); v[13] = bfhi(b.z); v[14] = bflo(b.w); v[15] = bfhi(b.w); return v; }
#define LDF(p) (((const bf16x8*)(p))[lane])
#define DNB_FENCE asm volatile("" ::: "memory")
#define LD_WQ(F, kt) do { F[0] = LDF(Wp + ((0 * 4 + (kt)) * 2 + 0) * 512); F[1] = LDF(Wp + ((0 * 4 + (kt)) * 2 + 1) * 512); F[2] = LDF(Wp + ((1 * 4 + (kt)) * 2 + 0) * 512); F[3] = LDF(Wp + ((1 * 4 + (kt)) * 2 + 1) * 512); \
                          F[4] = LDF(Qp + ((0 * 4 + (kt)) * 2 + 0) * 512); F[5] = LDF(Qp + ((0 * 4 + (kt)) * 2 + 1) * 512); F[6] = LDF(Qp + ((1 * 4 + (kt)) * 2 + 0) * 512); F[7] = LDF(Qp + ((1 * 4 + (kt)) * 2 + 1) * 512); } while (0)
#define CMP_WQ(F, kt) do { const bf16x8 sb0 = PACKS(S[kt], 0), sb1 = PACKS(S[kt], 1); \
        vn[0] = MFMA32(F[0], sb0, vn[0]); vn[1] = MFMA32(F[2], sb0, vn[1]); o[0] = MFMA32(F[4], sb0, o[0]); o[1] = MFMA32(F[6], sb0, o[1]); \
        vn[0] = MFMA32(F[1], sb1, vn[0]); vn[1] = MFMA32(F[3], sb1, vn[1]); o[0] = MFMA32(F[5], sb1, o[0]); o[1] = MFMA32(F[7], sb1, o[1]); } while (0)
#define LD_KT(F, kt0) do { _Pragma("unroll") for (int q_ = 0; q_ < 8; ++q_) F[q_] = LDF(Kp + ((kt0) * 4 + q_) * 512); } while (0)
#define CMP_KT(F, kt0) do { _Pragma("unroll") for (int k_ = 0; k_ < 2; ++k_) { _Pragma("unroll") for (int r_ = 0; r_ < 16; ++r_) S[(kt0) + k_][r_] *= egl; \
        S[(kt0) + k_] = MFMA32(F[4 * k_ + 0], d00, S[(kt0) + k_]); S[(kt0) + k_] = MFMA32(F[4 * k_ + 1], d01, S[(kt0) + k_]); \
        S[(kt0) + k_] = MFMA32(F[4 * k_ + 2], d10, S[(kt0) + k_]); S[(kt0) + k_] = MFMA32(F[4 * k_ + 3], d11, S[(kt0) + k_]); } } while (0)
#define DNB_SETPTR(nn) do { const size_t item_ = ((size_t)b * 32 + (nn)) * 32 + hv, itemk_ = ((size_t)b * 32 + (nn)) * 16 + hk; \
        Wp = Wimg + item_ * 8192; Qp = Qimg + itemk_ * 8192; Kp = KTimg + itemk_ * 8192; Ap = Aimg + item_ * 4096; \
        Up = Uimg + (item_ * 4 + vs) * 2048; Ep = EG + item_ * 64; Dp = DK + item_ * 64; row0 = (size_t)b * SEQ + (nn) * 64; } while (0)
#define LD_U() do { u0 = ((const u32x4*)Up)[2 * lane]; u1 = ((const u32x4*)Up)[2 * lane + 1]; u2 = ((const u32x4*)Up)[128 + 2 * lane]; u3 = ((const u32x4*)Up)[128 + 2 * lane + 1]; } while (0)
#define DNB_CHUNK(F, nn) do { \
        { const unsigned uu0[8] = {u0.x, u0.y, u0.z, u0.w, u1.x, u1.y, u1.z, u1.w}, uu1[8] = {u2.x, u2.y, u2.z, u2.w, u3.x, u3.y, u3.z, u3.w}; \
          _Pragma("unroll") for (int q_ = 0; q_ < 8; ++q_) { vn[0][2 * q_] = bflo(uu0[q_]); vn[0][2 * q_ + 1] = bfhi(uu0[q_]); vn[1][2 * q_] = bflo(uu1[q_]); vn[1][2 * q_ + 1] = bfhi(uu1[q_]); } } \
        _Pragma("unroll") for (int ct = 0; ct < 2; ++ct) _Pragma("unroll") for (int r = 0; r < 16; ++r) o[ct][r] = 0.f; \
        CMP_WQ(F, 0); DNB_FENCE; LD_WQ(F, 1); DNB_FENCE; \
        CMP_WQ(F, 1); DNB_FENCE; LD_WQ(F, 2); DNB_FENCE; \
        CMP_WQ(F, 2); DNB_FENCE; LD_WQ(F, 3); DNB_FENCE; \
        CMP_WQ(F, 3); DNB_FENCE; \
        _Pragma("unroll") for (int q_ = 0; q_ < 2; ++q_) { F[q_] = LDF(Ap + ((0 * 2 + 0) * 2 + q_) * 512); F[2 + q_] = LDF(Ap + ((1 * 2 + 0) * 2 + q_) * 512); F[4 + q_] = LDF(Ap + ((1 * 2 + 1) * 2 + q_) * 512); } \
        float egl; \
        { f32x4 eg[2][4]; _Pragma("unroll") for (int ct = 0; ct < 2; ++ct) _Pragma("unroll") for (int q_ = 0; q_ < 4; ++q_) eg[ct][q_] = ((const f32x4*)Ep)[ct * 8 + hi * 4 + q_]; \
          DNB_FENCE; \
          _Pragma("unroll") for (int ct = 0; ct < 2; ++ct) _Pragma("unroll") for (int r = 0; r < 16; ++r) o[ct][r] *= eg[ct][r >> 2][r & 3]; \
          egl = __shfl(eg[1][3][3], 63); } \
        { const bf16x8 v00 = PACKS(vn[0], 0), v01 = PACKS(vn[0], 1), v10 = PACKS(vn[1], 0), v11 = PACKS(vn[1], 1); \
          o[0] = MFMA32(F[0], v00, o[0]); o[1] = MFMA32(F[2], v00, o[1]); o[0] = MFMA32(F[1], v01, o[0]); o[1] = MFMA32(F[3], v01, o[1]); o[1] = MFMA32(F[4], v10, o[1]); o[1] = MFMA32(F[5], v11, o[1]); } \
        DNB_FENCE; LD_KT(F, 0); \
        { f32x4 dk[2][4]; _Pragma("unroll") for (int ct = 0; ct < 2; ++ct) _Pragma("unroll") for (int q_ = 0; q_ < 4; ++q_) dk[ct][q_] = ((const f32x4*)Dp)[ct * 8 + hi * 4 + q_]; \
          DNB_FENCE; \
          { bf16_t* op_ = OG + (row0 + 4 * hi) * 4096 + hv * 128 + 32 * vs + r32; \
            _Pragma("unroll") for (int ct = 0; ct < 2; ++ct) _Pragma("unroll") for (int g_ = 0; g_ < 4; ++g_) { \
              _Pragma("unroll") for (int i_ = 0; i_ < 4; ++i_) { *op_ = f2bf(o[ct][4 * g_ + i_]); op_ += 4096; asm volatile("" : "+v"(op_)); } \
              op_ += 4 * 4096; asm volatile("" : "+v"(op_)); } } \
          _Pragma("unroll") for (int ct = 0; ct < 2; ++ct) _Pragma("unroll") for (int r = 0; r < 16; ++r) vn[ct][r] *= dk[ct][r >> 2][r & 3]; } \
        { const bf16x8 d00 = PACKS(vn[0], 0), d01 = PACKS(vn[0], 1), d10 = PACKS(vn[1], 0), d11 = PACKS(vn[1], 1); \
          CMP_KT(F, 0); DNB_FENCE; LD_KT(F, 2); DNB_FENCE; CMP_KT(F, 2); DNB_FENCE; } \
        if ((nn) + 1 < 32) { DNB_SETPTR((nn) + 1); LD_WQ(F, 0); LD_U(); } DNB_FENCE; \
    } while (0)
DI void dnb_wave(const bf16_t* Wimg, const bf16_t* Uimg, const bf16_t* Aimg, const bf16_t* Qimg, const bf16_t* KTimg, const float* EG, const float* DK, bf16_t* OG, int bhv, int vs, int lane) {
    const int b = bhv >> 5, hv = bhv & 31, hk = hv >> 1, r32 = lane & 31, hi = lane >> 5;
    f32x16 S[4], vn[2], o[2];
#pragma unroll
    for (int kt = 0; kt < 4; ++kt)
#pragma unroll
        for (int r = 0; r < 16; ++r) S[kt][r] = 0.f;
    const bf16_t *Wp, *Qp, *Kp, *Ap, *Up; const float *Ep, *Dp; size_t row0;
    bf16x8 F[8]; u32x4 u0, u1, u2, u3;
    DNB_SETPTR(0); LD_WQ(F, 0); LD_U();
    for (int n = 0; n < 32; ++n) { DNB_CHUNK(F, n); }
}

DI void dnc_phase(bf16_t* OG, const bf16_t* Z, const float* norm_g, int wave, int lane) {
    const int gw = blockIdx.x * NWAVES + wave, ngw = gridDim.x * NWAVES;
    const int sub = lane >> 4, c8 = (lane & 15) * 8;
    float g[8];
    { const f32x4 a = *(const f32x4*)(norm_g + c8), c = *(const f32x4*)(norm_g + c8 + 4); g[0] = a.x; g[1] = a.y; g[2] = a.z; g[3] = a.w; g[4] = c.x; g[5] = c.y; g[6] = c.z; g[7] = c.w; }
    for (int it = gw; it < M * 32 / 16; it += ngw) {
        u32x4 ro[4], rz[4];
#pragma unroll
        for (int k = 0; k < 4; ++k) { const size_t off = ((size_t)it * 16 + k * 4 + sub) * 128 + c8; ro[k] = *(const u32x4*)(OG + off); rz[k] = *(const u32x4*)(Z + off); }
#pragma unroll
        for (int k = 0; k < 4; ++k) { const size_t off = ((size_t)it * 16 + k * 4 + sub) * 128 + c8;
            float o[8], z[8]; unpack8(ro[k], o); unpack8(rz[k], z);
            float ss = 0.f;
#pragma unroll
            for (int i = 0; i < 8; ++i) ss += o[i] * o[i];
            const float sc = rsqrtf(sum16(ss) * (1.f / 128.f) + RMS_EPS);
#pragma unroll
            for (int i = 0; i < 8; ++i) o[i] = o[i] * sc * g[i] * pg8::silu_f(z[i]);
            u32x4 w; w.x = pk2(o[0], o[1]); w.y = pk2(o[2], o[3]); w.z = pk2(o[4], o[5]); w.w = pk2(o[6], o[7]);
            *(u32x4*)(OG + off) = w; }
    }
}

#define XB_TMO      128
#define XB_XCNT(j)  (256  + 64 * (j))
#define XB_XSUB(j)  (1280 + 64 * (j))
#define XB_XGEN(j)  (2304 + 64 * (j))
#define XB_TOP      3328
#define XB_TOPGEN   3392
#define XCD_BAR_WORDS 3456
#define XB_SPIN_CAP (1u << 18)

__device__ __forceinline__ unsigned xb_ld(unsigned* p)              { return __hip_atomic_load(p, __ATOMIC_RELAXED, __HIP_MEMORY_SCOPE_AGENT); }
__device__ __forceinline__ unsigned xb_add(unsigned* p, unsigned v) { return __hip_atomic_fetch_add(p, v, __ATOMIC_RELAXED, __HIP_MEMORY_SCOPE_AGENT); }
__device__ __forceinline__ unsigned xb_xcc_id() { return (unsigned)__builtin_amdgcn_s_getreg((3 << 11) | 20) & 0xFu; }
#define XB_SPIN(cond, bar) do { unsigned _sp = 0; while (cond) { __builtin_amdgcn_s_sleep(1); \
    if ((++_sp & 255u) == 0u) { if (xb_ld(&(bar)[XB_TMO])) break; if (_sp > XB_SPIN_CAP) { atomicAdd(&(bar)[XB_TMO], 1u); break; } } } } while (0)

struct XcdBarrier {
    unsigned* bar; unsigned x;
    volatile LAS unsigned* st;
};

__device__ __forceinline__ XcdBarrier xcd_barrier_post(unsigned* bar, volatile LAS unsigned* st) {
    XcdBarrier b; b.bar = bar; b.x = xb_xcc_id(); b.st = st;
    if (threadIdx.x == 0) (void)xb_add(&bar[XB_XCNT(b.x)], 1u);
    return b;
}
__device__ __forceinline__ void xcd_barrier_complete(unsigned* bar, unsigned x, unsigned& nloc, unsigned& nx) {
    const unsigned G = gridDim.x * gridDim.y * gridDim.z;
    unsigned sum, cnt, mine, sp = 0u;
    for (;;) {
        sum = 0u; cnt = 0u; mine = 0u;
#pragma unroll
        for (unsigned j = 0; j < 16; ++j) { const unsigned c = xb_ld(&bar[XB_XCNT(j)]); sum += c; cnt += (c > 0u) ? 1u : 0u; mine = (j == x) ? c : mine; }
        if (sum == G) break;
        __builtin_amdgcn_s_sleep(1);
        if ((++sp & 255u) == 0u) { if (xb_ld(&bar[XB_TMO])) break; if (sp > XB_SPIN_CAP) { atomicAdd(&bar[XB_TMO], 1u); break; } }
    }
    nloc = mine > 0u ? mine : 1u; nx = cnt > 0u ? cnt : 1u;
}

__device__ __forceinline__ void xcd_barrier(const XcdBarrier& b) {
    asm volatile("s_waitcnt vmcnt(0)" ::: "memory");
    __syncthreads();
    if (threadIdx.x == 0) {
        unsigned* bar = b.bar;
        __builtin_amdgcn_s_waitcnt(0);
        unsigned nloc = b.st[0], nx = b.st[1];
        if (nloc == 0u) { xcd_barrier_complete(bar, b.x, nloc, nx); b.st[0] = nloc; b.st[1] = nx; }
        const unsigned old = xb_add(&bar[XB_XSUB(b.x)], 1u);
        const unsigned gen = old / nloc;
        if (old + 1u == (gen + 1u) * nloc) {
            __builtin_amdgcn_fence(__ATOMIC_RELEASE, "agent");
            asm volatile("s_waitcnt vmcnt(0)" ::: "memory");
            const unsigned og = xb_add(&bar[XB_TOP], 1u);
            const unsigned tg = og / nx;
            if (og + 1u == (tg + 1u) * nx) xb_add(&bar[XB_TOPGEN], 1u);
            else XB_SPIN(xb_ld(&bar[XB_TOPGEN]) == tg, bar);
            __builtin_amdgcn_fence(__ATOMIC_ACQUIRE, "agent");
            xb_add(&bar[XB_XGEN(b.x)], 1u);
            asm volatile("s_waitcnt vmcnt(0)" ::: "memory");
        } else {
            XB_SPIN(xb_ld(&bar[XB_XGEN(b.x)]) == gen, bar);
            __builtin_amdgcn_fence(__ATOMIC_ACQUIRE, "agent");
            asm volatile("s_waitcnt vmcnt(0)" ::: "memory");
        }
    }
    __syncthreads();
}

constexpr int N_PHASES = 25;
DI void gemm_swiglu(LAS unsigned char* lds, const bf16_t* A, const bf16_t* Wt, bf16_t* H) {
    pg8::Gemm g{A, Wt, M, 2 * DFF, D}; pg8::StaticOrder S; S.init(M, 2 * DFF, (int)gridDim.x, (int)blockIdx.x);
    pg8::EpiSwiGLU E{H, DFF};
    pg8::gemm_phase<pg8::EpiSwiGLU, pg8::StaticOrder, true, true>(lds, g, S, E);
}
DI void gemm_resid(LAS unsigned char* lds, const bf16_t* A, const bf16_t* Wt, int K, const float* resid, float* out, float scale) {
    pg8::Gemm g{A, Wt, M, D, K}; pg8::StaticOrder S; S.init(M, D, (int)gridDim.x, (int)blockIdx.x);
    pg8::EpiResid E{resid, out, D, ALPHA, scale};
    pg8::gemm_phase<pg8::EpiResid, pg8::StaticOrder, true, true>(lds, g, S, E);
}
__global__ void __launch_bounds__(NTHREADS, 2) fwd_kernel(Args args) {
    extern __shared__ __attribute__((aligned(16))) unsigned char lds_raw[];
    LAS unsigned char* lds = (LAS unsigned char*)lds_raw;
    cg::grid_group grid = cg::this_grid();
    const int tid = threadIdx.x, lane = tid & 63, wave = __builtin_amdgcn_readfirstlane(tid >> 6);
    typedef const Args __attribute__((address_space(4)))* KArgP;
    KArgP ap = (KArgP)__builtin_amdgcn_kernarg_segment_ptr();
    const int lo = args.ph_lo, hi = args.ph_hi;
    { volatile LAS unsigned* st = (volatile LAS unsigned*)(lds + LDS_BYTES - 16); if (tid < 2) st[tid] = 0u; }
    __syncthreads();
    const XcdBarrier xbar = xcd_barrier_post((unsigned*)(args.ws + WS_BAR), (volatile LAS unsigned*)(lds + LDS_BYTES - 16));
#define PHASE(k) if (lo <= (k) && (k) < hi && ((k) == lo || (((k) == lo + 1) ? (grid.sync(), true) : (xcd_barrier(xbar), true))))
#define ARGS_RELOAD() asm volatile("" : "+s"(ap)); unsigned char* const ws = ap->ws
#define WSP(T, off) ((T*)(ws + (off)))
    PHASE(0) { ARGS_RELOAD(); p0_prologue(args, lds, wave, lane); }
    PHASE(1) { ARGS_RELOAD(); gemm_swiglu(lds, WSP(bf16_t, WS_XB), WSP(bf16_t, WS_WGU1_0), WSP(bf16_t, WS_BIG)); }
    PHASE(2) { ARGS_RELOAD(); gemm_resid(lds, WSP(bf16_t, WS_BIG), WSP(bf16_t, WS_WD1_0), DFF, ap->in[0], ap->out, 0.5f); }
    PHASE(3) { ARGS_RELOAD(); ln_phase(ap->out, WSP(bf16_t, WS_XB), ap->in[7] + 0 * D, ap->in[8] + 0 * D, wave, lane); }
    PHASE(4) { ARGS_RELOAD(); pg8::Gemm g{WSP(bf16_t, WS_XB), WSP(bf16_t, WS_WABIN), M, AB_IN, D}; pg8::StaticOrder S; S.init(M, AB_IN, (int)gridDim.x, (int)blockIdx.x);
        pg8::EpiPlain E{WSP(bf16_t, WS_BIG), AB_IN};
        pg8::gemm_phase<pg8::EpiPlain, pg8::StaticOrder, true, true>(lds, g, S, E); }
    PHASE(5) { ARGS_RELOAD();
        for (int it = blockIdx.x; it < 256; it += gridDim.x)
            rope_item(WSP(bf16_t, WS_BIG), WSP(bf16_t, WS_QR), WSP(bf16_t, WS_KR), WSP(bf16_t, WS_VT), WSP(float, WS_KMEAN), it, (LAS float*)lds, tid);
        for (int it = blockIdx.x; it < 512; it += gridDim.x)
            gmlp_item(WSP(bf16_t, WS_BIG), ap->in[10], ap->in[11], ap->in[12], ap->in[13], WSP(bf16_t, WS_CAT), it, lds, wave, lane);
    }
    PHASE(6) { ARGS_RELOAD();
        for (int wg = blockIdx.x; wg < 256; wg += gridDim.x) { const int bh = wg >> 3, sub = wg & 7;
            moba_wave(WSP(bf16_t, WS_QR), WSP(bf16_t, WS_KR), WSP(bf16_t, WS_VT), WSP(float, WS_KMEAN), WSP(bf16_t, WS_CAT), bh, wave * 8 + sub, lane); }
    }
    PHASE(7) { ARGS_RELOAD(); gemm_resid(lds, WSP(bf16_t, WS_CAT), WSP(bf16_t, WS_WABOUT), D, ap->out, ap->out, 1.0f); }
    PHASE(8) { ARGS_RELOAD(); ln_phase(ap->out, WSP(bf16_t, WS_XB), ap->in[7] + 1 * D, ap->in[8] + 1 * D, wave, lane); }
    PHASE(9) { ARGS_RELOAD(); gemm_swiglu(lds, WSP(bf16_t, WS_XB), WSP(bf16_t, WS_WGU2_0), WSP(bf16_t, WS_BIG)); }
    PHASE(10) { ARGS_RELOAD(); gemm_resid(lds, WSP(bf16_t, WS_BIG), WSP(bf16_t, WS_WD2_0), DFF, ap->out, ap->out, 0.5f); }
    PHASE(11) { ARGS_RELOAD(); ln_phase(ap->out, WSP(bf16_t, WS_XB), ap->in[7] + 2 * D, ap->in[8] + 2 * D, wave, lane); }
    PHASE(12) { ARGS_RELOAD(); gemm_swiglu(lds, WSP(bf16_t, WS_XB), WSP(bf16_t, WS_WGU1_1), WSP(bf16_t, WS_BIG)); }
    PHASE(13) { ARGS_RELOAD(); gemm_resid(lds, WSP(bf16_t, WS_BIG), WSP(bf16_t, WS_WD1_1), DFF, ap->out, ap->out, 0.5f); }
    PHASE(14) { ARGS_RELOAD(); ln_phase(ap->out, WSP(bf16_t, WS_XB), ap->in[7] + 3 * D, ap->in[8] + 3 * D, wave, lane); }
    PHASE(15) { ARGS_RELOAD(); pg8::Gemm g{WSP(bf16_t, WS_XB), WSP(bf16_t, WS_WDNIN), M, DN_IN_PAD, D}; pg8::StaticOrder S; S.init(M, DN_IN_PAD, (int)gridDim.x, (int)blockIdx.x);
        pg8::EpiDnIn E{WSP(bf16_t, WS_BIG), WSP(float, WS_BA)};
        pg8::gemm_phase<pg8::EpiDnIn, pg8::StaticOrder, true, true>(lds, g, S, E); }
    PHASE(16) { ARGS_RELOAD(); dnp_phase(WSP(bf16_t, WS_BIG), WSP(bf16_t, WS_BIG) + (size_t)M * 4096, WSP(float, WS_BA), ap->in[16], ap->in[17], ap->in[18],
                          WSP(bf16_t, WS_QN), WSP(bf16_t, WS_KN), WSP(bf16_t, WS_V), WSP(float, WS_G), WSP(float, WS_BETA), wave, lane); }
    PHASE(17) { ARGS_RELOAD();
        for (int it = blockIdx.x * NWAVES + wave; it < 4096; it += gridDim.x * NWAVES)
            dna_wave(WSP(bf16_t, WS_QN), WSP(bf16_t, WS_KN), WSP(bf16_t, WS_V), WSP(float, WS_G), WSP(float, WS_BETA),
                     WSP(bf16_t, WS_WIMG), WSP(bf16_t, WS_UIMG), WSP(bf16_t, WS_AIMG), WSP(bf16_t, WS_QIMG), WSP(bf16_t, WS_KTIMG), WSP(float, WS_GC), WSP(float, WS_GC + MiB), it, lds + wave * DW_STRIDE, lane);
    }
    PHASE(18) { ARGS_RELOAD();
        if (wave < 4) for (int it = blockIdx.x; it < 128; it += gridDim.x)
            dnb_wave(WSP(bf16_t, WS_WIMG), WSP(bf16_t, WS_UIMG), WSP(bf16_t, WS_AIMG), WSP(bf16_t, WS_QIMG), WSP(bf16_t, WS_KTIMG), WSP(float, WS_GC), WSP(float, WS_GC + MiB), WSP(bf16_t, WS_OG), it, wave, lane);
    }
    PHASE(19) { ARGS_RELOAD(); dnc_phase(WSP(bf16_t, WS_OG), WSP(bf16_t, WS_BIG) + (size_t)2 * M * 4096, ap->in[19], wave, lane); }
    PHASE(20) { ARGS_RELOAD(); gemm_resid(lds, WSP(bf16_t, WS_OG), WSP(bf16_t, WS_WDNOUT), 4096, ap->out, ap->out, 1.0f); }
    PHASE(21) { ARGS_RELOAD(); ln_phase(ap->out, WSP(bf16_t, WS_XB), ap->in[7] + 4 * D, ap->in[8] + 4 * D, wave, lane); }
    PHASE(22) { ARGS_RELOAD(); gemm_swiglu(lds, WSP(bf16_t, WS_XB), WSP(bf16_t, WS_WGU2_1), WSP(bf16_t, WS_BIG)); }
    PHASE(23) { ARGS_RELOAD(); gemm_resid(lds, WSP(bf16_t, WS_BIG), WSP(bf16_t, WS_WD2_1), DFF, ap->out, ap->out, 0.5f); }
    PHASE(24) { ARGS_RELOAD(); ln_phase(ap->out, WSP(bf16_t, WS_XB), ap->in[7] + 5 * D, ap->in[8] + 5 * D, wave, lane); }
}

extern "C" void kernel_launch(void* const* d_in, const int* in_sizes, int n_in, void* d_out, int out_size, void* d_ws, size_t ws_size, hipStream_t stream) {
    static int grid = 0;
    if (grid == 0) {
        if (n_in != 21 || out_size != M * D || ws_size < WS_END) { fprintf(stderr, "kernel_launch: unexpected shapes (n_in %d out %d ws %zu)\n", n_in, out_size, ws_size); grid = -1; return; }
        int dev = 0, cus = 0, per_cu = 0;
        (void)hipGetDevice(&dev); (void)hipDeviceGetAttribute(&cus, hipDeviceAttributeMultiprocessorCount, dev);
        (void)hipFuncSetAttribute((const void*)fwd_kernel, hipFuncAttributeMaxDynamicSharedMemorySize, LDS_BYTES);
        (void)hipOccupancyMaxActiveBlocksPerMultiprocessor(&per_cu, (const void*)fwd_kernel, NTHREADS, LDS_BYTES);
        if (per_cu < 1) { fprintf(stderr, "kernel_launch: occupancy query says %d blocks/CU\n", per_cu); per_cu = 1; }
        (void)hipGetLastError();
        grid = cus;
    }
    if (grid < 0) return;
    Args a{};
    for (int i = 0; i < 21; ++i) a.in[i] = (const float*)d_in[i];
    a.out = (float*)d_out; a.ws = (unsigned char*)d_ws; a.ph_lo = 0; a.ph_hi = N_PHASES;
    (void)hipMemsetAsync((char*)d_ws + WS_BAR, 0, BAR_BYTES, stream);
    void* kargs[] = {&a};
    hipError_t e = hipLaunchCooperativeKernel((const void*)fwd_kernel, dim3(grid), dim3(NTHREADS), kargs, LDS_BYTES, stream);
    if (e != hipSuccess) fprintf(stderr, "kernel_launch: cooperative launch failed: %s (grid %d)\n", hipGetErrorString(e), grid);
}
```
